# Optimizing an MI355X kernel written in HIP

```python
import jax
import jax.numpy as jnp
from jax import lax
import numpy as np

D_MODEL = 1024
BATCH = 8
SEQ = 4096
DEPTH = 4

GRID_W = 64
CTX_LEN = 256
N_MOD = 6

POOL_GROUPS = 4
POOL_WINDOWS = (2, 4, 8, 16)
POOL_WIDTH = D_MODEL // 4
POOL_GROUP_DIM = POOL_WIDTH // POOL_GROUPS

NA_HEAD_DIM = 64
NA_HEADS = (D_MODEL - POOL_WIDTH) // NA_HEAD_DIM
NA_WIDTH = NA_HEADS * NA_HEAD_DIM
WIN_H = 8
WIN_W = 16
COL_BLOCK = 16
COL_BAND = COL_BLOCK + WIN_W
N_COL_BLOCKS = GRID_W // COL_BLOCK
AB_IN = POOL_WIDTH + 3 * NA_WIDTH
AB_OUT = POOL_WIDTH + NA_WIDTH

GLA_HEADS = 4
GLA_DK = D_MODEL // 2 // GLA_HEADS
GLA_DV = D_MODEL // GLA_HEADS
GATE_RANK = 16
GATE_NORM = 16.0
GLA_CHUNK = 64
GLA_QK = GLA_HEADS * GLA_DK
GLA_V = GLA_HEADS * GLA_DV
GLA_IN = 2 * GLA_QK + 2 * GLA_V + 2 * GATE_RANK
ROPE_BASE = 10000.0

N_EXPERTS = 32
TOP_K = 4
D_EXPERT = D_MODEL
SWIGLU_LIMIT = 7.0
SWIGLU_ALPHA = 1.702
MOE_BLOCK = 256

DEEPNORM_ALPHA = (2.0 * DEPTH) ** 0.25
DEEPNORM_BETA = (8.0 * DEPTH) ** -0.25
N_EVEN = (DEPTH + 1) // 2
N_ODD = DEPTH // 2
LN_EPS = 1e-5
RMS_EPS = 1e-6
NEG_INF = -1e30

kernel_name = 'hybrid_pool_natten_gla_moe_dit'


def layer_norm(x, g, b):
    xf = x.astype(jnp.float32)
    mu = jnp.mean(xf, axis=-1, keepdims=True)
    var = jnp.mean(jnp.square(xf - mu), axis=-1, keepdims=True)
    return ((xf - mu) * lax.rsqrt(var + LN_EPS) * g + b).astype(x.dtype)


def multiscale_pool(u):
    T = u.shape[1]
    uf = u.astype(jnp.float32)
    csum = jnp.concatenate([jnp.zeros_like(uf[:, :1]), jnp.cumsum(uf, axis=1)], axis=1)
    w = jnp.array(POOL_WINDOWS, dtype=jnp.int32)
    t = jnp.arange(T)[:, None]
    lo = jnp.clip(t - w // 2, 0, T)
    hi = jnp.clip(t - w // 2 + w, 0, T)
    g = jnp.arange(POOL_GROUPS)[None, :]
    mean = (csum[:, hi, g] - csum[:, lo, g]) / (hi - lo).astype(jnp.float32)[None, :, :, None]
    return (mean - uf).astype(u.dtype)


def axial_rope_tables(T, dim):
    t = jnp.arange(T)
    row = (t // GRID_W).astype(jnp.float32)
    col = (t % GRID_W).astype(jnp.float32)
    nf = dim // 4
    freqs = ROPE_BASE ** (-jnp.arange(nf, dtype=jnp.float32) / nf)
    ang = jnp.concatenate([row[:, None] * freqs, col[:, None] * freqs], axis=-1)
    return jnp.cos(ang), jnp.sin(ang)


def apply_rope(x, cos, sin):
    x1, x2 = jnp.split(x, 2, axis=-1)
    cs = cos[None, :, None, :]
    sn = sin[None, :, None, :]
    return jnp.concatenate([x1 * cs - x2 * sn, x1 * sn + x2 * cs], axis=-1).astype(x.dtype)


def neighborhood_attention(q, k, v, kc, vc, rpb):
    B, T, H, Dh = q.shape
    rows = T // GRID_W
    kh = min(WIN_H, rows)
    scale = Dh ** -0.5

    def grid(a):
        return a.reshape(B, rows, GRID_W, H, Dh).transpose(0, 3, 1, 2, 4)

    qg = grid(q).reshape(B, H, rows, N_COL_BLOCKS, COL_BLOCK, Dh)
    kg, vg = grid(k), grid(v)
    r = jnp.arange(rows)
    row_start = jnp.clip(r - kh // 2, 0, rows - kh)
    key_rows = row_start[:, None] + jnp.arange(kh)
    jb = jnp.arange(N_COL_BLOCKS)
    band_start = jnp.clip(jb * COL_BLOCK - WIN_W // 2, 0, GRID_W - COL_BAND)
    key_cols = band_start[:, None] + jnp.arange(COL_BAND)
    ridx = key_rows[:, :, None, None]
    cidx = key_cols[None, None, :, :]
    kb = kg[:, :, ridx, cidx]
    vb = vg[:, :, ridx, cidx]

    qcol = jb[:, None] * COL_BLOCK + jnp.arange(COL_BLOCK)
    win_start = jnp.clip(qcol - WIN_W // 2, 0, GRID_W - WIN_W)
    kcol = key_cols[:, None, :]
    col_ok = (kcol >= win_start[..., None]) & (kcol < win_start[..., None] + WIN_W)
    dcol = jnp.clip(kcol - qcol[..., None] + WIN_W - 1, 0, 2 * WIN_W - 2)
    drow = key_rows - r[:, None] + WIN_H - 1
    bias = rpb[:, drow[:, None, None, :, None], dcol[None, :, :, None, :]]

    s_band = jnp.einsum('bhrjqd,bhrkjcd->bhrjqkc', qg, kb).astype(jnp.float32) * scale + bias
    s_band = jnp.where(col_ok[:, :, None, :], s_band, NEG_INF)
    s_ctx = jnp.einsum('bhrjqd,bnhd->bhrjqn', qg, kc).astype(jnp.float32) * scale
    nb = kh * COL_BAND
    logits = jnp.concatenate([s_band.reshape(B, H, rows, N_COL_BLOCKS, COL_BLOCK, nb), s_ctx], axis=-1)
    p = jax.nn.softmax(logits, axis=-1).astype(v.dtype)
    p_band = p[..., :nb].reshape(B, H, rows, N_COL_BLOCKS, COL_BLOCK, kh, COL_BAND)
    p_ctx = p[..., nb:]
    o = jnp.einsum('bhrjqkc,bhrkjcd->bhrjqd', p_band, vb) + jnp.einsum('bhrjqn,bnhd->bhrjqd', p_ctx, vc)
    return o.reshape(B, H, rows, GRID_W, Dh).transpose(0, 2, 3, 1, 4).reshape(B, T, H * Dh)


def context_self_attention(q, k, v):
    B, N, H, Dh = q.shape
    s = jnp.einsum('bnhd,bmhd->bhnm', q, k).astype(jnp.float32) * Dh ** -0.5
    p = jax.nn.softmax(s, axis=-1).astype(v.dtype)
    return jnp.einsum('bhnm,bmhd->bnhd', p, v).reshape(B, N, H * Dh)


def pool_na_mixer(hx, hc, w_in, pool_w, pool_scale, rpb, w_out, with_ctx_out):
    def split_heads(p):
        u = p[..., :POOL_WIDTH]
        q, k, v = jnp.split(p[..., POOL_WIDTH:], 3, axis=-1)
        shp = p.shape[:2] + (NA_HEADS, NA_HEAD_DIM)
        return u, q.reshape(shp), k.reshape(shp), v.reshape(shp)

    def pool_branch(u):
        ug = u.reshape(u.shape[:2] + (POOL_GROUPS, POOL_GROUP_DIM))
        y = jnp.einsum('btgd,gde->btge', multiscale_pool(ug), pool_w)
        return y.reshape(u.shape) * pool_scale

    ux, qx, kx, vx = split_heads(hx @ w_in)
    uc, qc, kc, vc = split_heads(hc @ w_in)
    ax = neighborhood_attention(qx, kx, vx, kc, vc, rpb)
    ox = jnp.concatenate([pool_branch(ux), ax], axis=-1) @ w_out
    if not with_ctx_out:
        return ox, None
    ac = context_self_attention(qc, kc, vc)
    oc = jnp.concatenate([pool_branch(uc), ac], axis=-1) @ w_out
    return ox, oc


def gla_chunked(q, k, v, log_a, s0):
    B, H, T, dk = q.shape
    dv = v.shape[-1]
    n = T // GLA_CHUNK

    def chunks(a):
        return a.reshape(B, H, n, GLA_CHUNK, a.shape[-1]).transpose(2, 0, 1, 3, 4)

    lower = jnp.tril(jnp.ones((GLA_CHUNK, GLA_CHUNK), dtype=bool))[:, :, None]

    def step(S, inp):
        qc, kc, vc, gc = inp
        b = jnp.cumsum(gc.astype(jnp.float32), axis=2)
        b_last = b[:, :, -1:, :]
        o_inter = jnp.einsum('bhtd,bhde->bhte', qc * jnp.exp(b), S)
        diff = b[:, :, :, None, :] - b[:, :, None, :, :]
        decay = jnp.where(lower, jnp.exp(jnp.where(lower, diff, 0.0)), 0.0)
        att = jnp.einsum('bhtd,bhsd,bhtsd->bhts', qc, kc, decay)
        o = o_inter + jnp.einsum('bhts,bhse->bhte', att, vc)
        S_new = S * jnp.exp(b_last)[:, :, 0, :, None] + jnp.einsum('bhsd,bhse->bhde', kc * jnp.exp(b_last - b), vc)
        return S_new, o

    S, o = lax.scan(step, s0, (chunks(q), chunks(k), chunks(v), chunks(log_a)))
    return o.transpose(1, 2, 0, 3, 4).reshape(B, H, T, dv).astype(v.dtype), S


def bidir_gla_mixer(hx, hc, w_in, w_gate, b_gate, norm_g, w_out, cos, sin, with_ctx_out):
    def project(h, rotary):
        B, T, _ = h.shape
        p = h @ w_in
        q, k, v, r, g = jnp.split(p, [GLA_QK, 2 * GLA_QK, 2 * GLA_QK + GLA_V, 2 * GLA_QK + 2 * GLA_V], axis=-1)
        q = q.reshape(B, T, GLA_HEADS, GLA_DK)
        k = k.reshape(B, T, GLA_HEADS, GLA_DK)
        if rotary:
            q = apply_rope(q, cos, sin)
            k = apply_rope(k, cos, sin)
        q = q * GLA_DK ** -0.5
        v = v.reshape(B, T, GLA_HEADS, GLA_DV)
        g = g.reshape(B, T, 2, GATE_RANK)
        la = jax.nn.log_sigmoid((jnp.einsum('btzr,zre->btze', g, w_gate) + b_gate).astype(jnp.float32)) / GATE_NORM
        la = la.reshape(B, T, 2, GLA_HEADS, GLA_DK)
        heads = lambda a: a.transpose(0, 2, 1, 3)
        return heads(q), heads(k), heads(v), r, heads(la[:, :, 0]), heads(la[:, :, 1])

    def flip(a):
        return jnp.flip(a, axis=2)

    def output(o, r):
        B, H, T, dv = o.shape
        of = o.astype(jnp.float32)
        of = of * lax.rsqrt(jnp.mean(of * of, axis=-1, keepdims=True) + RMS_EPS) * norm_g
        of = of.transpose(0, 2, 1, 3).reshape(B, T, H * dv)
        return (of.astype(r.dtype) * jax.nn.silu(r)) @ w_out

    qc, kc, vc, rc, af_c, ab_c = project(hc, False)
    qx, kx, vx, rx, af_x, ab_x = project(hx, True)
    B = hx.shape[0]
    zero = jnp.zeros((B, GLA_HEADS, GLA_DK, GLA_DV), jnp.float32)
    of_c, s_f = gla_chunked(qc, kc, vc, af_c, zero)
    ob_c, s_b = gla_chunked(flip(qc), flip(kc), flip(vc), flip(ab_c), zero)
    of_x, _ = gla_chunked(qx, kx, vx, af_x, s_f)
    ob_x, _ = gla_chunked(flip(qx), flip(kx), flip(vx), flip(ab_x), s_b)
    ox = output(of_x + flip(ob_x), rx)
    if not with_ctx_out:
        return ox, None
    oc = output(of_c + flip(ob_c), rc)
    return ox, oc


def moe_ffn(h, router_w, router_b, w1, b1, w2, b2):
    lead = h.shape[:-1]
    d = h.shape[-1]
    xf = h.reshape(-1, d)
    n_tok = xf.shape[0]
    m = n_tok * TOP_K
    logits = (xf @ router_w + router_b).astype(jnp.float32)
    top_logit, top_idx = lax.top_k(logits, TOP_K)
    gates = jax.nn.softmax(top_logit, axis=-1).reshape(m)
    flat_e = top_idx.reshape(m)
    order = jnp.argsort(flat_e)
    e_sorted = flat_e[order]
    tok_sorted = order // TOP_K
    sizes = jnp.bincount(flat_e, length=N_EXPERTS)
    starts = jnp.cumsum(sizes) - sizes
    padded = (sizes + MOE_BLOCK - 1) // MOE_BLOCK * MOE_BLOCK
    pad_ends = jnp.cumsum(padded)
    pad_starts = pad_ends - padded
    dest = pad_starts[e_sorted] + jnp.arange(m) - starts[e_sorted]
    n_blocks = (m + N_EXPERTS * (MOE_BLOCK - 1)) // MOE_BLOCK + 1
    x_pad = jnp.zeros((n_blocks * MOE_BLOCK, d), xf.dtype).at[dest].set(xf[tok_sorted])
    block_start = jnp.arange(n_blocks) * MOE_BLOCK
    block_expert = jnp.minimum(jnp.searchsorted(pad_ends, block_start, side='right'), N_EXPERTS - 1)

    def expert_block(args):
        xb, e = args
        hid = xb @ w1[e] + b1[e]
        x_glu, x_lin = jnp.split(hid, 2, axis=-1)
        x_glu = jnp.minimum(x_glu, SWIGLU_LIMIT)
        x_lin = jnp.clip(x_lin, -SWIGLU_LIMIT, SWIGLU_LIMIT)
        act = x_glu * jax.nn.sigmoid(SWIGLU_ALPHA * x_glu) * (x_lin + 1.0)
        return act @ w2[e] + b2[e]

    y_pad = lax.map(expert_block, (x_pad.reshape(n_blocks, MOE_BLOCK, d), block_expert))
    y_sorted = y_pad.reshape(n_blocks * MOE_BLOCK, d)[dest] * gates[order][:, None]
    y = jax.ops.segment_sum(y_sorted, tok_sorted, num_segments=n_tok)
    return y.reshape(lead + (d,)).astype(h.dtype)


def setup_inputs(seed: int = 0) -> dict:
    key = jax.random.key(seed)
    ks = jax.random.split(key, 24)
    D = D_MODEL

    def nrm(k, shape, scale):
        return jax.random.normal(k, shape, jnp.float32) * scale

    return {
        'x': nrm(ks[0], (BATCH, SEQ, D), 1.0),
        'c': nrm(ks[1], (BATCH, D), 1.0),
        'ctx': nrm(ks[2], (BATCH, CTX_LEN, D), 1.0),
        'c_ctx': nrm(ks[3], (D,), 1.0),
        'ada_w': nrm(ks[4], (DEPTH, D, N_MOD * D), 0.5 * D ** -0.5),
        'ada_b': nrm(ks[5], (DEPTH, N_MOD * D), 0.02),
        'ln_g': 1.0 + nrm(ks[6], (DEPTH, 2, D), 0.02),
        'ln_b': nrm(ks[7], (DEPTH, 2, D), 0.02),
        'ab_w_in': nrm(ks[8], (N_EVEN, D, AB_IN), D ** -0.5),
        'ab_pool_w': nrm(ks[9], (N_EVEN, POOL_GROUPS, POOL_GROUP_DIM, POOL_GROUP_DIM), POOL_GROUP_DIM ** -0.5),
        'ab_pool_scale': 1.0 + nrm(ks[10], (N_EVEN, POOL_WIDTH), 0.1),
        'ab_rpb': nrm(ks[11], (N_EVEN, NA_HEADS, 2 * WIN_H - 1, 2 * WIN_W - 1), 0.1),
        'ab_w_out': nrm(ks[12], (N_EVEN, AB_OUT, D), DEEPNORM_BETA * AB_OUT ** -0.5),
        'gla_w_in': nrm(ks[13], (N_ODD, D, GLA_IN), D ** -0.5),
        'gla_w_gate': nrm(ks[14], (N_ODD, 2, GATE_RANK, GLA_QK), GATE_RANK ** -0.5),
        'gla_b_gate': nrm(ks[15], (N_ODD, 2, GLA_QK), 0.5),
        'gla_norm_g': 1.0 + nrm(ks[16], (N_ODD, GLA_DV), 0.02),
        'gla_w_out': nrm(ks[17], (N_ODD, GLA_V, D), DEEPNORM_BETA * GLA_V ** -0.5),
        'router_w': nrm(ks[18], (DEPTH, D, N_EXPERTS), D ** -0.5),
        'router_b': nrm(ks[19], (DEPTH, N_EXPERTS), 0.01),
        'exp_w1': nrm(ks[20], (DEPTH, N_EXPERTS, D, 2 * D_EXPERT), D ** -0.5),
        'exp_b1': nrm(ks[21], (DEPTH, N_EXPERTS, 2 * D_EXPERT), 0.01),
        'exp_w2': nrm(ks[22], (DEPTH, N_EXPERTS, D_EXPERT, D), DEEPNORM_BETA * D_EXPERT ** -0.5),
        'exp_b2': nrm(ks[23], (DEPTH, N_EXPERTS, D), 0.01),
    }


def reference(x, c, ctx, c_ctx, ada_w, ada_b, ln_g, ln_b, ab_w_in, ab_pool_w, ab_pool_scale, ab_rpb,
              ab_w_out, gla_w_in, gla_w_gate, gla_b_gate, gla_norm_g, gla_w_out, router_w, router_b,
              exp_w1, exp_b1, exp_w2, exp_b2):
    T = x.shape[1]
    n_ctx = ctx.shape[1]
    cos, sin = axial_rope_tables(T, GLA_DK)
    sc = jax.nn.silu(c)
    scc = jax.nn.silu(c_ctx)
    for i in range(DEPTH):
        last = i == DEPTH - 1
        j = i // 2
        sh1, s1, g1, sh2, s2, g2 = jnp.split((sc @ ada_w[i] + ada_b[i])[:, None, :], N_MOD, axis=-1)
        ch1, cs1, cg1, ch2, cs2, cg2 = jnp.split(scc @ ada_w[i] + ada_b[i], N_MOD, axis=-1)
        hx = x * (1.0 + s1) + sh1
        hc = ctx * (1.0 + cs1) + ch1
        if i % 2 == 0:
            ox, oc = pool_na_mixer(hx, hc, ab_w_in[j], ab_pool_w[j], ab_pool_scale[j], ab_rpb[j],
                                   ab_w_out[j], not last)
        else:
            ox, oc = bidir_gla_mixer(hx, hc, gla_w_in[j], gla_w_gate[j], gla_b_gate[j], gla_norm_g[j],
                                     gla_w_out[j], cos, sin, not last)
        x = layer_norm(DEEPNORM_ALPHA * x + g1 * ox, ln_g[i, 0], ln_b[i, 0])
        hx = x * (1.0 + s2) + sh2
        if last:
            y = moe_ffn(hx, router_w[i], router_b[i], exp_w1[i], exp_b1[i], exp_w2[i], exp_b2[i])
            x = layer_norm(DEEPNORM_ALPHA * x + g2 * y, ln_g[i, 1], ln_b[i, 1])
        else:
            ctx = layer_norm(DEEPNORM_ALPHA * ctx + cg1 * oc, ln_g[i, 0], ln_b[i, 0])
            hc = ctx * (1.0 + cs2) + ch2
            y = moe_ffn(jnp.concatenate([hc, hx], axis=1), router_w[i], router_b[i], exp_w1[i], exp_b1[i],
                        exp_w2[i], exp_b2[i])
            x = layer_norm(DEEPNORM_ALPHA * x + g2 * y[:, n_ctx:], ln_g[i, 1], ln_b[i, 1])
            ctx = layer_norm(DEEPNORM_ALPHA * ctx + cg2 * y[:, :n_ctx], ln_g[i, 1], ln_b[i, 1])
    return x
```

```cpp
#include <hip/hip_runtime.h>
#include <cstdio>
#include <cstdint>

#ifndef MK_PER_PHASE
#define MK_PER_PHASE 0
#endif

#ifndef PROBE_DUP
#define PROBE_DUP 0
#endif
#define LAS __attribute__((address_space(3)))
typedef unsigned short bf16;
typedef short bf16x8 __attribute__((ext_vector_type(8)));
typedef float f32x4 __attribute__((ext_vector_type(4)));
typedef unsigned u32x4 __attribute__((ext_vector_type(4)));
typedef unsigned u32x2 __attribute__((ext_vector_type(2)));

constexpr int D = 1024, NBATCH = 8, T = 4096, NCTX = 256, DEPTH = 4;
constexpr int ML = NBATCH * T, MC = NBATCH * NCTX, M = ML + MC;
constexpr int AB_IN = 2560, GLA_IN = 3104, NE = 32;
constexpr int NSLOT = M * 4;
constexpr float DN_ALPHA = 1.6817928305074292f;
constexpr float LN_EPS = 1e-5f;
constexpr int NTHREADS = 512, NWAVES = 8;

constexpr size_t MiB = 1ull << 20;
constexpr size_t WS_CTL = 0, CTL_ZERO_BYTES = 1 * MiB;
constexpr size_t WS_MODS = 1 * MiB;
constexpr size_t WS_WABIN = 2 * MiB;
constexpr size_t WS_WABOUT = 12 * MiB;
constexpr size_t WS_WGIN = 16 * MiB, WGIN_STRIDE = (size_t)3328 * 1024;
constexpr size_t WS_WGOUT = 29 * MiB;
constexpr size_t WS_W1T = 33 * MiB;
constexpr size_t WS_W2T = 545 * MiB;
constexpr size_t WS_X = 801 * MiB;
constexpr size_t WS_H = 937 * MiB;
constexpr size_t WS_P = 1005 * MiB;
constexpr size_t WS_A2 = 1213 * MiB;
constexpr size_t WS_OF = 1281 * MiB;
constexpr size_t WS_OB = 1417 * MiB;
constexpr size_t WS_ACT = 1553 * MiB;
constexpr size_t WS_YS = 1827 * MiB;
constexpr size_t WS_LIST = 2101 * MiB;
constexpr size_t WS_TOKE = 2106 * MiB;
constexpr size_t WS_TOKP = 2107 * MiB;
constexpr size_t WS_TOKG = 2108 * MiB;
constexpr size_t WS_VT = 2109 * MiB;
constexpr size_t WS_VTC = WS_VT + 48 * MiB;
constexpr size_t WS_GQD = 2165 * MiB;
constexpr size_t WS_GKLT = 2241 * MiB;
constexpr size_t WS_GATT = 2319 * MiB;
constexpr size_t WS_GDEC = 2359 * MiB;
constexpr size_t WS_GVT = 2362 * MiB;
constexpr size_t WS_ROPE = 2440 * MiB;
constexpr size_t WS_H8 = 2442 * MiB;
constexpr size_t WS_RWT = 2477 * MiB;
constexpr size_t WS_END = 2478 * MiB;
constexpr int CW_BAR = 4096;
constexpr int CW_CNT = 8192;

constexpr int LDS_BYTES = 155648;
constexpr int LDS_MISC = 155648 - 256;

struct Params {
    const float* in[24];
    float* out;
    unsigned char* ws;
    int ph_lo, ph_hi;
};

#define LDS_WAIT() asm volatile("s_waitcnt lgkmcnt(0)" ::: "memory")
#define LDS_BARRIER() asm volatile("s_waitcnt lgkmcnt(0)\n\ts_barrier" ::: "memory")
__device__ __forceinline__ unsigned f2bf(float f) { unsigned u = __builtin_bit_cast(unsigned, f); return (u + 0x7fffu + ((u >> 16) & 1u)) >> 16; }
__device__ __forceinline__ float bf2f(unsigned h) { return __builtin_bit_cast(float, h << 16); }
typedef float f32x2 __attribute__((ext_vector_type(2)));
typedef __bf16 bf16x2_t __attribute__((ext_vector_type(2)));
__device__ __forceinline__ unsigned pk2(float lo, float hi) { const f32x2 v = {lo, hi}; const bf16x2_t b = __builtin_convertvector(v, bf16x2_t); return __builtin_bit_cast(unsigned, b); }
__device__ __forceinline__ float wave_sum(float v) {
#pragma unroll
    for (int o = 1; o < 64; o <<= 1) v += __shfl_xor(v, o);
    return v;
}
__device__ __forceinline__ f32x4 mfma16(bf16x8 a, bf16x8 b, f32x4 c) { return __builtin_amdgcn_mfma_f32_16x16x32_bf16(a, b, c, 0, 0, 0); }
__device__ __forceinline__ bf16x8 mk_frag(unsigned a, unsigned b, unsigned c, unsigned d) { u32x4 v = {a, b, c, d}; return __builtin_bit_cast(bf16x8, v); }
__device__ __forceinline__ unsigned pk4_fp8(float a, float b, float c, float d) {
    a = fminf(fmaxf(a, -448.f), 448.f); b = fminf(fmaxf(b, -448.f), 448.f); c = fminf(fmaxf(c, -448.f), 448.f); d = fminf(fmaxf(d, -448.f), 448.f);
    int w = 0; w = __builtin_amdgcn_cvt_pk_fp8_f32(a, b, w, false); w = __builtin_amdgcn_cvt_pk_fp8_f32(c, d, w, true); return (unsigned)w; }
__device__ __forceinline__ unsigned pk4_fp8_nc(float a, float b, float c, float d) { int w = 0; w = __builtin_amdgcn_cvt_pk_fp8_f32(a, b, w, false); w = __builtin_amdgcn_cvt_pk_fp8_f32(c, d, w, true); return (unsigned)w; }
constexpr float H8_SCALE = 16.f, ACT8_SCALE = 4.f, W1_SCALE = 256.f, W2_SCALE = 512.f;
constexpr int H8_E8 = 0x7B7B7B7B, ACT8_E8 = 0x7D7D7D7D, W1_E8 = 0x77777777, W2_E8 = 0x76767676;
__device__ __forceinline__ float silu_f(float x) { return x / (1.f + __expf(-x)); }


__device__ __forceinline__ void conv_item(const float* W, int N, int k0, int nsrc, bf16* WT, int ndst, LAS float* scr, int lane) {
#pragma unroll 8
    for (int i = 0; i < 32; ++i) { const int kk = 2 * i + (lane >> 5); scr[kk * 33 + (lane & 31)] = W[(size_t)(k0 + kk) * N + nsrc + (lane & 31)]; }
    LDS_WAIT(); asm volatile("" ::: "memory");
    const int c = lane & 7;
#pragma unroll
    for (int j = 0; j < 4; ++j) { const int n = (lane >> 3) + 8 * j; const LAS float* s = scr + (8 * c) * 33 + n;
        u32x4 o; o.x = pk2(s[0 * 33], s[1 * 33]); o.y = pk2(s[2 * 33], s[3 * 33]); o.z = pk2(s[4 * 33], s[5 * 33]); o.w = pk2(s[6 * 33], s[7 * 33]);
        *(u32x4*)(WT + (size_t)(ndst + n) * 1024 + k0 + 8 * c) = o; }
    LDS_WAIT(); asm volatile("" ::: "memory");
}

__device__ __forceinline__ void conv_item8(const float* W, int N, int k0, int nsrc, unsigned char* WT8, int ndst, float scale, LAS float* scr, int lane) {
#pragma unroll 8
    for (int i = 0; i < 32; ++i) { const int kk = 2 * i + (lane >> 5); scr[kk * 33 + (lane & 31)] = W[(size_t)(k0 + kk) * N + nsrc + (lane & 31)]; }
    LDS_WAIT(); asm volatile("" ::: "memory");
    const int c = lane & 7;
#pragma unroll
    for (int j = 0; j < 4; ++j) { const int n = (lane >> 3) + 8 * j; const LAS float* s = scr + (8 * c) * 33 + n;
        u32x2 o; o.x = pk4_fp8(s[0 * 33] * scale, s[1 * 33] * scale, s[2 * 33] * scale, s[3 * 33] * scale); o.y = pk4_fp8(s[4 * 33] * scale, s[5 * 33] * scale, s[6 * 33] * scale, s[7 * 33] * scale);
        *(u32x2*)(WT8 + (size_t)(ndst + n) * 1024 + k0 + 8 * c) = o; }
    LDS_WAIT(); asm volatile("" ::: "memory");
}

__device__ __forceinline__ void phase_prologue_a(const Params& P, LAS unsigned char* lds, int tid, int bid, int nb) {
    const int lane = tid & 63, wave = tid >> 6;
    unsigned char* ws = P.ws;
    for (int idx = bid * NTHREADS + tid; idx < T * 64; idx += nb * NTHREADS) { const int t = idx >> 6, f = idx & 63;
        const float pos = (f < 32) ? (float)(t >> 6) : (float)(t & 63); const float freq = expf(-(float)(f & 31) * (9.210340371976184f / 32.0f));
        float sn, cn; sincosf(pos * freq, &sn, &cn); ((float*)(ws + WS_ROPE))[idx] = cn; ((float*)(ws + WS_ROPE))[T * 64 + idx] = sn; }
    for (int idx = bid * NTHREADS + tid; idx < DEPTH * 32 * 1024; idx += nb * NTHREADS) { const int l = idx >> 15, e = (idx >> 10) & 31, k = idx & 1023;
        const float w = P.in[18][((size_t)l * 1024 + k) * 32 + e]; const unsigned hi = f2bf(w); const unsigned lo = f2bf(w - bf2f(hi));
        bf16* rwt = (bf16*)(ws + WS_RWT) + (size_t)l * 2 * 32 * 1024; rwt[e * 1024 + k] = (bf16)hi; rwt[32 * 1024 + e * 1024 + k] = (bf16)lo; }
    for (int u = bid; u < 4 * 48; u += nb) {
        const int l = u / 48, j0 = (u % 48) * 128;
        LAS float* sc = (LAS float*)lds;
        LAS float* red = (LAS float*)(lds + 9 * 1024 * 4);
        for (int idx = tid; idx < 9 * 1024; idx += NTHREADS) { const int r = idx >> 10, k = idx & 1023; const float c = (r < 8) ? P.in[1][r * 1024 + k] : P.in[3][k]; sc[idx] = silu_f(c); }
        __syncthreads();
        const int c = tid & 127, kq = tid >> 7;
        float acc[9];
#pragma unroll
        for (int r = 0; r < 9; ++r) acc[r] = 0.f;
        const float* w = P.in[4] + (size_t)l * 1024 * 6144 + j0 + c;
        for (int k = kq * 256; k < kq * 256 + 256; ++k) { const float wv = w[(size_t)k * 6144];
#pragma unroll
            for (int r = 0; r < 9; ++r) acc[r] += sc[r * 1024 + k] * wv; }
#pragma unroll
        for (int r = 0; r < 9; ++r) red[(kq * 9 + r) * 128 + c] = acc[r];
        __syncthreads();
        float* mods = (float*)(ws + WS_MODS);
        for (int idx = tid; idx < 9 * 128; idx += NTHREADS) { const int r = idx >> 7, cc = idx & 127;
            const float s = (red[(0 * 9 + r) * 128 + cc] + red[(1 * 9 + r) * 128 + cc]) + (red[(2 * 9 + r) * 128 + cc] + red[(3 * 9 + r) * 128 + cc]);
            mods[(size_t)(l * 9 + r) * 6144 + j0 + cc] = s + P.in[5][l * 6144 + j0 + cc]; }
        __syncthreads();
    }
    LAS float* scr = (LAS float*)(lds + wave * 16384);
    const int gw = bid * NWAVES + wave, NGW = nb * NWAVES;
    constexpr int I0 = 2 * 16 * 80, I1 = 2 * 16 * 32, I2 = 2 * 16 * 97, I3 = 2 * 16 * 32, I4 = 128 * 16 * 64, I5 = 128 * 16 * 32;
    constexpr int NITEMS = I0 + I1 + I2 + I3 + I4 + I5;
    for (int it = gw; it < NITEMS; it += NGW) {
        int r = it;
        if (r < I0) { const int mt = r / (16 * 80), q = r % (16 * 80), kb = q / 80, nbk = q % 80;
            conv_item8(P.in[8] + (size_t)mt * 1024 * AB_IN, AB_IN, kb * 64, nbk * 32, (unsigned char*)(ws + WS_WABIN) + (size_t)mt * AB_IN * 1024, nbk * 32, W1_SCALE, scr, lane); continue; } r -= I0;
        if (r < I1) { const int mt = r / (16 * 32), q = r % (16 * 32), kb = q / 32, nbk = q % 32;
            conv_item(P.in[12] + (size_t)mt * 1024 * 1024, 1024, kb * 64, nbk * 32, (bf16*)(ws + WS_WABOUT) + (size_t)mt * 1024 * 1024, nbk * 32, scr, lane); continue; } r -= I1;
        if (r < I2) { const int mt = r / (16 * 97), q = r % (16 * 97), kb = q / 97, nbk = q % 97;
            conv_item8(P.in[13] + (size_t)mt * 1024 * GLA_IN, GLA_IN, kb * 64, nbk * 32, (unsigned char*)(ws + WS_WGIN) + (size_t)mt * WGIN_STRIDE, nbk * 32, W1_SCALE, scr, lane); continue; } r -= I2;
        if (r < I3) { const int mt = r / (16 * 32), q = r % (16 * 32), kb = q / 32, nbk = q % 32;
            conv_item(P.in[17] + (size_t)mt * 1024 * 1024, 1024, kb * 64, nbk * 32, (bf16*)(ws + WS_WGOUT) + (size_t)mt * 1024 * 1024, nbk * 32, scr, lane); continue; } r -= I3;
        if (r < I4) { const int mt = r / (16 * 64), q = r % (16 * 64), kb = q / 64, rb = q % 64;
            const int tile = rb >> 3, half = (rb >> 2) & 1, qq = rb & 3; const int nsrc = half * 1024 + tile * 128 + qq * 32;
            conv_item8(P.in[20] + (size_t)mt * 1024 * 2048, 2048, kb * 64, nsrc, (unsigned char*)(ws + WS_W1T) + (size_t)mt * 2048 * 1024, rb * 32, W1_SCALE, scr, lane); continue; } r -= I4;
        { const int mt = r / (16 * 32), q = r % (16 * 32), kb = q / 32, nbk = q % 32;
            conv_item8(P.in[22] + (size_t)mt * 1024 * 1024, 1024, kb * 64, nbk * 32, (unsigned char*)(ws + WS_W2T) + (size_t)mt * 1024 * 1024, nbk * 32, W2_SCALE, scr, lane); }
    }
}

__device__ __forceinline__ void store_h_row(unsigned char* hrow, const f32x4 (&v)[4], const float* shift, const float* scale, int lane) {
#pragma unroll
    for (int j = 0; j < 4; ++j) { const int col = 4 * lane + 256 * j;
        const f32x4 sh = *(const f32x4*)(shift + col), sc = *(const f32x4*)(scale + col);
        *(unsigned*)(hrow + col) = pk4_fp8((v[j].x * (1.f + sc.x) + sh.x) * H8_SCALE, (v[j].y * (1.f + sc.y) + sh.y) * H8_SCALE, (v[j].z * (1.f + sc.z) + sh.z) * H8_SCALE, (v[j].w * (1.f + sc.w) + sh.w) * H8_SCALE); }
}

__device__ __forceinline__ void phase_prologue_b(const Params& P, int tid, int bid, int nb) {
    const int lane = tid & 63, wave = tid >> 6; unsigned char* ws = P.ws;
    const float* mods = (const float*)(ws + WS_MODS);
    for (int m = bid * NWAVES + wave; m < M; m += nb * NWAVES) {
        const float* src = (m < ML) ? P.in[0] + (size_t)m * D : P.in[2] + (size_t)(m - ML) * D;
        const int mb = (m < ML) ? (m >> 12) : 8;
        f32x4 v[4];
#pragma unroll
        for (int j = 0; j < 4; ++j) v[j] = *(const f32x4*)(src + 4 * lane + 256 * j);
        const float* md = mods + (size_t)(0 * 9 + mb) * 6144;
        store_h_row((unsigned char*)(ws + WS_H) + (size_t)m * D, v, md + 0, md + 1024, lane);
    }
}


namespace g8 {
constexpr int BM = 256, BK = 64, HALF = 128, HTB = HALF * BK * 2, STAGE_BYTES = 8 * HTB, NXCD = 8, WGM = 8, KDIM = 1024, NT = KDIM / BK;
__device__ __forceinline__ int lds_byte(int r, int c) { const int st = (r >> 4) * 2 + (c >> 5), rr = r & 15, cc = c & 31, ob = rr * 64 + cc * 2; return st * 1024 + (ob ^ (((ob >> 9) & 1) << 5)); }
__device__ __forceinline__ void stage_rc(int b, int& R, int& C) { const int st = b / 1024, sb = b % 1024, swz = sb ^ (((sb >> 9) & 1) << 5); R = (st >> 1) * 16 + swz / 64; C = (st & 1) * 32 + (swz % 64) / 2; }
template <bool FP8> __device__ __forceinline__ void stage_rcb(int b, int& R, int& CB) { const int st = b / 1024, sb = b % 1024, swz = sb ^ (((sb >> 9) & 1) << 5); R = (st >> 1) * 16 + swz / 64;
    CB = FP8 ? (2 * ((swz % 64) >> 4) + (st & 1)) * 16 : (st & 1) * 64 + (swz % 64); }
__device__ __forceinline__ int perm32(int rho) { const int n = rho >> 4, i = rho & 15; return 8 * (i >> 2) + 4 * n + (i & 3); }

struct Unit { int pm, pn, ui, e, nvalid; unsigned slot0; };
typedef int i32x8 __attribute__((ext_vector_type(8)));
typedef int i32x4 __attribute__((ext_vector_type(4)));
__device__ __forceinline__ i32x8 cat8(bf16x8 lo, bf16x8 hi) { const u32x4 a = __builtin_bit_cast(u32x4, lo), c = __builtin_bit_cast(u32x4, hi); return (i32x8){(int)a.x, (int)a.y, (int)a.z, (int)a.w, (int)c.x, (int)c.y, (int)c.z, (int)c.w}; }

template <class Prob, class Epi>
__device__ __forceinline__ void gemm_phase(LAS unsigned char* lds, const Prob& S, const Epi& E, int tid) {
    const int wid = __builtin_amdgcn_readfirstlane(tid >> 6), wr = wid >> 2, wc = wid & 3;
    constexpr int ROWB = Prob::FP8 ? KDIM : KDIM * 2;
    constexpr int NTK = Prob::FP8 ? NT / 2 : NT;
    unsigned voffB; { int R0, CB; stage_rcb<Prob::FP8>(tid * 16, R0, CB); const int Rb = Epi::PERM ? ((R0 & ~31) + perm32(R0 & 31)) : R0; voffB = (unsigned)(Rb * ROWB + CB); }
    constexpr size_t kstep = (size_t)(BK * 2);
    constexpr size_t hstep = (size_t)HALF * ROWB;
    constexpr size_t pstep = (size_t)64 * ROWB;
    const unsigned ldsw = (unsigned)wid * 1024u;
    int aoff, boff; { const int fr = tid & 15, fq = (tid >> 4) & 3; aoff = lds_byte(wr * 64 + fr, fq * 8); boff = lds_byte(wc * 32 + fr, fq * 8); }
#define PG8_SA(b, h) (((b) * 2 + (h)) * HTB)
#define PG8_SB(b, h) ((4 + (b) * 2 + (h)) * HTB)
#define PG8_GLDS2(sbase, voff, ldsoff) do { const char* _sb = (const char*)(sbase); asm volatile("" : "+s"(_sb)); unsigned _vo = (voff); asm volatile("" : "+v"(_vo)); __builtin_amdgcn_global_load_lds((const unsigned*)(_sb + _vo), (LAS unsigned*)(lds + (ldsoff)), 16, 0, 0); } while (0)
#define PG8_STAGE_B(bufoff, gbase) do { PG8_GLDS2((const char*)(gbase), voffB, (bufoff) + ldsw); PG8_GLDS2((const char*)(gbase) + pstep, voffB, (bufoff) + ldsw + 8192); } while (0)
#define PG8_STAGE_A(bufoff, gbase, h) do { if (Prob::GATHER) { PG8_GLDS2((const char*)(gbase), vA[h][0], (bufoff) + ldsw); PG8_GLDS2((const char*)(gbase), vA[h][1], (bufoff) + ldsw + 8192); } \
        else { PG8_GLDS2((const char*)(gbase) + (h) * hstep, vA[0][0], (bufoff) + ldsw); PG8_GLDS2((const char*)(gbase) + (h) * hstep + pstep, vA[0][0], (bufoff) + ldsw + 8192); } } while (0)
#define PG8_LDA(dst, b, h) do { _Pragma("unroll") for (int m = 0; m < 4; ++m) _Pragma("unroll") for (int k = 0; k < 2; ++k) dst[m][k] = *(const LAS bf16x8*)(lds + PG8_SA(b, h) + aoff + m * 2048 + k * 1024); } while (0)
#define PG8_LDB(dst, b, h) do { _Pragma("unroll") for (int n = 0; n < 2; ++n) _Pragma("unroll") for (int k = 0; k < 2; ++k) dst[n][k] = *(const LAS bf16x8*)(lds + PG8_SB(b, h) + boff + n * 2048 + k * 1024); } while (0)
#define PG8_MMA(ai, bj, At, Bt) do { __builtin_amdgcn_s_setprio(1); _Pragma("unroll") for (int m = 0; m < 4; ++m) _Pragma("unroll") for (int n = 0; n < 2; ++n) { \
        if constexpr (Prob::FP8) acc[ai][bj][m][n] = __builtin_amdgcn_mfma_scale_f32_16x16x128_f8f6f4(cat8(Bt[n][0], Bt[n][1]), cat8(At[m][0], At[m][1]), acc[ai][bj][m][n], 0, 0, 0, Prob::SCALE_B, 0, Prob::SCALE_A); \
        else { _Pragma("unroll") for (int k = 0; k < 2; ++k) acc[ai][bj][m][n] = __builtin_amdgcn_mfma_f32_16x16x32_bf16(Bt[n][k], At[m][k], acc[ai][bj][m][n], 0, 0, 0); } } __builtin_amdgcn_s_setprio(0); } while (0)
#define PG8_WAIT_V(n) asm volatile("s_waitcnt vmcnt(" #n ")" ::: "memory")
#define PG8_WAIT_L(n) asm volatile("s_waitcnt lgkmcnt(" #n ")" ::: "memory")
#define PG8_BAR __builtin_amdgcn_s_barrier()
#define PG8_SCHED __builtin_amdgcn_sched_barrier(0)
    Unit cur, nxt; int ui = 0;
    if (!S.next(0, cur)) return;
    f32x4 acc[2][2][4][2];
#pragma unroll
    for (int a = 0; a < 2; ++a)
#pragma unroll
        for (int b = 0; b < 2; ++b)
#pragma unroll
            for (int m = 0; m < 4; ++m)
#pragma unroll
                for (int n = 0; n < 2; ++n) acc[a][b][m][n] = (f32x4){0.f, 0.f, 0.f, 0.f};
    bf16x8 At[4][2], B0[2][2], B1[2][2];
    const char* cA = S.a_base(cur); const char* cB = S.b_base(cur);
    unsigned vA[2][2];
    S.a_voff(cur, tid, vA);
    PG8_STAGE_B(PG8_SB(0, 0), cB); PG8_STAGE_B(PG8_SB(0, 1), cB + hstep); PG8_STAGE_A(PG8_SA(0, 0), cA, 0); PG8_STAGE_A(PG8_SA(0, 1), cA, 1);
    if (wr == 1) PG8_BAR;
    PG8_WAIT_V(2); PG8_BAR;
    PG8_STAGE_B(PG8_SB(1, 0), cB + kstep); PG8_STAGE_A(PG8_SA(1, 0), cA + kstep, 0); PG8_STAGE_B(PG8_SB(1, 1), cB + hstep + kstep);
    PG8_WAIT_V(6); PG8_BAR;
    for (;;) {
        const bool has_next = S.next(ui + 1, nxt);
        const char* nA = cA; const char* nB = cB;
        unsigned vN[2];
        if (has_next) { nA = S.a_base(nxt); nB = S.b_base(nxt); if (Prob::GATHER) S.a_tok(nxt, tid, vN); }
#pragma unroll 1
        for (int t = 0; t < NTK; t += 2) {
            const bool last = (t == NTK - 2);
            const char* a1 = cA + (size_t)(t + 1) * kstep;
            const char* a2 = last ? nA : cA + (size_t)(t + 2) * kstep; const char* b2 = last ? nB : cB + (size_t)(t + 2) * kstep;
            const char* a3 = a2 + kstep; const char* b3 = b2 + kstep;
            PG8_LDB(B0, 0, 0); PG8_LDB(B1, 0, 1); PG8_SCHED; PG8_LDA(At, 0, 0); PG8_STAGE_A(PG8_SA(1, 1), a1, 1);
            PG8_WAIT_V(8); PG8_WAIT_L(0); PG8_BAR; PG8_MMA(0, 0, At, B0); PG8_MMA(0, 1, At, B1); PG8_BAR; PG8_SCHED;
            if (Prob::GATHER) { if (last && has_next) { int R0, CB; stage_rcb<Prob::FP8>(tid * 16, R0, CB); const unsigned c2 = (unsigned)CB; constexpr int SH = Prob::FP8 ? 10 : 11; vA[0][0] = ((vN[0] & 0xffffu) << SH) | c2; vA[0][1] = ((vN[0] >> 16) << SH) | c2; vA[1][0] = ((vN[1] & 0xffffu) << SH) | c2; vA[1][1] = ((vN[1] >> 16) << SH) | c2; } }
            PG8_LDA(At, 0, 1); PG8_STAGE_B(PG8_SB(0, 0), b2); PG8_STAGE_B(PG8_SB(0, 1), b2 + hstep); PG8_STAGE_A(PG8_SA(0, 0), a2, 0);
            PG8_WAIT_V(8); PG8_WAIT_L(0); PG8_BAR; PG8_MMA(1, 0, At, B0); PG8_MMA(1, 1, At, B1); PG8_BAR; PG8_SCHED;
            PG8_LDB(B0, 1, 0); PG8_LDB(B1, 1, 1); PG8_SCHED; PG8_LDA(At, 1, 0); PG8_STAGE_A(PG8_SA(0, 1), a2, 1);
            PG8_WAIT_V(8); PG8_WAIT_L(0); PG8_BAR; PG8_MMA(0, 0, At, B0); PG8_MMA(0, 1, At, B1); PG8_BAR; PG8_SCHED;
            PG8_LDA(At, 1, 1); PG8_STAGE_B(PG8_SB(1, 0), b3); PG8_STAGE_B(PG8_SB(1, 1), b3 + hstep); PG8_STAGE_A(PG8_SA(1, 0), a3, 0);
            PG8_WAIT_V(8); PG8_WAIT_L(0); PG8_BAR; PG8_MMA(1, 0, At, B0); PG8_MMA(1, 1, At, B1); PG8_BAR; PG8_SCHED;
        }
        if (wr == 0) PG8_BAR;
        { int t_e = tid; asm volatile("" : "+v"(t_e)); int fr_e = t_e & 15, fq_e = (t_e >> 4) & 3;
          E(acc, cur, wr, wc, fr_e, fq_e); }
        if (!has_next) break;
#pragma unroll
        for (int a = 0; a < 2; ++a)
#pragma unroll
            for (int b = 0; b < 2; ++b)
#pragma unroll
                for (int m = 0; m < 4; ++m)
#pragma unroll
                    for (int n = 0; n < 2; ++n) acc[a][b][m][n] = (f32x4){0.f, 0.f, 0.f, 0.f};
        cur = nxt; cA = nA; cB = nB; ++ui;
        if (wr == 1) PG8_BAR;
    }
    PG8_WAIT_V(0);
    PG8_BAR;
#undef PG8_SA
#undef PG8_SB
#undef PG8_GLDS2
#undef PG8_STAGE_A
#undef PG8_STAGE_B
#undef PG8_LDA
#undef PG8_LDB
#undef PG8_MMA
#undef PG8_WAIT_V
#undef PG8_WAIT_L
#undef PG8_BAR
#undef PG8_SCHED
}

template <bool F8>
struct DenseProb {
    const void* A; const void* Bt; int nM, nN, nwg, G, c;
    __device__ __forceinline__ void init(const void* A_, const void* Bt_, int Mrows, int Npad, int G_, int c_) { A = A_; Bt = Bt_; nM = Mrows / BM; nN = Npad / BM; nwg = nM * nN; G = G_; c = c_; }
    __device__ __forceinline__ bool next(int i, Unit& u) const {
        const long L = (long)i * G + c; if (L >= nwg) return false;
        int wgid = (int)L; { const int q = nwg / NXCD, r = nwg % NXCD, xcd = wgid % NXCD, off = wgid / NXCD; wgid = (xcd < r ? xcd * (q + 1) : r * (q + 1) + (xcd - r) * q) + off; }
        const int nig = WGM * nN, gid = wgid / nig, fm = gid * WGM, gsz = (nM - fm) < WGM ? (nM - fm) : WGM;
        u.pm = fm + ((wgid % nig) % gsz); u.pn = (wgid % nig) / gsz; u.ui = i; u.e = 0; u.nvalid = 256; u.slot0 = 0; return true;
    }
    static constexpr int RB_ = F8 ? KDIM : KDIM * 2;
    __device__ __forceinline__ const char* a_base(const Unit& u) const { return (const char*)A + (size_t)u.pm * BM * RB_; }
    __device__ __forceinline__ const char* b_base(const Unit& u) const { return (const char*)Bt + (size_t)u.pn * BM * RB_; }
    static constexpr bool GATHER = false, FP8 = F8; static constexpr int SCALE_A = H8_E8, SCALE_B = W1_E8;
    __device__ __forceinline__ void a_voff(const Unit&, int tid, unsigned (&v)[2][2]) const { int R0, CB; stage_rcb<F8>(tid * 16, R0, CB); v[0][0] = (unsigned)(R0 * RB_ + CB); }
    __device__ __forceinline__ void a_tok(const Unit&, int, unsigned (&)[2]) const {}
};

constexpr int MOE_IDX = STAGE_BYTES;
constexpr int MOE_MAXU = 40;
constexpr int MOE_TAB = MOE_IDX + MOE_MAXU * 512;
constexpr int TB_XN = 130, TB_XE = 138, TB_XUP = 394;
constexpr int MOE_UT = MOE_TAB + 2688;
template <int WHICH>
struct MoeProb {
    const unsigned char* A; const unsigned char* Wt; LAS unsigned char* lds; int nunits, G, c, xy; int same;
    static constexpr int nN = (WHICH == 1) ? 8 : 4;
    static constexpr bool FP8 = true; static constexpr int SCALE_A = (WHICH == 1) ? H8_E8 : ACT8_E8, SCALE_B = (WHICH == 1) ? W1_E8 : W2_E8;
    __device__ __forceinline__ void fill_units(int tid) const {
        if (tid < MOE_MAXU) { const LAS int* tab = (const LAS int*)(lds + MOE_TAB); int L = tid * G + c;
            if (xy >= 0) { const int x = xy & 7, y = xy >> 3, q = nunits >> 3, rr = nunits & 7, len = q + (x < rr ? 1 : 0), li = tid * (G >> 3) + y; L = (li < len) ? x * q + min(x, rr) + li : nunits; }
            i32x4 r = {-1, 0, 0, 0};
            if (L < nunits) { const int tt = L / nN, pn = L % nN; int e = 0;
                for (int q = 1; q < 32; ++q) e = (tab[32 + q] <= tt) ? q : e;
                const int tl = tt - tab[32 + e], cnt = tab[e];
                r = (i32x4){e | (pn << 8), tl, min(cnt - tl * 256, 256), tab[96 + e] + tl * 256}; }
            ((LAS i32x4*)(lds + MOE_UT))[tid] = r; }
    }
    __device__ __forceinline__ bool next(int i, Unit& u) const {
        if (i >= MOE_MAXU) return false;
        const i32x4 r = ((const LAS i32x4*)(lds + MOE_UT))[i];
        const int w0 = __builtin_amdgcn_readfirstlane(r.x); if (w0 < 0) return false;
        u.e = w0 & 255; u.pn = w0 >> 8; u.ui = i; u.pm = __builtin_amdgcn_readfirstlane(r.y); u.nvalid = __builtin_amdgcn_readfirstlane(r.z); u.slot0 = (unsigned)__builtin_amdgcn_readfirstlane(r.w); return true;
    }
    __device__ __forceinline__ const char* a_base(const Unit& u) const { return (WHICH == 1) ? (const char*)A : (const char*)A + (size_t)u.slot0 * KDIM; }
    __device__ __forceinline__ const char* b_base(const Unit& u) const { return same ? (const char*)Wt : (const char*)Wt + ((size_t)u.e * (nN * 256) + (size_t)u.pn * 256) * KDIM; }
    static constexpr bool GATHER = (WHICH == 1);
    __device__ __forceinline__ void a_voff(const Unit& u, int tid, unsigned (&v)[2][2]) const {
        int R0, CB; stage_rcb<true>(tid * 16, R0, CB);
        if (WHICH == 1) { const LAS unsigned short* idx = (const LAS unsigned short*)(lds + MOE_IDX) + u.ui * 256;
#pragma unroll
            for (int h = 0; h < 2; ++h)
#pragma unroll
                for (int i = 0; i < 2; ++i) v[h][i] = (unsigned)(idx[h * HALF + i * 64 + R0] * KDIM + CB);
        } else v[0][0] = (unsigned)(R0 * KDIM + CB);
    }
    __device__ __forceinline__ void a_tok(const Unit& u, int tid, unsigned (&v)[2]) const {
        if (WHICH == 1) { int R0, CB; stage_rcb<true>(tid * 16, R0, CB); const LAS unsigned short* idx = (const LAS unsigned short*)(lds + MOE_IDX) + u.ui * 256;
            v[0] = (unsigned)idx[R0] | ((unsigned)idx[64 + R0] << 16); v[1] = (unsigned)idx[HALF + R0] | ((unsigned)idx[HALF + 64 + R0] << 16); }
    }
};

struct EpiP {
    static constexpr bool PERM = true;
    bf16* out; int ncols; bf16* vt;
    __device__ __forceinline__ void operator()(const f32x4 (&acc)[2][2][4][2], const Unit& u, int wr, int wc, int fr, int fq) const {
        if (vt != nullptr && ncols == GLA_IN && u.pn >= 4 && u.pn < 8) {
            const int row0 = u.pm * BM;
#pragma unroll
            for (int bj = 0; bj < 2; ++bj) { const int e0 = u.pn * BM + bj * HALF + wc * 32 + 8 * fq - 1024;
#pragma unroll
                for (int ai = 0; ai < 2; ++ai)
#pragma unroll
                    for (int m = 0; m < 4; ++m) { const int rl = ai * HALF + wr * 64 + m * 16 + fr; const int c = (row0 + rl) >> 6, i = rl & 63;
                        bf16* p = vt + ((size_t)c * 1024 + e0) * 72 + i;
#pragma unroll
                        for (int n = 0; n < 2; ++n) { const unsigned w0 = pk2(acc[ai][bj][m][n][0], acc[ai][bj][m][n][1]), w1 = pk2(acc[ai][bj][m][n][2], acc[ai][bj][m][n][3]);
                            p[(4 * n + 0) * 72] = (bf16)(w0 & 0xffffu); p[(4 * n + 1) * 72] = (bf16)(w0 >> 16); p[(4 * n + 2) * 72] = (bf16)(w1 & 0xffffu); p[(4 * n + 3) * 72] = (bf16)(w1 >> 16); } } }
            return;
        }
        if (vt != nullptr && ncols == AB_IN && u.pn >= 7) {
            const int row0 = u.pm * BM;
            bf16* base; int tl, tok0;
            if (row0 < ML) { base = vt + (size_t)(row0 >> 12) * 12 * 64 * T; tl = T; tok0 = row0 & (T - 1); }
            else { base = vt + (size_t)(WS_VTC - WS_VT) / 2 + (size_t)((row0 - ML) >> 8) * 12 * 64 * NCTX; tl = NCTX; tok0 = 0; }
#pragma unroll
            for (int bj = 0; bj < 2; ++bj) { const int c = u.pn * BM + bj * HALF + wc * 32 + 8 * fq - 1792;
                bf16* cb = base + (size_t)c * tl + tok0 + wr * 64 + fr;
#pragma unroll
                for (int ai = 0; ai < 2; ++ai)
#pragma unroll
                    for (int m = 0; m < 4; ++m) { bf16* p = cb + ai * HALF + m * 16;
#pragma unroll
                        for (int n = 0; n < 2; ++n) { const unsigned w0 = pk2(acc[ai][bj][m][n][0], acc[ai][bj][m][n][1]), w1 = pk2(acc[ai][bj][m][n][2], acc[ai][bj][m][n][3]);
                            p[(size_t)(4 * n + 0) * tl] = (bf16)(w0 & 0xffffu); p[(size_t)(4 * n + 1) * tl] = (bf16)(w0 >> 16); p[(size_t)(4 * n + 2) * tl] = (bf16)(w1 & 0xffffu); p[(size_t)(4 * n + 3) * tl] = (bf16)(w1 >> 16); } } }
            return;
        }
#pragma unroll
        for (int ai = 0; ai < 2; ++ai)
#pragma unroll
            for (int m = 0; m < 4; ++m) { const size_t row = (size_t)u.pm * BM + ai * HALF + wr * 64 + m * 16 + fr;
#pragma unroll
                for (int bj = 0; bj < 2; ++bj) { const int col = u.pn * BM + bj * HALF + wc * 32 + 8 * fq;
                    if (col < ncols) { const f32x4 v0 = acc[ai][bj][m][0], v1 = acc[ai][bj][m][1];
                        u32x4 w; w.x = pk2(v0[0], v0[1]); w.y = pk2(v0[2], v0[3]); w.z = pk2(v1[0], v1[1]); w.w = pk2(v1[2], v1[3]);
                        *(u32x4*)(out + row * ncols + col) = w; } } }
    }
};
struct EpiResid {
    static constexpr bool PERM = false;
    float* X; const float* gate_base;
    __device__ __forceinline__ void operator()(const f32x4 (&acc)[2][2][4][2], const Unit& u, int wr, int wc, int fr, int fq) const {
#pragma unroll
        for (int ai = 0; ai < 2; ++ai)
#pragma unroll
            for (int m = 0; m < 4; ++m) { const size_t row = (size_t)u.pm * BM + ai * HALF + wr * 64 + m * 16 + fr; const int mb = (row < (size_t)ML) ? (int)(row >> 12) : 8;
#pragma unroll
                for (int bj = 0; bj < 2; ++bj)
#pragma unroll
                    for (int n = 0; n < 2; ++n) { const int col = u.pn * BM + bj * HALF + wc * 32 + n * 16 + 4 * fq;
                        const f32x4 g = *(const f32x4*)(gate_base + (size_t)mb * 6144 + col); float* xp = X + row * D + col; const f32x4 x = *(const f32x4*)xp;
                        *(f32x4*)xp = x * DN_ALPHA + g * acc[ai][bj][m][n]; } }
    }
};
struct EpiSwiglu {
    static constexpr bool PERM = true;
    unsigned char* act; const float* b1_base; int dbg;
    __device__ __forceinline__ void operator()(const f32x4 (&acc)[2][2][4][2], const Unit& u, int wr, int wc, int fr, int fq) const {
        if (dbg & 2) return;
        const float* b1 = b1_base + (size_t)u.e * 2048; const int gcol = u.pn * HALF + wc * 32 + 8 * fq;
        f32x4 bg[2], bl[2];
#pragma unroll
        for (int n = 0; n < 2; ++n) { if (dbg & 8) { bg[n] = (f32x4){0.f, 0.f, 0.f, 0.f}; bl[n] = bg[n]; } else { bg[n] = *(const f32x4*)(b1 + gcol + 4 * n); bl[n] = *(const f32x4*)(b1 + 1024 + gcol + 4 * n); } }
        __builtin_amdgcn_s_waitcnt(0x0F70);
#pragma unroll
        for (int ai = 0; ai < 2; ++ai)
#pragma unroll
            for (int m = 0; m < 4; ++m) { const int rl = ai * HALF + wr * 64 + m * 16 + fr;
                if (rl < u.nvalid) { float o[8];
#pragma unroll
                    for (int n = 0; n < 2; ++n)
#pragma unroll
                        for (int jp = 0; jp < 2; ++jp) {
                            f32x2 g = (f32x2){acc[ai][0][m][n][2 * jp], acc[ai][0][m][n][2 * jp + 1]} + (f32x2){bg[n][2 * jp], bg[n][2 * jp + 1]};
                            f32x2 l = (f32x2){acc[ai][1][m][n][2 * jp], acc[ai][1][m][n][2 * jp + 1]} + (f32x2){bl[n][2 * jp], bl[n][2 * jp + 1]};
                            if (dbg & 1) { o[4 * n + 2 * jp] = g.x + l.x; o[4 * n + 2 * jp + 1] = g.y + l.y; } else {
                                g.x = fminf(g.x, 7.0f); g.y = fminf(g.y, 7.0f); l.x = fminf(fmaxf(l.x, -7.0f), 7.0f); l.y = fminf(fmaxf(l.y, -7.0f), 7.0f);
                                const f32x2 t = g * (f32x2){-1.702f * 1.44269504f, -1.702f * 1.44269504f};
                                const f32x2 a = (f32x2){__builtin_amdgcn_exp2f(t.x), __builtin_amdgcn_exp2f(t.y)} + (f32x2){1.f, 1.f};
                                const f32x2 sg = g * (f32x2){__builtin_amdgcn_rcpf(a.x), __builtin_amdgcn_rcpf(a.y)};
                                const f32x2 ov = sg * (l * (f32x2){ACT8_SCALE, ACT8_SCALE} + (f32x2){ACT8_SCALE, ACT8_SCALE});
                                o[4 * n + 2 * jp] = ov.x; o[4 * n + 2 * jp + 1] = ov.y; } }
                    u32x2 w; w.x = pk4_fp8_nc(o[0], o[1], o[2], o[3]); w.y = pk4_fp8_nc(o[4], o[5], o[6], o[7]);
                    if (!(dbg & 4) || w.x == 0x12345u) *(u32x2*)(act + ((size_t)u.slot0 + rl) * 1024 + gcol) = w; }
                __builtin_amdgcn_sched_barrier(0); }
    }
};
struct EpiYs {
    static constexpr bool PERM = true;
    bf16* ys; const float* b2_base;
    __device__ __forceinline__ void operator()(const f32x4 (&acc)[2][2][4][2], const Unit& u, int wr, int wc, int fr, int fq) const {
        const float* b2 = b2_base + (size_t)u.e * 1024;
        f32x4 bb[2][2];
#pragma unroll
        for (int bj = 0; bj < 2; ++bj)
#pragma unroll
            for (int n = 0; n < 2; ++n) bb[bj][n] = *(const f32x4*)(b2 + u.pn * BM + bj * HALF + wc * 32 + 8 * fq + 4 * n);
        __builtin_amdgcn_s_waitcnt(0x0F70);
#pragma unroll
        for (int ai = 0; ai < 2; ++ai)
#pragma unroll
            for (int m = 0; m < 4; ++m) { const int rl = ai * HALF + wr * 64 + m * 16 + fr;
                if (rl < u.nvalid) {
#pragma unroll
                    for (int bj = 0; bj < 2; ++bj) { const int col = u.pn * BM + bj * HALF + wc * 32 + 8 * fq;
                        const f32x4 v0 = acc[ai][bj][m][0] + bb[bj][0], v1 = acc[ai][bj][m][1] + bb[bj][1];
                        u32x4 w; w.x = pk2(v0[0], v0[1]); w.y = pk2(v0[2], v0[3]); w.z = pk2(v1[0], v1[1]); w.w = pk2(v1[2], v1[3]);
                        *(u32x4*)(ys + ((size_t)u.slot0 + rl) * 1024 + col) = w; } } }
    }
};
}

template <int KIND>
__device__ __forceinline__ void phase_gemm_dense(const Params& P, LAS unsigned char* lds, int tid, int bid, int nb, const void* A, const void* Wt, int Mrows, int N, int layer) {
    unsigned char* ws = P.ws;
    if (KIND == 0) { g8::DenseProb<true> S; S.init(A, Wt, Mrows, (N + 255) & ~255, nb, bid);
        g8::EpiP e{(bf16*)(ws + WS_P), N, (N == AB_IN) ? (bf16*)(ws + WS_VT) : (bf16*)(ws + WS_GVT)}; g8::gemm_phase(lds, S, e, tid); }
    else { g8::DenseProb<false> S; S.init(A, Wt, Mrows, (N + 255) & ~255, nb, bid);
        g8::EpiP e{(bf16*)(ws + WS_P), 1024, (bf16*)nullptr}; g8::gemm_phase(lds, S, e, tid); }
}

template <int NN>
__device__ __forceinline__ void moe_tables(const Params& P, LAS unsigned char* lds, int tid, int layer) {
    LAS int* tab = (LAS int*)(lds + g8::MOE_TAB);
    __syncthreads();
    if (tid < 32) tab[tid] = (int)__hip_atomic_load((const unsigned*)(P.ws + WS_CTL) + CW_CNT + layer * 32 + tid, __ATOMIC_RELAXED, __HIP_MEMORY_SCOPE_AGENT);
    __syncthreads();
    if (tid == 0) { int tp = 0, rb = 0;
        for (int e = 0; e < 32; ++e) { const int c = tab[e]; tab[32 + e] = tp; tab[96 + e] = rb; tp += (c + 255) >> 8; rb += c; }
        tab[32 + 32] = tp; tab[96 + 32] = rb;
        if (NN > 0) {
            int load[8]; unsigned taken = 0u;
            for (int x = 0; x < 8; ++x) { load[x] = 0; tab[g8::TB_XN + x] = 0; tab[g8::TB_XUP + x * 33] = 0; }
            for (int it = 0; it < 32; ++it) { int be = -1, bt = -1;
                for (int e = 0; e < 32; ++e) { const int t = (tab[e] + 255) >> 8; if (!((taken >> e) & 1u) && t > bt) { bt = t; be = e; } }
                taken |= 1u << be;
                int bx = 0; for (int x = 1; x < 8; ++x) if (load[x] < load[bx]) bx = x;
                const int n = tab[g8::TB_XN + bx]; tab[g8::TB_XE + bx * 32 + n] = be; tab[g8::TB_XUP + bx * 33 + n + 1] = tab[g8::TB_XUP + bx * 33 + n] + bt * NN; tab[g8::TB_XN + bx] = n + 1; load[bx] += bt; } } }
    __syncthreads();
}
template <int WHICH>
__device__ __forceinline__ void phase_moe_gemm(const Params& P, LAS unsigned char* lds, int tid, int bid, int nb, int layer, int dbg = 0) {
    unsigned char* ws = P.ws;
    moe_tables<0>(P, lds, tid, layer);
    const LAS int* tab = (const LAS int*)(lds + g8::MOE_TAB);
    g8::MoeProb<WHICH> S; S.lds = lds; S.G = nb; S.c = bid; S.xy = ((nb & 7) == 0) ? bid : -1;        S.same = (dbg & 16) ? 1 : 0; S.nunits = __builtin_amdgcn_readfirstlane(tab[64]) * g8::MoeProb<WHICH>::nN;
    S.fill_units(tid); __syncthreads();
    if (WHICH == 1) {
        S.A = (const unsigned char*)(ws + WS_H8); S.Wt = (const unsigned char*)(ws + WS_W1T) + (size_t)layer * 32 * 2048 * 1024;
        const int* list = (const int*)(ws + WS_LIST); LAS unsigned short* idx = (LAS unsigned short*)(lds + g8::MOE_IDX);
        { const LAS g8::i32x4* ut = (const LAS g8::i32x4*)(lds + g8::MOE_UT);
#pragma unroll 4
          for (int ent = tid; ent < g8::MOE_MAXU * 256; ent += NTHREADS) { const int i = ent >> 8, r = ent & 255; const g8::i32x4 q = ut[i];
              if (q.x >= 0) idx[ent] = (unsigned short)((r < q.z) ? list[(size_t)(q.x & 255) * M + q.y * 256 + r] : 0); } }
        __syncthreads();
        g8::EpiSwiglu e{(unsigned char*)(ws + WS_ACT), P.in[21] + (size_t)layer * 32 * 2048, dbg};
        g8::gemm_phase(lds, S, e, tid);
    } else {
        S.A = (const unsigned char*)(ws + WS_ACT); S.Wt = (const unsigned char*)(ws + WS_W2T) + (size_t)layer * 32 * 1024 * 1024;
        g8::EpiYs e{(bf16*)(ws + WS_YS), P.in[23] + (size_t)layer * 32 * 1024};
        g8::gemm_phase(lds, S, e, tid);
    }
}

constexpr int NA_RPB_OFF = 102400;
constexpr int NA_KC_OFF = 0, NA_VC_OFF = 32768, NA_VC_PITCH = 544, NA_KW_OFF = 67584, NA_KW_PITCH = 144, NA_KW_ROW = 64 * 144, NA_RPB2 = NA_KW_OFF + 9 * NA_KW_ROW;
template <bool ISCTX, bool CTXLDS>
__device__ __forceinline__ void na_wave_unit(const Params& P, LAS unsigned char* lds, int v, int lane) {
    const bf16* PB = (const bf16*)(P.ws + WS_P);
    bf16* A2 = (bf16*)(P.ws + WS_A2);
    const int fr = lane & 15, fq = lane >> 4;
    int b, h, r = 0, jb = 0; size_t mq0;
    if (!ISCTX) { jb = v & 3; r = (v >> 2) & 63; h = (v >> 8) % 12; b = v / (256 * 12); mq0 = (size_t)b * T + r * 64 + jb * 16; }
    else { const int qb = v & 15; h = (v >> 4) % 12; b = v / (16 * 12); mq0 = (size_t)ML + b * NCTX + qb * 16; }
    const int row_start = min(max(r - 4, 0), 56);
    const int band_start = min(max(jb * 16 - 8, 0), 32);
    const int kap = 8 * (fr >> 2) + (fr & 3);
    const bf16* kwin = PB + ((size_t)b * T + (size_t)row_start * 64 + band_start + kap) * AB_IN + 1024 + h * 64 + fq * 8;
    const bf16* kctx = PB + ((size_t)ML + (size_t)b * NCTX + kap) * AB_IN + 1024 + h * 64 + fq * 8;
    const bf16* vtl = (const bf16*)(P.ws + WS_VT) + ((size_t)(b * 12 + h) * 64 + fr) * T + (size_t)row_start * 64 + band_start + 8 * fq;
    const bf16* vtc = (const bf16*)(P.ws + WS_VTC) + ((size_t)(b * 12 + h) * 64 + fr) * NCTX + 8 * fq;
    const bf16* qp = PB + (mq0 + fr) * AB_IN + 256 + h * 64 + fq * 8;
    const bf16x8 qf0 = *(const bf16x8*)qp, qf1 = *(const bf16x8*)(qp + 32);
    const f32x4 zero4 = {0.f, 0.f, 0.f, 0.f};
    const LAS float* rpb = CTXLDS ? (const LAS float*)(lds + NA_RPB2) : (const LAS float*)(lds + NA_RPB_OFF) + h * 15 * 31;
    const int qcol = jb * 16 + fr, wstart = min(max(qcol - 8, 0), 48);
    constexpr int C0 = ISCTX ? 4 : 0;
    bf16x8 kf[4][2], vf[2][4];
#define NA_LOAD_KV(c) do { _Pragma("unroll") for (int s_ = 0; s_ < 2; ++s_) { _Pragma("unroll") for (int hh = 0; hh < 2; ++hh) { \
        if (CTXLDS && (c) >= 4) { const int key_ = (2 * ((c) - 4) + s_) * 32 + 4 * hh + kap; const LAS unsigned char* kl_ = lds + NA_KC_OFF + key_ * 128; \
            kf[2 * s_ + hh][0] = *(const LAS bf16x8*)(kl_ + ((fq ^ (key_ & 7)) << 4)); kf[2 * s_ + hh][1] = *(const LAS bf16x8*)(kl_ + (((4 + fq) ^ (key_ & 7)) << 4)); } \
        else if (CTXLDS) { const LAS unsigned char* kl_ = lds + NA_KW_OFF + ((row_start + 2 * (c) + s_) % 9) * NA_KW_ROW + (band_start + 4 * hh + kap) * NA_KW_PITCH + fq * 16; \
            kf[2 * s_ + hh][0] = *(const LAS bf16x8*)kl_; kf[2 * s_ + hh][1] = *(const LAS bf16x8*)(kl_ + 64); } \
        else { const bf16* kp_ = ((c) < 4) ? kwin + (size_t)((2 * (c) + s_) * 64 + 4 * hh) * AB_IN : kctx + (size_t)((2 * ((c) - 4) + s_) * 32 + 4 * hh) * AB_IN; \
            kf[2 * s_ + hh][0] = *(const bf16x8*)kp_; kf[2 * s_ + hh][1] = *(const bf16x8*)(kp_ + 32); } } \
        _Pragma("unroll") for (int dt = 0; dt < 4; ++dt) { \
            if (CTXLDS && (c) >= 4) vf[s_][dt] = *(const LAS bf16x8*)(lds + NA_VC_OFF + (dt * 16 + fr) * NA_VC_PITCH + ((2 * ((c) - 4) + s_) * 32 + 8 * fq) * 2); \
            else vf[s_][dt] = ((c) < 4) ? *(const bf16x8*)(vtl + (size_t)(dt * 16) * T + (2 * (c) + s_) * 64) : *(const bf16x8*)(vtc + (size_t)(dt * 16) * NCTX + (2 * ((c) - 4) + s_) * 32); } } } while (0)
    float mrun = -3.0e38f, lrun = 0.f;
    f32x4 o[4];
#pragma unroll
    for (int dt = 0; dt < 4; ++dt) o[dt] = zero4;
#pragma unroll
    for (int c = C0; c < 8; ++c) {
        NA_LOAD_KV(c);
        f32x4 s[4];
#pragma unroll
        for (int t = 0; t < 4; ++t) { f32x4 a = mfma16(kf[t][0], qf0, zero4); s[t] = mfma16(kf[t][1], qf1, a); }
        float mx = mrun;
        if (c < 4) {
#pragma unroll
            for (int t = 0; t < 4; ++t) { const int kr = 2 * c + (t >> 1), hh = t & 1; const int drow = row_start + kr - r + 7;
#pragma unroll
                for (int i = 0; i < 4; ++i) { const int kcol = band_start + 8 * fq + 4 * hh + i; const bool ok = (kcol >= wstart) && (kcol < wstart + 16);
                    const int dcol = min(max(kcol - qcol + 15, 0), 30);
                    const float lg = ok ? (s[t][i] * 0.125f + rpb[drow * 31 + dcol]) : -1.0e30f; s[t][i] = lg; mx = fmaxf(mx, lg); } }
        } else {
#pragma unroll
            for (int t = 0; t < 4; ++t)
#pragma unroll
                for (int i = 0; i < 4; ++i) { const float lg = s[t][i] * 0.125f; s[t][i] = lg; mx = fmaxf(mx, lg); }
        }
        mx = fmaxf(mx, __shfl_xor(mx, 16)); mx = fmaxf(mx, __shfl_xor(mx, 32));
        const float corr = __expf(mrun - mx); mrun = mx;
        float sum = 0.f;
#pragma unroll
        for (int t = 0; t < 4; ++t)
#pragma unroll
            for (int i = 0; i < 4; ++i) { const float p = __expf(s[t][i] - mx); s[t][i] = p; sum += p; }
        sum += __shfl_xor(sum, 16); sum += __shfl_xor(sum, 32);
        lrun = lrun * corr + sum;
#pragma unroll
        for (int dt = 0; dt < 4; ++dt) o[dt] = o[dt] * corr;
#pragma unroll
        for (int s_ = 0; s_ < 2; ++s_) { const int ta = 2 * s_, tb = 2 * s_ + 1;
            const bf16x8 pf = mk_frag(pk2(s[ta][0], s[ta][1]), pk2(s[ta][2], s[ta][3]), pk2(s[tb][0], s[tb][1]), pk2(s[tb][2], s[tb][3]));
#pragma unroll
            for (int dt = 0; dt < 4; ++dt) o[dt] = mfma16(vf[s_][dt], pf, o[dt]); }
    }
#undef NA_LOAD_KV
    const float inv = 1.0f / lrun;
#pragma unroll
    for (int dt = 0; dt < 4; ++dt) { u32x2 w; w.x = pk2(o[dt].x * inv, o[dt].y * inv); w.y = pk2(o[dt].z * inv, o[dt].w * inv);
        *(u32x2*)(A2 + (mq0 + fr) * D + 256 + h * 64 + dt * 16 + 4 * fq) = w; }
}

__device__ __forceinline__ void pool_units(const Params& P, LAS unsigned char* lds, int j_even, int tid, int bid, int nb) {
    const bf16* PB = (const bf16*)(P.ws + WS_P);
    bf16* A2 = (bf16*)(P.ws + WS_A2);
    const int lane = tid & 63, wave = tid >> 6, fr = lane & 15, fq = lane >> 4;
    LAS bf16* pwT = (LAS bf16*)lds;
    LAS bf16* pooled = (LAS bf16*)(lds + 36864);
    LAS bf16* U = (LAS bf16*)(lds + 128000);
    for (int idx = tid; idx < 4 * 64 * 64; idx += NTHREADS) { const int g = idx >> 12, d = (idx >> 6) & 63, e = idx & 63;
        pwT[(g * 64 + e) * 72 + d] = (bf16)f2bf(P.in[9][(size_t)j_even * 4 * 64 * 64 + idx]); }
    for (int u = bid; u < 1088; u += nb) {
        size_t seq0; int t0, TL;
        if (u < 1024) { const int b = u >> 7; t0 = (u & 127) * 32; seq0 = (size_t)b * T; TL = T; }
        else { const int q = u - 1024; const int b = q >> 3; t0 = (q & 7) * 32; seq0 = (size_t)ML + (size_t)b * NCTX; TL = NCTX; }
        __syncthreads();
        for (int c = tid; c < 48 * 32; c += NTHREADS) { const int rr = c >> 5, ck = c & 31; const int t = t0 - 8 + rr;
            if (t >= 0 && t < TL) *(LAS u32x4*)(U + rr * 256 + ck * 8) = *(const u32x4*)(PB + (seq0 + t) * AB_IN + ck * 8); }
        __syncthreads();
        for (int idx = tid; idx < 32 * 256; idx += NTHREADS) { const int ti = idx >> 8, ch = idx & 255, g = ch >> 6, w = 2 << g; const int t = t0 + ti;
            const int lo = max(t - w / 2, 0), hi = min(t - w / 2 + w, TL);
            float sum = 0.f;
            for (int sx = lo; sx < hi; ++sx) sum += bf2f(U[(sx - t0 + 8) * 256 + ch]);
            pooled[ti * 272 + ch] = (bf16)f2bf(sum / (float)(hi - lo) - bf2f(U[(ti + 8) * 256 + ch])); }
        __syncthreads();
        { const int g = wave >> 1, tt = wave & 1;
          const size_t mrow = seq0 + t0 + tt * 16 + fr;
#pragma unroll
          for (int et = 0; et < 4; ++et) { f32x4 a = {0.f, 0.f, 0.f, 0.f};
#pragma unroll
              for (int ks = 0; ks < 2; ++ks) { const bf16x8 wf = *(const LAS bf16x8*)(pwT + (g * 64 + et * 16 + fr) * 72 + ks * 32 + fq * 8); const bf16x8 pf = *(const LAS bf16x8*)(pooled + (tt * 16 + fr) * 272 + g * 64 + ks * 32 + fq * 8);
                  a = mfma16(wf, pf, a); }
              const int col = g * 64 + et * 16 + 4 * fq; const f32x4 sc = *(const f32x4*)(P.in[10] + j_even * 256 + col);
              u32x2 w; w.x = pk2(a.x * sc.x, a.y * sc.y); w.y = pk2(a.z * sc.z, a.w * sc.w); *(u32x2*)(A2 + mrow * D + col) = w; } }
    }
    __syncthreads();
}

__device__ __forceinline__ void phase_even_mixer(const Params& P, LAS unsigned char* lds, int j_even, int tid, int bid, int nb) {
    const int lane = tid & 63, wave = tid >> 6;
    if (nb != 256) for (int idx = tid; idx < 12 * 15 * 31; idx += NTHREADS) ((LAS float*)(lds + NA_RPB_OFF))[idx] = P.in[11][(size_t)j_even * 12 * 15 * 31 + idx];
    pool_units(P, lds, j_even, tid, bid, nb);
    const int gw = bid * NWAVES + wave, NGW = nb * NWAVES;
    if (nb == 256) {
        const bf16* PB = (const bf16*)(P.ws + WS_P);
        int bh_cur = -1, res_hi = 0;
        u32x4 pre[2]; int pre_lo = 0, pre_n = 0;
        const int it_end = bid * 12 + 12;
        for (int it = bid * 12; it < it_end; ++it) { const int bh = it >> 5, b = bh / 12, h = bh % 12;
            const int r0 = (it & 31) * 2, lo_need = min(max(r0 - 4, 0), 56), hi_need = min(max(r0 + 1 - 4, 0), 56) + 7;
            const int key = tid >> 3, c8 = tid & 7;
            __syncthreads();
            if (bh != bh_cur) { bh_cur = bh; res_hi = lo_need; pre_n = 0;
                for (int ch = tid; ch < 256 * 8; ch += NTHREADS) { const int kk = ch >> 3, cc = ch & 7;
                    *(LAS u32x4*)(lds + NA_KC_OFF + kk * 128 + ((cc ^ (kk & 7)) << 4)) = *(const u32x4*)(PB + ((size_t)ML + (size_t)b * NCTX + kk) * AB_IN + 1024 + h * 64 + cc * 8); }
                const bf16* vtc = (const bf16*)(P.ws + WS_VTC) + (size_t)(b * 12 + h) * 64 * NCTX;
                for (int ch = tid; ch < 64 * 32; ch += NTHREADS) { const int dh = ch >> 5, cc = ch & 31;
                    *(LAS u32x4*)(lds + NA_VC_OFF + dh * NA_VC_PITCH + cc * 16) = *(const u32x4*)(vtc + (size_t)dh * NCTX + cc * 8); }
                for (int idx = tid; idx < 15 * 31; idx += NTHREADS) ((LAS float*)(lds + NA_RPB2))[idx] = P.in[11][((size_t)j_even * 12 + h) * 15 * 31 + idx]; }
            { const int first = max(res_hi, lo_need);
              if (pre_n > 0 && pre_lo == first && pre_lo + pre_n == hi_need + 1) {
#pragma unroll
                  for (int q = 0; q < 2; ++q) if (q < pre_n) *(LAS u32x4*)(lds + NA_KW_OFF + ((pre_lo + q) % 9) * NA_KW_ROW + key * NA_KW_PITCH + c8 * 16) = pre[q];
              } else
                  for (int R = first; R <= hi_need; ++R)
                      *(LAS u32x4*)(lds + NA_KW_OFF + (R % 9) * NA_KW_ROW + key * NA_KW_PITCH + c8 * 16) = *(const u32x4*)(PB + ((size_t)b * T + (size_t)R * 64 + key) * AB_IN + 1024 + h * 64 + c8 * 8); }
            res_hi = hi_need + 1; pre_n = 0;
            __syncthreads();
            if (it + 1 < it_end && ((it + 1) >> 5) == bh) {
                const int r1 = ((it + 1) & 31) * 2, lo1 = min(max(r1 - 4, 0), 56), hi1 = min(max(r1 + 1 - 4, 0), 56) + 7; const int f1 = max(res_hi, lo1);
                if (hi1 - f1 + 1 >= 1 && hi1 - f1 + 1 <= 2) { pre_lo = f1; pre_n = hi1 - f1 + 1;
#pragma unroll
                    for (int q = 0; q < 2; ++q) if (q < pre_n) pre[q] = *(const u32x4*)(PB + ((size_t)b * T + (size_t)(f1 + q) * 64 + key) * AB_IN + 1024 + h * 64 + c8 * 8); } }
            na_wave_unit<false, true>(P, lds, bh * 256 + (it & 31) * 8 + wave, lane); }
        __syncthreads();
    } else {
        for (int v = gw; v < 24576; v += NGW) na_wave_unit<false, false>(P, lds, v, lane);
    }
    for (int v = gw; v < 1536; v += NGW) na_wave_unit<true, false>(P, lds, v, lane);
}

constexpr int GP_G = 0;
constexpr int GP_SEG = 8192;
constexpr int GP_B = 12288;
constexpr int GP_QD = 45056;
constexpr int GP_KD = 62464;
constexpr int GP_KLT = 79872;
constexpr int GP_ATT = 98304;
constexpr int GP_VT = 107520;
__device__ __forceinline__ void phase_gla_prepass(const Params& P, LAS unsigned char* lds, int j_odd, int tid, int bid, int nb, int dbg = 0) {
    const bf16* PB = (const bf16*)(P.ws + WS_P);
    const int lane = tid & 63, wave = tid >> 6, fr = lane & 15, fq = lane >> 4;
    LAS float* G = (LAS float*)(lds + GP_G); LAS float* SEG = (LAS float*)(lds + GP_SEG); LAS float* BC = (LAS float*)(lds + GP_B);
    LAS bf16* QD = (LAS bf16*)(lds + GP_QD); LAS bf16* KD = (LAS bf16*)(lds + GP_KD); LAS bf16* KLT = (LAS bf16*)(lds + GP_KLT); LAS bf16* ATT = (LAS bf16*)(lds + GP_ATT); LAS bf16* VTs = (LAS bf16*)(lds + GP_VT);
    const float* ROPEC = (const float*)(P.ws + WS_ROPE); const float* ROPES = ROPEC + T * 64;
    const f32x4 zero4 = {0.f, 0.f, 0.f, 0.f};
    const int f = tid & 63, seg = tid >> 6;
    const int ri = tid >> 3, rg = tid & 7;
    for (int unit = bid; unit < 544 * 4; unit += nb) {
        const int c = unit >> 2, h = unit & 3;
        const bool latent = c < 512;
        const size_t m0 = latent ? (size_t)c * 64 : (size_t)ML + (size_t)(c - 512) * 64;
        const int t0 = (c & 63) * 64;
        float gv[4];
#pragma unroll
        for (int q = 0; q < 4; ++q) { const int idx = tid + NTHREADS * q; gv[q] = bf2f(PB[(m0 + (idx >> 5)) * GLA_IN + 3072 + (idx & 31)]); }
        const bf16* rowp = PB + (m0 + ri) * GLA_IN + h * 128 + rg * 8;
        const u32x4 q1r = *(const u32x4*)rowp, q2r = *(const u32x4*)(rowp + 64), k1r = *(const u32x4*)(rowp + 512), k2r = *(const u32x4*)(rowp + 576);
        f32x4 cs4[4];
        if (latent) { const float* cp = ROPEC + (size_t)(t0 + ri) * 64 + rg * 8; const float* sp = ROPES + (size_t)(t0 + ri) * 64 + rg * 8;
            cs4[0] = *(const f32x4*)cp; cs4[1] = *(const f32x4*)(cp + 4); cs4[2] = *(const f32x4*)sp; cs4[3] = *(const f32x4*)(sp + 4); }
        else { cs4[0] = cs4[1] = (f32x4){1.f, 1.f, 1.f, 1.f}; cs4[2] = cs4[3] = zero4; }
        __syncthreads();
#pragma unroll
        for (int q = 0; q < 4; ++q) G[tid + NTHREADS * q] = gv[q];
        float qa[8], qb[8], ka[8], kb[8];
        { const unsigned qw1[4] = {q1r.x, q1r.y, q1r.z, q1r.w}, qw2[4] = {q2r.x, q2r.y, q2r.z, q2r.w}, kw1[4] = {k1r.x, k1r.y, k1r.z, k1r.w}, kw2[4] = {k2r.x, k2r.y, k2r.z, k2r.w};
#pragma unroll
          for (int e = 0; e < 8; ++e) { const int sh = (e & 1) * 16;
              const float x1 = bf2f((qw1[e >> 1] >> sh) & 0xffffu), x2 = bf2f((qw2[e >> 1] >> sh) & 0xffffu), y1 = bf2f((kw1[e >> 1] >> sh) & 0xffffu), y2 = bf2f((kw2[e >> 1] >> sh) & 0xffffu);
              const float cn = cs4[e >> 2][e & 3], sn = cs4[2 + (e >> 2)][e & 3];
              qa[e] = (x1 * cn - x2 * sn) * 0.08838834764831845f; qb[e] = (x1 * sn + x2 * cn) * 0.08838834764831845f; ka[e] = y1 * cn - y2 * sn; kb[e] = y1 * sn + y2 * cn; } }
        __syncthreads();
#pragma unroll 1
        for (int z = 0; z < 2; ++z) {
            const size_t u = ((size_t)c * 4 + h) * 2 + z;
            float bb1[8], bb2[8];
            { float wg1[16], wg2[16];
#pragma unroll
              for (int rr = 0; rr < 16; ++rr) { const float* wp = P.in[14] + ((size_t)(j_odd * 2 + z) * 16 + rr) * 512 + h * 128 + f; wg1[rr] = wp[0]; wg2[rr] = wp[64]; }
              const float bg1 = P.in[15][(size_t)(j_odd * 2 + z) * 512 + h * 128 + f], bg2 = P.in[15][(size_t)(j_odd * 2 + z) * 512 + h * 128 + 64 + f];
              float run1 = 0.f, run2 = 0.f;
#pragma unroll
              for (int ii = 0; ii < 8; ++ii) { const int ip = seg * 8 + ii, i = z ? 63 - ip : ip; float x1 = bg1, x2 = bg2;
                  if (!(dbg & 2))
#pragma unroll
                  for (int r4 = 0; r4 < 4; ++r4) { const f32x4 g4 = *(const LAS f32x4*)(G + i * 32 + z * 16 + r4 * 4);
                      x1 += g4.x * wg1[4 * r4] + g4.y * wg1[4 * r4 + 1] + g4.z * wg1[4 * r4 + 2] + g4.w * wg1[4 * r4 + 3];
                      x2 += g4.x * wg2[4 * r4] + g4.y * wg2[4 * r4 + 1] + g4.z * wg2[4 * r4 + 2] + g4.w * wg2[4 * r4 + 3]; }
                  run1 += (fminf(x1, 0.f) - __logf(1.0f + __expf(-fabsf(x1)))) * (1.0f / 16.0f); run2 += (fminf(x2, 0.f) - __logf(1.0f + __expf(-fabsf(x2)))) * (1.0f / 16.0f);
                  bb1[ii] = run1; bb2[ii] = run2; }
              SEG[seg * 128 + f] = run1; SEG[seg * 128 + 64 + f] = run2; }
            __syncthreads();
            { float off1 = 0.f, off2 = 0.f, tot1 = 0.f, tot2 = 0.f;
#pragma unroll
              for (int sg = 0; sg < 8; ++sg) { const float a1 = SEG[sg * 128 + f], a2 = SEG[sg * 128 + 64 + f]; tot1 += a1; tot2 += a2; if (sg < seg) { off1 += a1; off2 += a2; } }
              if (seg == 0) { float* dec = (float*)(P.ws + WS_GDEC) + u * 128; dec[f] = __expf(tot1); dec[64 + f] = __expf(tot2); }
#pragma unroll
              for (int ii = 0; ii < 8; ++ii) { BC[(seg * 8 + ii) * 128 + f] = bb1[ii] + off1; BC[(seg * 8 + ii) * 128 + 64 + f] = bb2[ii] + off2; } }
            __syncthreads();
            { const int ip = z ? 63 - ri : ri;
              const LAS float* bp = BC + ip * 128 + rg * 8; const LAS float* lp = BC + 63 * 128 + rg * 8;
              float ba[8], bbv[8], la[8], lb[8];
#pragma unroll
              for (int q4 = 0; q4 < 2; ++q4) { const f32x4 x = *(const LAS f32x4*)(bp + 4 * q4), y = *(const LAS f32x4*)(bp + 64 + 4 * q4), lx = *(const LAS f32x4*)(lp + 4 * q4), ly = *(const LAS f32x4*)(lp + 64 + 4 * q4);
#pragma unroll
                  for (int e = 0; e < 4; ++e) { ba[4 * q4 + e] = x[e]; bbv[4 * q4 + e] = y[e]; la[4 * q4 + e] = lx[e]; lb[4 * q4 + e] = ly[e]; } }
              float qda[8], qdb[8], kda[8], kdb[8];
#pragma unroll
              for (int e = 0; e < 8; ++e) { qda[e] = qa[e] * __expf(ba[e]); qdb[e] = qb[e] * __expf(bbv[e]); kda[e] = ka[e] * __expf(-ba[e]); kdb[e] = kb[e] * __expf(-bbv[e]);
                  KLT[(rg * 8 + e) * 72 + ip] = (bf16)f2bf(ka[e] * __expf(la[e] - ba[e])); KLT[(64 + rg * 8 + e) * 72 + ip] = (bf16)f2bf(kb[e] * __expf(lb[e] - bbv[e])); }
              u32x4 w;
              w.x = pk2(qda[0], qda[1]); w.y = pk2(qda[2], qda[3]); w.z = pk2(qda[4], qda[5]); w.w = pk2(qda[6], qda[7]); *(LAS u32x4*)(QD + ip * 136 + rg * 8) = w;
              w.x = pk2(qdb[0], qdb[1]); w.y = pk2(qdb[2], qdb[3]); w.z = pk2(qdb[4], qdb[5]); w.w = pk2(qdb[6], qdb[7]); *(LAS u32x4*)(QD + ip * 136 + 64 + rg * 8) = w;
              w.x = pk2(kda[0], kda[1]); w.y = pk2(kda[2], kda[3]); w.z = pk2(kda[4], kda[5]); w.w = pk2(kda[6], kda[7]); *(LAS u32x4*)(KD + ip * 136 + rg * 8) = w;
              w.x = pk2(kdb[0], kdb[1]); w.y = pk2(kdb[2], kdb[3]); w.z = pk2(kdb[4], kdb[5]); w.w = pk2(kdb[6], kdb[7]); *(LAS u32x4*)(KD + ip * 136 + 64 + rg * 8) = w; }
            __syncthreads();
#pragma unroll
            for (int tt = 0; tt < 2; ++tt) { const int id = wave * 2 + tt, ti = id >> 2, ts = id & 3;
                f32x4 a = zero4;
                if (ts <= ti && !(dbg & 4)) {
#pragma unroll
                    for (int kk = 0; kk < 4; ++kk) { const bf16x8 qf = *(const LAS bf16x8*)(QD + (ti * 16 + fr) * 136 + kk * 32 + fq * 8); const bf16x8 kf = *(const LAS bf16x8*)(KD + (ts * 16 + fr) * 136 + kk * 32 + fq * 8);
                        a = mfma16(kf, qf, a); }
#pragma unroll
                    for (int jx = 0; jx < 4; ++jx) if (ts * 16 + 4 * fq + jx > ti * 16 + fr) a[jx] = 0.f;
                }
                u32x2 w; w.x = pk2(a.x, a.y); w.y = pk2(a.z, a.w); *(LAS u32x2*)(ATT + (ti * 16 + fr) * 72 + ts * 16 + 4 * fq) = w; }
            __syncthreads();
            if (!(dbg & 8)) { bf16* QDG = (bf16*)(P.ws + WS_GQD) + u * 22528; bf16* KLG = QDG + 64 * 136; bf16* ATG = KLG + 128 * 72;
              for (int ch = tid; ch < 64 * 136 / 8; ch += NTHREADS) *(u32x4*)(QDG + ch * 8) = *(const LAS u32x4*)(QD + ch * 8);
              for (int ch = tid; ch < 128 * 72 / 8; ch += NTHREADS) *(u32x4*)(KLG + ch * 8) = *(const LAS u32x4*)(KLT + ch * 8);
              for (int ch = tid; ch < 64 * 72 / 8; ch += NTHREADS) *(u32x4*)(ATG + ch * 8) = *(const LAS u32x4*)(ATT + ch * 8); }
            __syncthreads();
        }
    }
}

constexpr int GS_X = 54272, GS_QD = 0, GS_KLT = 17408, GS_ATT = 35840, GS_VT = 45056, GS_ST = 2 * GS_X, GS_STB = 17408;
__device__ __forceinline__ bf16x8 rev8(bf16x8 v) {
    const u32x4 x = __builtin_bit_cast(u32x4, v); u32x4 y;
    y.x = __builtin_amdgcn_alignbit(x.w, x.w, 16); y.y = __builtin_amdgcn_alignbit(x.z, x.z, 16); y.z = __builtin_amdgcn_alignbit(x.y, x.y, 16); y.w = __builtin_amdgcn_alignbit(x.x, x.x, 16);
    return __builtin_bit_cast(bf16x8, y);
}
__device__ __forceinline__ int gla_chunk(int b, int z, int cs) { return (cs < 4) ? 512 + b * 4 + (z ? 3 - cs : cs) : b * 64 + (z ? 63 - (cs - 4) : (cs - 4)); }
struct GlaStage { u32x4 r[7]; };
__device__ __forceinline__ void gla_stage_load(const Params& P, GlaStage& R, int b, int h, int z, int dvs, int cs, int tid, int wave, int fq) {
    const int c = gla_chunk(b, z, cs); const size_t u = ((size_t)c * 4 + h) * 2 + z;
    const unsigned char* IMG = P.ws + WS_GQD + u * 45056;
    const unsigned char* VTG = P.ws + WS_GVT + ((size_t)c * 1024 + h * 256 + dvs * 64) * 144 - (size_t)2816 * 16;
#pragma unroll
    for (int q = 0; q < 5; ++q) R.r[q] = *(const u32x4*)(IMG + (tid + 512 * q) * 16);
    { const int g = tid + 2560; R.r[5] = *(const u32x4*)((g < 2816 ? IMG : VTG) + g * 16); }
    { const int g = min(tid + 3072, 3391); R.r[6] = *(const u32x4*)(VTG + g * 16); }
}
__device__ __forceinline__ f32x4 gla_dec_load(const Params& P, int b, int h, int z, int cs, int wave, int fq) {
    const int c = gla_chunk(b, z, cs); const size_t u = ((size_t)c * 4 + h) * 2 + z; return *(const f32x4*)((const float*)(P.ws + WS_GDEC) + u * 128 + wave * 16 + 4 * fq);
}
__device__ __forceinline__ void gla_stage_store(LAS unsigned char* xb, const GlaStage& R, int tid) {
#pragma unroll
    for (int q = 0; q < 7; ++q) { const int g = tid + 512 * q; if (q < 6 || g < 3392) *(LAS u32x4*)(xb + g * 16) = R.r[q]; }
}
__device__ __forceinline__ void phase_gla_scan(const Params& P, LAS unsigned char* lds, int tid, int bid, int nb) {
    const int lane = tid & 63, wave = tid >> 6, fr = lane & 15, fq = lane >> 4;
    for (int cb = bid; cb < 256; cb += nb) {
        const int xcd = cb & 7, kq = cb >> 3, g = xcd * 8 + (kq >> 2), dvs = kq & 3;
        const int b = g >> 3, h = (g >> 1) & 3, z = g & 1;
        bf16* O = (bf16*)(P.ws + (z ? WS_OB : WS_OF));
        f32x4 Sacc[4];
#pragma unroll
        for (int te = 0; te < 4; ++te) Sacc[te] = (f32x4){0.f, 0.f, 0.f, 0.f};
        GlaStage R;
        gla_stage_load(P, R, b, h, z, dvs, 0, tid, wave, fq);
        __syncthreads();
        for (int idx = tid; idx < 2 * GS_STB / 4; idx += NTHREADS) ((LAS unsigned*)(lds + GS_ST))[idx] = 0u;
        gla_stage_store(lds, R, tid);
        gla_stage_load(P, R, b, h, z, dvs, 1, tid, wave, fq);
        __syncthreads();
#pragma unroll 1
        for (int cs = 0; cs < 68; ++cs) {
            const LAS unsigned char* xb = lds + (cs & 1) * GS_X;
            const f32x4 dec_cur = gla_dec_load(P, b, h, z, cs, wave, fq);
            if (cs + 1 < 68) gla_stage_store(lds + ((cs + 1) & 1) * GS_X, R, tid);
            if (cs + 2 < 68) gla_stage_load(P, R, b, h, z, dvs, cs + 2, tid, wave, fq);
            const int c = gla_chunk(b, z, cs); const int ti = wave >> 1;
            const LAS bf16* STr = (const LAS bf16*)(lds + GS_ST + (cs & 1) * GS_STB);
            LAS bf16* STw = (LAS bf16*)(lds + GS_ST + ((cs + 1) & 1) * GS_STB);
            const LAS bf16* QDl = (const LAS bf16*)(xb + GS_QD); const LAS bf16* KLl = (const LAS bf16*)(xb + GS_KLT); const LAS bf16* ATl = (const LAS bf16*)(xb + GS_ATT); const LAS bf16* VTl = (const LAS bf16*)(xb + GS_VT);
            bf16x8 vt[4][2];
#pragma unroll
            for (int te = 0; te < 4; ++te)
#pragma unroll
                for (int kk = 0; kk < 2; ++kk) { const bf16x8 v = *(const LAS bf16x8*)(VTl + (te * 16 + fr) * 72 + (z ? (56 - kk * 32 - fq * 8) : (kk * 32 + fq * 8))); vt[te][kk] = z ? rev8(v) : v; }
            const size_t m0 = (c < 512) ? (size_t)c * 64 : (size_t)ML + (size_t)(c - 512) * 64;
            const int ip = ti * 16 + fr; const size_t mrow = m0 + (z ? 63 - ip : ip);
            bf16x8 qd[4], at[2];
#pragma unroll
            for (int kk = 0; kk < 4; ++kk) qd[kk] = *(const LAS bf16x8*)(QDl + ip * 136 + kk * 32 + fq * 8);
#pragma unroll
            for (int kk = 0; kk < 2; ++kk) at[kk] = *(const LAS bf16x8*)(ATl + ip * 72 + kk * 32 + fq * 8);
#pragma unroll
            for (int tt = 0; tt < 2; ++tt) { const int te = (wave & 1) * 2 + tt;
                f32x4 a = {0.f, 0.f, 0.f, 0.f};
#pragma unroll
                for (int kk = 0; kk < 4; ++kk) { const bf16x8 sf = *(const LAS bf16x8*)(STr + (te * 16 + fr) * 136 + kk * 32 + fq * 8); a = mfma16(sf, qd[kk], a); }
                bf16x8 v0 = *(const LAS bf16x8*)(VTl + (te * 16 + fr) * 72 + (z ? (56 - fq * 8) : (fq * 8))), v1 = *(const LAS bf16x8*)(VTl + (te * 16 + fr) * 72 + (z ? (24 - fq * 8) : (32 + fq * 8)));
                if (z) { v0 = rev8(v0); v1 = rev8(v1); }
                a = mfma16(v0, at[0], a); a = mfma16(v1, at[1], a);
                { u32x2 w; w.x = pk2(a.x, a.y); w.y = pk2(a.z, a.w); *(u32x2*)(O + mrow * D + h * 256 + dvs * 64 + te * 16 + 4 * fq) = w; } }
            { const bf16x8 kl0 = *(const LAS bf16x8*)(KLl + (wave * 16 + fr) * 72 + fq * 8), kl1 = *(const LAS bf16x8*)(KLl + (wave * 16 + fr) * 72 + 32 + fq * 8);
#pragma unroll
              for (int te = 0; te < 4; ++te) { f32x4 a = Sacc[te] * dec_cur; a = mfma16(kl0, vt[te][0], a); a = mfma16(kl1, vt[te][1], a); Sacc[te] = a;
                  u32x2 w; w.x = pk2(a.x, a.y); w.y = pk2(a.z, a.w); *(LAS u32x2*)(STw + (te * 16 + fr) * 136 + wave * 16 + 4 * fq) = w; } }
            __syncthreads();
        }
    }
}

__device__ __forceinline__ void phase_gla_out(const Params& P, int j_odd, int tid, int bid, int nb, int Mrows) {
    const int lane = tid & 63, wave = tid >> 6; unsigned char* ws = P.ws;
    const bf16* PB = (const bf16*)(ws + WS_P); bf16* A2 = (bf16*)(ws + WS_A2);
    const bf16* OF = (const bf16*)(ws + WS_OF); const bf16* OB = (const bf16*)(ws + WS_OB);
    const f32x4 ng = *(const f32x4*)(P.in[16] + j_odd * 256 + 4 * lane);
    for (int m0 = (bid * NWAVES + wave) * 2; m0 < Mrows; m0 += nb * NWAVES * 2) {
        u32x2 of[2][4], ob[2][4], rr[2][4];
#pragma unroll
        for (int q = 0; q < 2; ++q) { const int m = min(m0 + q, Mrows - 1);
#pragma unroll
            for (int h = 0; h < 4; ++h) { const int col = h * 256 + 4 * lane;
                of[q][h] = *(const u32x2*)(OF + (size_t)m * D + col); ob[q][h] = *(const u32x2*)(OB + (size_t)m * D + col); rr[q][h] = *(const u32x2*)(PB + (size_t)m * GLA_IN + 2048 + col); } }
#pragma unroll
        for (int q = 0; q < 2; ++q) { const int m = m0 + q;
            if (m < Mrows) {
#pragma unroll
                for (int h = 0; h < 4; ++h) { const int col = h * 256 + 4 * lane;
                    const f32x4 o = {bf2f(of[q][h].x & 0xffffu) + bf2f(ob[q][h].x & 0xffffu), bf2f(of[q][h].x >> 16) + bf2f(ob[q][h].x >> 16), bf2f(of[q][h].y & 0xffffu) + bf2f(ob[q][h].y & 0xffffu), bf2f(of[q][h].y >> 16) + bf2f(ob[q][h].y >> 16)};
                    const float ss = wave_sum(o.x * o.x + o.y * o.y + o.z * o.z + o.w * o.w);
                    const float rs = rsqrtf(ss * (1.0f / 256.0f) + 1e-6f);
                    const float r0 = bf2f(rr[q][h].x & 0xffffu), r1 = bf2f(rr[q][h].x >> 16), r2 = bf2f(rr[q][h].y & 0xffffu), r3 = bf2f(rr[q][h].y >> 16);
                    u32x2 w; w.x = pk2(o.x * rs * ng.x * silu_f(r0), o.y * rs * ng.y * silu_f(r1)); w.y = pk2(o.z * rs * ng.z * silu_f(r2), o.w * rs * ng.w * silu_f(r3));
                    *(u32x2*)(A2 + (size_t)m * D + col) = w; } } }
    }
}

constexpr int L1_HP = 1040;
constexpr int L1_HHI = 0, L1_HLO = 16 * L1_HP * 2;
constexpr int L1_PART = 2 * 16 * L1_HP * 2;
constexpr int L1_SEL = L1_PART + 16384;
constexpr int L1_MAXROWS = 136;
constexpr int L1_VEC = L1_SEL + 8192;
template <bool B> struct BTag { static constexpr bool value = B; };
template <bool L0> struct L1XSel { typedef f32x4 type; };
template <> struct L1XSel<false> { typedef u32x2 type; };
__device__ __forceinline__ f32x4 l1_xval(const f32x4& x) { return x; }
__device__ __forceinline__ f32x4 l1_xval(const u32x2& w) { return (f32x4){bf2f(w.x & 0xffffu), bf2f(w.x >> 16), bf2f(w.y & 0xffffu), bf2f(w.y >> 16)}; }
__device__ __forceinline__ void phase_ln1_router(const Params& P, LAS unsigned char* lds, int layer, int tid, int bid, int nb, int Mrows, bool dry = false) {
    const int lane = tid & 63, wave = tid >> 6, fr = lane & 15, fq = lane >> 4; unsigned char* ws = P.ws;
    LAS bf16* HHI = (LAS bf16*)(lds + L1_HHI); LAS bf16* HLO = (LAS bf16*)(lds + L1_HLO); LAS float* PART = (LAS float*)(lds + L1_PART);
    LAS int* SELE = (LAS int*)(lds + L1_SEL); LAS int* SELP = SELE + L1_MAXROWS * 4; LAS float* SELG = (LAS float*)(SELP + L1_MAXROWS * 4);
    LAS int* hist = (LAS int*)(SELG + L1_MAXROWS * 4); LAS int* base = hist + 32;
    __syncthreads();
    LAS float* RB = (LAS float*)(base + 32);
    if (tid < 32) { hist[tid] = 0; RB[tid] = P.in[19][layer * 32 + tid]; }
    bf16x8 whi[2][4], wlo[2][4];
    { const bf16* rwt = (const bf16*)(ws + WS_RWT) + (size_t)layer * 2 * 32 * 1024;
#pragma unroll
      for (int et = 0; et < 2; ++et)
#pragma unroll
          for (int ks = 0; ks < 4; ++ks) { const bf16* p = rwt + (size_t)(et * 16 + fr) * 1024 + wave * 128 + ks * 32 + fq * 8; whi[et][ks] = *(const bf16x8*)p; wlo[et][ks] = *(const bf16x8*)(p + 32 * 1024); } }
    const int rpb = (Mrows + nb - 1) / nb;
    const int row_lo = bid * rpb, row_hi = min(row_lo + rpb, Mrows);
    const float* mods = (const float*)(ws + WS_MODS) + (size_t)layer * 9 * 6144;
    LAS float* VEC = (LAS float*)(lds + L1_VEC);
    const int mb0 = (row_lo < ML) ? (row_lo >> 12) : 8, mb1 = (row_hi - 1 < ML) ? ((row_hi - 1) >> 12) : 8;
    for (int idx = tid; idx < 8 * 1024; idx += NTHREADS) { const int vsel = idx >> 10, col = idx & 1023; float x;
        if (vsel == 0) x = P.in[6][(size_t)(layer * 2 + 0) * D + col]; else if (vsel == 1) x = P.in[7][(size_t)(layer * 2 + 0) * D + col];
        else { const int set = (vsel - 2) / 3, what = (vsel - 2) % 3; x = mods[(size_t)(set ? mb1 : mb0) * 6144 + (what == 0 ? 3 : what == 1 ? 4 : 2) * 1024 + col]; }
        VEC[idx] = x; }
    const bf16* X2 = (const bf16*)(ws + WS_X); bf16* Xo = (bf16*)(ws + WS_OB); unsigned char* H8o        = (unsigned char*)(ws + (dry ? WS_A2 : WS_H8));
    const bf16* OPR = (const bf16*)(ws + WS_P);
    const f32x4 zero4 = {0.f, 0.f, 0.f, 0.f};
    __syncthreads();
    auto run = [&](auto l0tag) __attribute__((always_inline)) {
        constexpr bool L0 = decltype(l0tag)::value;
        typedef typename L1XSel<L0>::type XT;
        XT xA[2][4], xB[2][4]; u32x2 oA[2][4], oB[2][4];
        auto load_rows = [&](int pp, XT (&xs)[2][4], u32x2 (&os)[2][4]) __attribute__((always_inline)) {
#pragma unroll
            for (int rr = 0; rr < 2; ++rr) { const int m = min(pp + wave * 2 + rr, row_hi - 1);
#pragma unroll
                for (int j = 0; j < 4; ++j) {
                    if constexpr (L0) { const float* xsrc = (m < ML) ? P.in[0] + (size_t)m * D : P.in[2] + (size_t)(m - ML) * D; xs[rr][j] = *(const f32x4*)(xsrc + 4 * lane + 256 * j); }
                    else xs[rr][j] = *(const u32x2*)(X2 + (size_t)m * D + 4 * lane + 256 * j);
                    os[rr][j] = *(const u32x2*)(OPR + (size_t)m * D + 4 * lane + 256 * j); } } };
        auto pass = [&](int p0, XT (&xs)[2][4], u32x2 (&os)[2][4]) __attribute__((always_inline)) {
#pragma unroll
        for (int rr = 0; rr < 2; ++rr) { const int lr16 = wave * 2 + rr, m = p0 + lr16;
            if (m < row_hi) {
                const int mb = (m < ML) ? (m >> 12) : 8; const LAS float* VS = VEC + 2048 + ((mb == mb0) ? 0 : 3072);
                f32x4 v[4]; float s = 0.f;
#pragma unroll
                for (int j = 0; j < 4; ++j) { const int col = 4 * lane + 256 * j; const u32x2 ow = os[rr][j]; const f32x4 g1 = *(const LAS f32x4*)(VS + 2048 + col);
                    const f32x4 o = {bf2f(ow.x & 0xffffu), bf2f(ow.x >> 16), bf2f(ow.y & 0xffffu), bf2f(ow.y >> 16)};
                    const f32x4 xv = l1_xval(xs[rr][j]);
                    v[j] = xv * DN_ALPHA + g1 * o; s += (v[j].x + v[j].y) + (v[j].z + v[j].w); }
                const float mean = wave_sum(s) * (1.f / D); float s2 = 0.f;
#pragma unroll
                for (int j = 0; j < 4; ++j) { v[j] = v[j] - mean; s2 += (v[j].x * v[j].x + v[j].y * v[j].y) + (v[j].z * v[j].z + v[j].w * v[j].w); }
                const float rstd = rsqrtf(wave_sum(s2) * (1.f / D) + LN_EPS);
#pragma unroll
                for (int j = 0; j < 4; ++j) { const int col = 4 * lane + 256 * j; const f32x4 g = *(const LAS f32x4*)(VEC + col), bb = *(const LAS f32x4*)(VEC + 1024 + col);
                    v[j] = v[j] * rstd * g + bb; { u32x2 xw; xw.x = pk2(v[j].x, v[j].y); xw.y = pk2(v[j].z, v[j].w); *(u32x2*)(Xo + (size_t)m * D + col) = xw; }
                    const f32x4 sh = *(const LAS f32x4*)(VS + col), sc = *(const LAS f32x4*)(VS + 1024 + col);
                    const f32x4 hq = v[j] * (1.f + sc) + sh;
                    *(unsigned*)(H8o + (size_t)m * D + col) = pk4_fp8(hq.x * H8_SCALE, hq.y * H8_SCALE, hq.z * H8_SCALE, hq.w * H8_SCALE);
                    const unsigned h01 = pk2(hq.x, hq.y), h23 = pk2(hq.z, hq.w);
                    const unsigned l01 = pk2(hq.x - bf2f(h01 & 0xffffu), hq.y - bf2f(h01 >> 16)), l23 = pk2(hq.z - bf2f(h23 & 0xffffu), hq.w - bf2f(h23 >> 16));
                    u32x2 wh = {h01, h23}, wl = {l01, l23};
                    *(LAS u32x2*)(HHI + lr16 * L1_HP + col) = wh; *(LAS u32x2*)(HLO + lr16 * L1_HP + col) = wl; }
            } }
        __syncthreads();
        { f32x4 acc[2] = {zero4, zero4};
#pragma unroll
          for (int ks = 0; ks < 4; ++ks) { const bf16x8 hh = *(const LAS bf16x8*)(HHI + fr * L1_HP + wave * 128 + ks * 32 + fq * 8), hl = *(const LAS bf16x8*)(HLO + fr * L1_HP + wave * 128 + ks * 32 + fq * 8);
#pragma unroll
              for (int et = 0; et < 2; ++et) { acc[et] = mfma16(whi[et][ks], hh, acc[et]); acc[et] = mfma16(whi[et][ks], hl, acc[et]); acc[et] = mfma16(wlo[et][ks], hh, acc[et]); } }
#pragma unroll
          for (int et = 0; et < 2; ++et) *(LAS f32x4*)(PART + (wave * 16 + fr) * 32 + et * 16 + 4 * fq) = acc[et]; }
        __syncthreads();
        { const int hl = lane & 31, lr16 = wave * 2 + (lane >> 5), m = p0 + lr16;
          float lgv = RB[hl];
#pragma unroll
          for (int w8 = 0; w8 < 8; ++w8) lgv += PART[(w8 * 16 + lr16) * 32 + hl];
          int se[4]; float sv[4];
#pragma unroll
          for (int k = 0; k < 4; ++k) {
              float mx = lgv;
              mx = fmaxf(mx, __builtin_bit_cast(float, __builtin_amdgcn_update_dpp(0, __builtin_bit_cast(int, mx), 0x128, 0xf, 0xf, false)));
              mx = fmaxf(mx, __builtin_bit_cast(float, __builtin_amdgcn_update_dpp(0, __builtin_bit_cast(int, mx), 0x124, 0xf, 0xf, false)));
              mx = fmaxf(mx, __builtin_bit_cast(float, __builtin_amdgcn_update_dpp(0, __builtin_bit_cast(int, mx), 0x122, 0xf, 0xf, false)));
              mx = fmaxf(mx, __builtin_bit_cast(float, __builtin_amdgcn_update_dpp(0, __builtin_bit_cast(int, mx), 0x121, 0xf, 0xf, false)));
              mx = fmaxf(mx, __builtin_bit_cast(float, __builtin_amdgcn_ds_bpermute((lane ^ 16) << 2, __builtin_bit_cast(int, mx))));
              const unsigned long long bal = __ballot(lgv == mx);
              const unsigned hm = (unsigned)(bal >> (lane & 32));
              const int bi = __builtin_ctz(hm);
              se[k] = bi; sv[k] = mx;
              lgv = (hl == bi) ? -3.0e38f : lgv; }
          const float e1 = __expf(sv[1] - sv[0]), e2 = __expf(sv[2] - sv[0]), e3 = __expf(sv[3] - sv[0]); const float inv = 1.f / (1.f + e1 + e2 + e3);
          if ((lane & 31) == 0 && m < row_hi) { const int lr = m - row_lo;
              const float gt[4] = {inv, e1 * inv, e2 * inv, e3 * inv};
#pragma unroll
              for (int k = 0; k < 4; ++k) { const int pos = atomicAdd((int*)(hist + se[k]), 1); SELE[lr * 4 + k] = se[k]; SELP[lr * 4 + k] = pos; SELG[lr * 4 + k] = gt[k]; } } }
        };
        load_rows(row_lo, xA, oA);
        for (int p0 = row_lo; p0 < row_hi; p0 += 32) {
            const bool more = p0 + 16 < row_hi;
            if (more) load_rows(p0 + 16, xB, oB);
            pass(p0, xA, oA);
            if (more) { if (p0 + 32 < row_hi) load_rows(p0 + 32, xA, oA); pass(p0 + 16, xB, oB); }
        }
    };
    if (layer == 0) run(BTag<true>{}); else run(BTag<false>{});
    __syncthreads();
    if (dry) return;
    if (tid < 32) { unsigned* cnt = (unsigned*)(ws + WS_CTL) + CW_CNT + layer * 32; const int hc = hist[tid]; base[tid] = hc ? (int)__hip_atomic_fetch_add(cnt + tid, (unsigned)hc, __ATOMIC_RELAXED, __HIP_MEMORY_SCOPE_AGENT) : 0; }
    __syncthreads();
    const int nrows = row_hi - row_lo;
    int* TOKE = (int*)(ws + WS_TOKE); int* TOKP = (int*)(ws + WS_TOKP); float* TOKG = (float*)(ws + WS_TOKG); int* LIST = (int*)(ws + WS_LIST);
    for (int idx = tid; idx < nrows * 4; idx += NTHREADS) { const int lr = idx >> 2; const int m = row_lo + lr; const int e = SELE[idx], pos = base[e] + SELP[idx];
        TOKE[(size_t)m * 4 + (idx & 3)] = e; TOKP[(size_t)m * 4 + (idx & 3)] = pos; TOKG[(size_t)m * 4 + (idx & 3)] = SELG[idx]; LIST[(size_t)e * M + pos] = m; }
}

__device__ __forceinline__ void phase_ln2_combine(const Params& P, LAS unsigned char* lds, int layer, int tid, int bid, int nb, int Mrows, bool dry = false) {
    const int lane = tid & 63, wave = tid >> 6; unsigned char* ws = P.ws;
    moe_tables<0>(P, lds, tid, layer);
    const LAS int* tab = (const LAS int*)(lds + g8::MOE_TAB);
    const float* mods = (const float*)(ws + WS_MODS) + (size_t)layer * 9 * 6144;
    const float* modn = (const float*)(ws + WS_MODS) + (size_t)(layer + 1) * 9 * 6144;
    const bf16* X = (const bf16*)(ws + WS_OB); bf16* X2 = (bf16*)(ws + WS_X); const bf16* YS = (const bf16*)(ws + WS_YS);
    const int* TOKE = (const int*)(ws + WS_TOKE); const int* TOKP = (const int*)(ws + WS_TOKP); const float* TOKG = (const float*)(ws + WS_TOKG);
    const int rpb = (Mrows + nb - 1) / nb;
    const int row_lo = bid * rpb, row_hi = min(row_lo + rpb, Mrows);
    LAS float* VEC = (LAS float*)lds;
    const int mb0 = (row_lo < ML) ? (row_lo >> 12) : 8, mb1 = (row_hi - 1 < ML) ? ((row_hi - 1) >> 12) : 8;
    const bool has_next = layer < DEPTH - 1;
    for (int idx = tid; idx < 8 * 1024; idx += NTHREADS) { const int vsel = idx >> 10, col = idx & 1023; float x;
        if (vsel == 0) x = P.in[6][(size_t)(layer * 2 + 1) * D + col]; else if (vsel == 1) x = P.in[7][(size_t)(layer * 2 + 1) * D + col];
        else { const int set = (vsel - 2) / 3, what = (vsel - 2) % 3; const int mbs = set ? mb1 : mb0;
            x = (what == 0) ? mods[(size_t)mbs * 6144 + 5 * 1024 + col] : (has_next ? modn[(size_t)mbs * 6144 + (what == 1 ? 0 : 1024) + col] : 0.f); }
        VEC[idx] = x; }
    __syncthreads();
    for (int m0 = row_lo + wave * 2; m0 < row_hi; m0 += 2 * NWAVES) {
        int te[2][4], tp[2][4]; float tg[2][4];
#pragma unroll
        for (int rr = 0; rr < 2; ++rr) { const int m = min(m0 + rr, row_hi - 1);
#pragma unroll
            for (int k = 0; k < 4; ++k) { te[rr][k] = TOKE[(size_t)m * 4 + k]; tp[rr][k] = TOKP[(size_t)m * 4 + k]; tg[rr][k] = TOKG[(size_t)m * 4 + k]; } }
        u32x2 xr[2][4]; u32x2 yr[2][4][4];
#pragma unroll
        for (int rr = 0; rr < 2; ++rr) { const int m = min(m0 + rr, row_hi - 1);
#pragma unroll
            for (int j = 0; j < 4; ++j) xr[rr][j] = *(const u32x2*)(X + (size_t)m * D + 4 * lane + 256 * j);
#pragma unroll
            for (int k = 0; k < 4; ++k) { const bf16* yp = YS + ((size_t)tab[96 + te[rr][k]] + tp[rr][k]) * 1024 + 4 * lane;
#pragma unroll
                for (int j = 0; j < 4; ++j) yr[rr][k][j] = *(const u32x2*)(yp + 256 * j); } }
#pragma unroll
        for (int rr = 0; rr < 2; ++rr) { const int m = m0 + rr;
            if (m < row_hi) {
                const int mb = (m < ML) ? (m >> 12) : 8; const LAS float* VS = VEC + 2048 + ((mb == mb0) ? 0 : 3072);
                f32x4 v[4]; float s = 0.f;
#pragma unroll
                for (int j = 0; j < 4; ++j) { const int col = 4 * lane + 256 * j; f32x4 y = {0.f, 0.f, 0.f, 0.f};
#pragma unroll
                    for (int k = 0; k < 4; ++k) { const u32x2 rw = yr[rr][k][j]; const float gt = tg[rr][k];
                        y.x += gt * bf2f(rw.x & 0xffffu); y.y += gt * bf2f(rw.x >> 16); y.z += gt * bf2f(rw.y & 0xffffu); y.w += gt * bf2f(rw.y >> 16); }
                    const f32x4 g2 = *(const LAS f32x4*)(VS + col);
                    const u32x2 xw = xr[rr][j]; const f32x4 xv = {bf2f(xw.x & 0xffffu), bf2f(xw.x >> 16), bf2f(xw.y & 0xffffu), bf2f(xw.y >> 16)};
                    v[j] = xv * DN_ALPHA + g2 * y; s += (v[j].x + v[j].y) + (v[j].z + v[j].w); }
                const float mean = wave_sum(s) * (1.f / D); float s2 = 0.f;
#pragma unroll
                for (int j = 0; j < 4; ++j) { v[j] = v[j] - mean; s2 += (v[j].x * v[j].x + v[j].y * v[j].y) + (v[j].z * v[j].z + v[j].w * v[j].w); }
                const float rstd = rsqrtf(wave_sum(s2) * (1.f / D) + LN_EPS);
#pragma unroll
                for (int j = 0; j < 4; ++j) { const int col = 4 * lane + 256 * j; const f32x4 g = *(const LAS f32x4*)(VEC + col), bb = *(const LAS f32x4*)(VEC + 1024 + col);
                    v[j] = v[j] * rstd * g + bb;
                    if (dry) *(f32x4*)((float*)(ws + WS_OB) + (size_t)m * D + col) = v[j]; else if (has_next) { u32x2 xo; xo.x = pk2(v[j].x, v[j].y); xo.y = pk2(v[j].z, v[j].w); *(u32x2*)(X2 + (size_t)m * D + col) = xo; } else *(f32x4*)(P.out + (size_t)m * D + col) = v[j];
                    if (has_next) { const f32x4 sh = *(const LAS f32x4*)(VS + 1024 + col), sc = *(const LAS f32x4*)(VS + 2048 + col);
                        *(unsigned*)((unsigned char*)(ws + (dry ? WS_A2 : WS_H)) + (size_t)m * D + col) = pk4_fp8((v[j].x * (1.f + sc.x) + sh.x) * H8_SCALE, (v[j].y * (1.f + sc.y) + sh.y) * H8_SCALE, (v[j].z * (1.f + sc.z) + sh.z) * H8_SCALE, (v[j].w * (1.f + sc.w) + sh.w) * H8_SCALE); } }
            } }
    }
}

#define XB_TMO      128
#define XB_XCNT(j)  (256  + 64 * (j))
#define XB_XSUB(j)  (1280 + 64 * (j))
#define XB_XGEN(j)  (2304 + 64 * (j))
#define XB_TOP      3328
#define XB_TOPGEN   3392
#define XCD_BAR_WORDS 3456
#define XB_SPIN_CAP (1u << 20)

__device__ __forceinline__ unsigned xb_ld(unsigned* p)              { return __hip_atomic_load(p, __ATOMIC_RELAXED, __HIP_MEMORY_SCOPE_AGENT); }
__device__ __forceinline__ unsigned xb_add(unsigned* p, unsigned v) { return __hip_atomic_fetch_add(p, v, __ATOMIC_RELAXED, __HIP_MEMORY_SCOPE_AGENT); }
__device__ __forceinline__ unsigned xb_xcc_id() { return (unsigned)__builtin_amdgcn_s_getreg((3 << 11) | 20) & 0xFu; }
#define XB_SPIN(cond, bar) do { unsigned _sp = 0; while (cond) { __builtin_amdgcn_s_sleep(1); \
    if ((++_sp & 255u) == 0u) { if (xb_ld(&(bar)[XB_TMO])) break; if (_sp > XB_SPIN_CAP) { atomicAdd(&(bar)[XB_TMO], 1u); break; } } } } while (0)

struct XcdBarrier {
    unsigned* bar; unsigned x;
    volatile LAS unsigned* st;
};

__device__ __forceinline__ XcdBarrier xcd_barrier_post(unsigned* bar, volatile LAS unsigned* st) {
    XcdBarrier b; b.bar = bar; b.x = xb_xcc_id(); b.st = st;
    if (threadIdx.x == 0) (void)xb_add(&bar[XB_XCNT(b.x)], 1u);
    return b;
}
__device__ __forceinline__ void xcd_barrier_complete(unsigned* bar, unsigned x, unsigned& nloc, unsigned& nx) {
    const unsigned G = gridDim.x * gridDim.y * gridDim.z;
    unsigned sum, cnt, mine, sp = 0u;
    for (;;) {
        sum = 0u; cnt = 0u; mine = 0u;
#pragma unroll
        for (unsigned j = 0; j < 16; ++j) { const unsigned c = xb_ld(&bar[XB_XCNT(j)]); sum += c; cnt += (c > 0u) ? 1u : 0u; mine = (j == x) ? c : mine; }
        if (sum == G) break;
        __builtin_amdgcn_s_sleep(1);
        if ((++sp & 255u) == 0u) { if (xb_ld(&bar[XB_TMO])) break; if (sp > XB_SPIN_CAP) { atomicAdd(&bar[XB_TMO], 1u); break; } }
    }
    nloc = mine > 0u ? mine : 1u; nx = cnt > 0u ? cnt : 1u;
}

__device__ __forceinline__ void xcd_barrier(const XcdBarrier& b) {
    asm volatile("s_waitcnt vmcnt(0)" ::: "memory");
    __syncthreads();
    if (threadIdx.x == 0) {
        unsigned* bar = b.bar;
        __builtin_amdgcn_s_waitcnt(0);
        unsigned nloc = b.st[0], nx = b.st[1];
        if (nloc == 0u) { xcd_barrier_complete(bar, b.x, nloc, nx); b.st[0] = nloc; b.st[1] = nx; }
        const unsigned old = xb_add(&bar[XB_XSUB(b.x)], 1u);
        const unsigned gen = old / nloc;
        if (old + 1u == (gen + 1u) * nloc) {
            __builtin_amdgcn_fence(__ATOMIC_RELEASE, "agent");
            asm volatile("s_waitcnt vmcnt(0)" ::: "memory");
            const unsigned og = xb_add(&bar[XB_TOP], 1u);
            const unsigned tg = og / nx;
            if (og + 1u == (tg + 1u) * nx) xb_add(&bar[XB_TOPGEN], 1u);
            else XB_SPIN(xb_ld(&bar[XB_TOPGEN]) == tg, bar);
            __builtin_amdgcn_fence(__ATOMIC_ACQUIRE, "agent");
            xb_add(&bar[XB_XGEN(b.x)], 1u);
            asm volatile("s_waitcnt vmcnt(0)" ::: "memory");
        } else {
            XB_SPIN(xb_ld(&bar[XB_XGEN(b.x)]) == gen, bar);
            __builtin_amdgcn_fence(__ATOMIC_ACQUIRE, "agent");
            asm volatile("s_waitcnt vmcnt(0)" ::: "memory");
        }
    }
    __syncthreads();
}


constexpr int NPHASES = 2 + 8 * DEPTH;
__global__ void __launch_bounds__(NTHREADS, 2) fwd_kernel(Params P) {
    extern __shared__ __attribute__((aligned(16))) unsigned char lds_raw[];
    LAS unsigned char* lds = (LAS unsigned char*)lds_raw;
    const int tid = threadIdx.x, bid = blockIdx.x, nb = gridDim.x;
    const int lo = P.ph_lo, hi = P.ph_hi;
    volatile LAS unsigned* misc = (volatile LAS unsigned*)(lds + LDS_MISC);
    if (tid < 4) misc[tid] = 0u;
    __syncthreads();
    XcdBarrier bar; bar.bar = (unsigned*)(P.ws + WS_CTL) + CW_BAR; bar.x = 0; bar.st = misc;
    if (hi - lo > 1) bar = xcd_barrier_post((unsigned*)(P.ws + WS_CTL) + CW_BAR, misc);
#define IN(k) (lo <= (k) && (k) < hi)
#define GRIDBAR() do { XcdBarrier b2_ = bar; int z2_ = 0; asm volatile("" : "+s"(z2_)); b2_.bar = bar.bar + z2_; xcd_barrier(b2_); } while (0)
#define SEAM(k) do { if (lo <= (k) && (k) + 1 < hi) GRIDBAR(); } while (0)
#define DUP(bit, call) do { if (PROBE_DUP & (bit)) { GRIDBAR(); call; } } while (0)
    if (IN(0)) { phase_prologue_a(P, lds, tid, bid, nb); DUP(1, phase_prologue_a(P, lds, tid, bid, nb)); SEAM(0); }
    if (IN(1)) { phase_prologue_b(P, tid, bid, nb); SEAM(1); }
#pragma unroll 1
    for (int i = 0; i < DEPTH; ++i) {
        const int pb = 2 + 8 * i, j = i >> 1;
        Params Pl = P; { int z_ = 0; asm volatile("" : "+s"(z_)); Pl.ws = P.ws + z_; }
        int tid_l = threadIdx.x, bid_l = blockIdx.x; asm volatile("" : "+v"(tid_l)); asm volatile("" : "+s"(bid_l));
        const bool last = (i == DEPTH - 1);
        const int Mres = last ? ML : M;
        if ((i & 1) == 0) {
            if (IN(pb + 0)) { phase_gemm_dense<0>(Pl, lds, tid_l, bid_l, nb, (const void*)(Pl.ws + WS_H), (const void*)(Pl.ws + WS_WABIN + (size_t)j * AB_IN * 1024), M, AB_IN, i); DUP(2, phase_gemm_dense<0>(Pl, lds, tid_l, bid_l, nb, (const void*)(Pl.ws + WS_H), (const void*)(Pl.ws + WS_WABIN + (size_t)j * AB_IN * 1024), M, AB_IN, i)); SEAM(pb + 0); }
            if (IN(pb + 1)) { phase_even_mixer(Pl, lds, j, tid_l, bid_l, nb); DUP(4, phase_even_mixer(Pl, lds, j, tid_l, bid_l, nb)); SEAM(pb + 1); }
            if (IN(pb + 3)) { phase_gemm_dense<1>(Pl, lds, tid_l, bid_l, nb, (const bf16*)(Pl.ws + WS_A2), (const bf16*)(Pl.ws + WS_WABOUT) + (size_t)j * 1024 * 1024, Mres, 1024, i); SEAM(pb + 3); }
        } else {
            if (IN(pb + 0)) { phase_gemm_dense<0>(Pl, lds, tid_l, bid_l, nb, (const void*)(Pl.ws + WS_H), (const void*)(Pl.ws + WS_WGIN + (size_t)j * WGIN_STRIDE), M, GLA_IN, i); DUP(2, phase_gemm_dense<0>(Pl, lds, tid_l, bid_l, nb, (const void*)(Pl.ws + WS_H), (const void*)(Pl.ws + WS_WGIN + (size_t)j * WGIN_STRIDE), M, GLA_IN, i)); SEAM(pb + 0); }
            if (IN(pb + 1)) { if (PROBE_DUP & (1 << 16)) { phase_gla_prepass(Pl, lds, j, tid_l, bid_l, nb, (PROBE_DUP >> 17) & 15); GRIDBAR(); } phase_gla_prepass(Pl, lds, j, tid_l, bid_l, nb); DUP(128, phase_gla_prepass(Pl, lds, j, tid_l, bid_l, nb)); GRIDBAR(); phase_gla_scan(Pl, lds, tid_l, bid_l, nb); DUP(8, phase_gla_scan(Pl, lds, tid_l, bid_l, nb)); SEAM(pb + 1); }
            if (IN(pb + 2)) { phase_gla_out(Pl, j, tid_l, bid_l, nb, Mres); DUP(64, phase_gla_out(Pl, j, tid_l, bid_l, nb, Mres)); SEAM(pb + 2); }
            if (IN(pb + 3)) { phase_gemm_dense<1>(Pl, lds, tid_l, bid_l, nb, (const bf16*)(Pl.ws + WS_A2), (const bf16*)(Pl.ws + WS_WGOUT) + (size_t)j * 1024 * 1024, Mres, 1024, i); SEAM(pb + 3); }
        }
        if (IN(pb + 4)) { if (PROBE_DUP & 256) { phase_ln1_router(Pl, lds, i, tid_l, bid_l, nb, Mres, true); GRIDBAR(); } phase_ln1_router(Pl, lds, i, tid_l, bid_l, nb, Mres); SEAM(pb + 4); }
        if (IN(pb + 5)) { if (PROBE_DUP & (1024 | 2048 | 4096 | 8192 | 16384 | 32768)) { phase_moe_gemm<1>(Pl, lds, tid_l, bid_l, nb, i, (PROBE_DUP >> 10) & 63); GRIDBAR(); } phase_moe_gemm<1>(Pl, lds, tid_l, bid_l, nb, i); DUP(16, phase_moe_gemm<1>(Pl, lds, tid_l, bid_l, nb, i)); SEAM(pb + 5); }
        if (IN(pb + 6)) { phase_moe_gemm<2>(Pl, lds, tid_l, bid_l, nb, i); DUP(32, phase_moe_gemm<2>(Pl, lds, tid_l, bid_l, nb, i)); SEAM(pb + 6); }
        if (IN(pb + 7)) { if (PROBE_DUP & 512) { phase_ln2_combine(Pl, lds, i, tid_l, bid_l, nb, Mres, true); GRIDBAR(); } phase_ln2_combine(Pl, lds, i, tid_l, bid_l, nb, Mres); SEAM(pb + 7); }
    }
#undef IN
#undef SEAM
#undef GRIDBAR
}

extern "C" void kernel_launch(void* const* d_in, const int* in_sizes, int n_in, void* d_out, int out_size, void* d_ws, size_t ws_size, hipStream_t stream) {
    static int grid = 0;
    if (grid == 0) {
        if (n_in != 24 || out_size != ML * D || ws_size < WS_END) { fprintf(stderr, "kernel_launch: unexpected problem (n_in %d, out %d, ws %zu < %zu)\n", n_in, out_size, ws_size, (size_t)WS_END); grid = -1; return; }
        int dev = 0, cus = 0, per_cu = 0;
        if (hipGetDevice(&dev) != hipSuccess || hipDeviceGetAttribute(&cus, hipDeviceAttributeMultiprocessorCount, dev) != hipSuccess) { grid = -1; return; }
        if (hipFuncSetAttribute((const void*)fwd_kernel, hipFuncAttributeMaxDynamicSharedMemorySize, LDS_BYTES) != hipSuccess) { fprintf(stderr, "kernel_launch: hipFuncSetAttribute failed\n"); grid = -1; return; }
        if (hipOccupancyMaxActiveBlocksPerMultiprocessor(&per_cu, (const void*)fwd_kernel, NTHREADS, LDS_BYTES) != hipSuccess || per_cu < 1) { fprintf(stderr, "kernel_launch: occupancy query says %d blocks per CU\n", per_cu); }
        (void)hipGetLastError();
        grid = cus;
    }
    if (grid < 0) return;
    (void)hipMemsetAsync((char*)d_ws + WS_CTL, 0, CTL_ZERO_BYTES, stream);
    Params p{};
    for (int i = 0; i < 24; ++i) p.in[i] = (const float*)d_in[i];
    p.out = (float*)d_out; p.ws = (unsigned char*)d_ws;
#if MK_PER_PHASE
    for (int ph = 0; ph < NPHASES; ++ph) {
        if (ph >= 2 && ((ph - 2) & 7) == 2 && ((((ph - 2) >> 3) & 1) == 0)) continue;
        p.ph_lo = ph; p.ph_hi = ph + 1;
        hipLaunchKernelGGL(fwd_kernel, dim3(grid), dim3(NTHREADS), LDS_BYTES, stream, p);
    }
#else
    p.ph_lo = 0; p.ph_hi = NPHASES;
    hipLaunchKernelGGL(fwd_kernel, dim3(grid), dim3(NTHREADS), LDS_BYTES, stream, p);
#endif
    const hipError_t le = hipPeekAtLastError();
    if (le != hipSuccess) fprintf(stderr, "kernel_launch: launch failed: %s\n", hipGetErrorName(le));
}
```

```cpp
#include <hip/hip_runtime.h>
#include <cstdio>
#include <cstdint>

#ifndef MK_PER_PHASE
#define MK_PER_PHASE 0
#endif

#ifndef PROBE_DUP
#define PROBE_DUP 0
#endif
#define LAS __attribute__((address_space(3)))
typedef unsigned short bf16;
typedef short bf16x8 __attribute__((ext_vector_type(8)));
typedef float f32x4 __attribute__((ext_vector_type(4)));
typedef unsigned u32x4 __attribute__((ext_vector_type(4)));
typedef unsigned u32x2 __attribute__((ext_vector_type(2)));

constexpr int D = 1024, NBATCH = 8, T = 4096, NCTX = 256, DEPTH = 4;
constexpr int ML = NBATCH * T, MC = NBATCH * NCTX, M = ML + MC;
constexpr int AB_IN = 2560, GLA_IN = 3104, NE = 32;
constexpr int NSLOT = M * 4;
constexpr float DN_ALPHA = 1.6817928305074292f;
constexpr float LN_EPS = 1e-5f;
constexpr int NTHREADS = 512, NWAVES = 8;

constexpr size_t MiB = 1ull << 20;
constexpr size_t WS_CTL = 0, CTL_ZERO_BYTES = 1 * MiB;
constexpr size_t WS_MODS = 1 * MiB;
constexpr size_t WS_WABIN = 2 * MiB;
constexpr size_t WS_WABOUT = 12 * MiB;
constexpr size_t WS_WGIN = 16 * MiB, WGIN_STRIDE = (size_t)3328 * 1024;
constexpr size_t WS_WGOUT = 29 * MiB;
constexpr size_t WS_W1T = 33 * MiB;
constexpr size_t WS_W2T = 545 * MiB;
constexpr size_t WS_X = 801 * MiB;
constexpr size_t WS_H = 937 * MiB;
constexpr size_t WS_P = 1005 * MiB;
constexpr size_t WS_A2 = 1213 * MiB;
constexpr size_t WS_OF = 1281 * MiB;
constexpr size_t WS_OB = 1417 * MiB;
constexpr size_t WS_ACT = 1553 * MiB;
constexpr size_t WS_YS = 1827 * MiB;
constexpr size_t WS_LIST = 2101 * MiB;
constexpr size_t WS_TOKE = 2106 * MiB;
constexpr size_t WS_TOKP = 2107 * MiB;
constexpr size_t WS_TOKG = 2108 * MiB;
constexpr size_t WS_VT = 2109 * MiB;
constexpr size_t WS_VTC = WS_VT + 48 * MiB;
constexpr size_t WS_GQD = 2165 * MiB;
constexpr size_t WS_GKLT = 2241 * MiB;
constexpr size_t WS_GATT = 2319 * MiB;
constexpr size_t WS_GDEC = 2359 * MiB;
constexpr size_t WS_GVT = 2362 * MiB;
constexpr size_t WS_ROPE = 2440 * MiB;
constexpr size_t WS_H8 = 2442 * MiB;
constexpr size_t WS_RWT = 2477 * MiB;
constexpr size_t WS_END = 2478 * MiB;
constexpr int CW_BAR = 4096;
constexpr int CW_CNT = 8192;

constexpr int LDS_BYTES = 155648;
constexpr int LDS_MISC = 155648 - 256;

struct Params {
    const float* in[24];
    float* out;
    unsigned char* ws;
    int ph_lo, ph_hi;
};

#define LDS_WAIT() asm volatile("s_waitcnt lgkmcnt(0)" ::: "memory")
#define LDS_BARRIER() asm volatile("s_waitcnt lgkmcnt(0)\n\ts_barrier" ::: "memory")
__device__ __forceinline__ unsigned f2bf(float f) { unsigned u = __builtin_bit_cast(unsigned, f); return (u + 0x7fffu + ((u >> 16) & 1u)) >> 16; }
__device__ __forceinline__ float bf2f(unsigned h) { return __builtin_bit_cast(float, h << 16); }
typedef float f32x2 __attribute__((ext_vector_type(2)));
typedef __bf16 bf16x2_t __attribute__((ext_vector_type(2)));
__device__ __forceinline__ unsigned pk2(float lo, float hi) { const f32x2 v = {lo, hi}; const bf16x2_t b = __builtin_convertvector(v, bf16x2_t); return __builtin_bit_cast(unsigned, b); }
template <int CTRL> __device__ __forceinline__ float dppf(float x) { return __builtin_bit_cast(float, __builtin_amdgcn_update_dpp(0, __builtin_bit_cast(int, x), CTRL, 0xf, 0xf, false)); }
__device__ __forceinline__ void swap16(float x, float& a, float& b) { const unsigned u = __builtin_bit_cast(unsigned, x); const auto r = __builtin_amdgcn_permlane16_swap(u, u, false, false); const unsigned r0 = r[0], r1 = r[1]; a = __builtin_bit_cast(float, r0); b = __builtin_bit_cast(float, r1); }
__device__ __forceinline__ void swap32(float x, float& a, float& b) { const unsigned u = __builtin_bit_cast(unsigned, x); const auto r = __builtin_amdgcn_permlane32_swap(u, u, false, false); const unsigned r0 = r[0], r1 = r[1]; a = __builtin_bit_cast(float, r0); b = __builtin_bit_cast(float, r1); }
__device__ __forceinline__ float xsum_16_32(float v) { float a, b; swap16(v, a, b); v = a + b; swap32(v, a, b); return a + b; }
__device__ __forceinline__ float xmax_16_32(float v) { float a, b; swap16(v, a, b); v = fmaxf(a, b); swap32(v, a, b); return fmaxf(a, b); }
__device__ __forceinline__ float wave_sum(float v) {
    v += dppf<0xB1>(v);
    v += dppf<0x4E>(v);
    v += dppf<0x141>(v);
    v += dppf<0x140>(v);
    return xsum_16_32(v);
}
__device__ __forceinline__ f32x4 mfma16(bf16x8 a, bf16x8 b, f32x4 c) { return __builtin_amdgcn_mfma_f32_16x16x32_bf16(a, b, c, 0, 0, 0); }
__device__ __forceinline__ bf16x8 mk_frag(unsigned a, unsigned b, unsigned c, unsigned d) { u32x4 v = {a, b, c, d}; return __builtin_bit_cast(bf16x8, v); }
__device__ __forceinline__ unsigned pk4_fp8(float a, float b, float c, float d) {
    a = fminf(fmaxf(a, -448.f), 448.f); b = fminf(fmaxf(b, -448.f), 448.f); c = fminf(fmaxf(c, -448.f), 448.f); d = fminf(fmaxf(d, -448.f), 448.f);
    int w = 0; w = __builtin_amdgcn_cvt_pk_fp8_f32(a, b, w, false); w = __builtin_amdgcn_cvt_pk_fp8_f32(c, d, w, true); return (unsigned)w; }
__device__ __forceinline__ unsigned pk4_fp8_nc(float a, float b, float c, float d) { int w = 0; w = __builtin_amdgcn_cvt_pk_fp8_f32(a, b, w, false); w = __builtin_amdgcn_cvt_pk_fp8_f32(c, d, w, true); return (unsigned)w; }
constexpr float H8_SCALE = 16.f, ACT8_SCALE = 4.f, W1_SCALE = 256.f, W2_SCALE = 512.f;
constexpr int H8_E8 = 0x7B7B7B7B, ACT8_E8 = 0x7D7D7D7D, W1_E8 = 0x77777777, W2_E8 = 0x76767676;
__device__ __forceinline__ float silu_f(float x) { return x / (1.f + __expf(-x)); }


__device__ __forceinline__ void conv_item(const float* W, int N, int k0, int nsrc, bf16* WT, int ndst, LAS float* scr, int lane) {
#pragma unroll 8
    for (int i = 0; i < 32; ++i) { const int kk = 2 * i + (lane >> 5); scr[kk * 33 + (lane & 31)] = W[(size_t)(k0 + kk) * N + nsrc + (lane & 31)]; }
    LDS_WAIT(); asm volatile("" ::: "memory");
    const int c = lane & 7;
#pragma unroll
    for (int j = 0; j < 4; ++j) { const int n = (lane >> 3) + 8 * j; const LAS float* s = scr + (8 * c) * 33 + n;
        u32x4 o; o.x = pk2(s[0 * 33], s[1 * 33]); o.y = pk2(s[2 * 33], s[3 * 33]); o.z = pk2(s[4 * 33], s[5 * 33]); o.w = pk2(s[6 * 33], s[7 * 33]);
        *(u32x4*)(WT + (size_t)(ndst + n) * 1024 + k0 + 8 * c) = o; }
    LDS_WAIT(); asm volatile("" ::: "memory");
}

__device__ __forceinline__ void conv_item8(const float* W, int N, int k0, int nsrc, unsigned char* WT8, int ndst, float scale, LAS float* scr, int lane) {
#pragma unroll 8
    for (int i = 0; i < 32; ++i) { const int kk = 2 * i + (lane >> 5); scr[kk * 33 + (lane & 31)] = W[(size_t)(k0 + kk) * N + nsrc + (lane & 31)]; }
    LDS_WAIT(); asm volatile("" ::: "memory");
    const int c = lane & 7;
#pragma unroll
    for (int j = 0; j < 4; ++j) { const int n = (lane >> 3) + 8 * j; const LAS float* s = scr + (8 * c) * 33 + n;
        u32x2 o; o.x = pk4_fp8(s[0 * 33] * scale, s[1 * 33] * scale, s[2 * 33] * scale, s[3 * 33] * scale); o.y = pk4_fp8(s[4 * 33] * scale, s[5 * 33] * scale, s[6 * 33] * scale, s[7 * 33] * scale);
        *(u32x2*)(WT8 + (size_t)(ndst + n) * 1024 + k0 + 8 * c) = o; }
    LDS_WAIT(); asm volatile("" ::: "memory");
}

__device__ __forceinline__ void phase_prologue_a(const Params& P, LAS unsigned char* lds, int tid, int bid, int nb) {
    const int lane = tid & 63, wave = tid >> 6;
    unsigned char* ws = P.ws;
    for (int idx = bid * NTHREADS + tid; idx < T * 64; idx += nb * NTHREADS) { const int t = idx >> 6, f = idx & 63;
        const float pos = (f < 32) ? (float)(t >> 6) : (float)(t & 63); const float freq = expf(-(float)(f & 31) * (9.210340371976184f / 32.0f));
        float sn, cn; sincosf(pos * freq, &sn, &cn); ((float*)(ws + WS_ROPE))[idx] = cn; ((float*)(ws + WS_ROPE))[T * 64 + idx] = sn; }
    for (int idx = bid * NTHREADS + tid; idx < DEPTH * 32 * 1024; idx += nb * NTHREADS) { const int l = idx >> 15, e = (idx >> 10) & 31, k = idx & 1023;
        const float w = P.in[18][((size_t)l * 1024 + k) * 32 + e]; const unsigned hi = f2bf(w); const unsigned lo = f2bf(w - bf2f(hi));
        bf16* rwt = (bf16*)(ws + WS_RWT) + (size_t)l * 2 * 32 * 1024; rwt[e * 1024 + k] = (bf16)hi; rwt[32 * 1024 + e * 1024 + k] = (bf16)lo; }
    for (int u = bid; u < 4 * 48; u += nb) {
        const int l = u / 48, j0 = (u % 48) * 128;
        LAS float* sc = (LAS float*)lds;
        LAS float* red = (LAS float*)(lds + 9 * 1024 * 4);
        for (int idx = tid; idx < 9 * 1024; idx += NTHREADS) { const int r = idx >> 10, k = idx & 1023; const float c = (r < 8) ? P.in[1][r * 1024 + k] : P.in[3][k]; sc[idx] = silu_f(c); }
        __syncthreads();
        const int c = tid & 127, kq = tid >> 7;
        float acc[9];
#pragma unroll
        for (int r = 0; r < 9; ++r) acc[r] = 0.f;
        const float* w = P.in[4] + (size_t)l * 1024 * 6144 + j0 + c;
        for (int k = kq * 256; k < kq * 256 + 256; ++k) { const float wv = w[(size_t)k * 6144];
#pragma unroll
            for (int r = 0; r < 9; ++r) acc[r] += sc[r * 1024 + k] * wv; }
#pragma unroll
        for (int r = 0; r < 9; ++r) red[(kq * 9 + r) * 128 + c] = acc[r];
        __syncthreads();
        float* mods = (float*)(ws + WS_MODS);
        for (int idx = tid; idx < 9 * 128; idx += NTHREADS) { const int r = idx >> 7, cc = idx & 127;
            const float s = (red[(0 * 9 + r) * 128 + cc] + red[(1 * 9 + r) * 128 + cc]) + (red[(2 * 9 + r) * 128 + cc] + red[(3 * 9 + r) * 128 + cc]);
            mods[(size_t)(l * 9 + r) * 6144 + j0 + cc] = s + P.in[5][l * 6144 + j0 + cc]; }
        __syncthreads();
    }
    LAS float* scr = (LAS float*)(lds + wave * 16384);
    const int gw = bid * NWAVES + wave, NGW = nb * NWAVES;
    constexpr int I0 = 2 * 16 * 80, I1 = 2 * 16 * 32, I2 = 2 * 16 * 97, I3 = 2 * 16 * 32, I4 = 128 * 16 * 64, I5 = 128 * 16 * 32;
    constexpr int NITEMS = I0 + I1 + I2 + I3 + I4 + I5;
    for (int it = gw; it < NITEMS; it += NGW) {
        int r = it;
        if (r < I0) { const int mt = r / (16 * 80), q = r % (16 * 80), kb = q / 80, nbk = q % 80;
            conv_item8(P.in[8] + (size_t)mt * 1024 * AB_IN, AB_IN, kb * 64, nbk * 32, (unsigned char*)(ws + WS_WABIN) + (size_t)mt * AB_IN * 1024, nbk * 32, W1_SCALE, scr, lane); continue; } r -= I0;
        if (r < I1) { const int mt = r / (16 * 32), q = r % (16 * 32), kb = q / 32, nbk = q % 32;
            conv_item(P.in[12] + (size_t)mt * 1024 * 1024, 1024, kb * 64, nbk * 32, (bf16*)(ws + WS_WABOUT) + (size_t)mt * 1024 * 1024, nbk * 32, scr, lane); continue; } r -= I1;
        if (r < I2) { const int mt = r / (16 * 97), q = r % (16 * 97), kb = q / 97, nbk = q % 97;
            conv_item8(P.in[13] + (size_t)mt * 1024 * GLA_IN, GLA_IN, kb * 64, nbk * 32, (unsigned char*)(ws + WS_WGIN) + (size_t)mt * WGIN_STRIDE, nbk * 32, W1_SCALE, scr, lane); continue; } r -= I2;
        if (r < I3) { const int mt = r / (16 * 32), q = r % (16 * 32), kb = q / 32, nbk = q % 32;
            conv_item(P.in[17] + (size_t)mt * 1024 * 1024, 1024, kb * 64, nbk * 32, (bf16*)(ws + WS_WGOUT) + (size_t)mt * 1024 * 1024, nbk * 32, scr, lane); continue; } r -= I3;
        if (r < I4) { const int mt = r / (16 * 64), q = r % (16 * 64), kb = q / 64, rb = q % 64;
            const int tile = rb >> 3, half = (rb >> 2) & 1, qq = rb & 3; const int nsrc = half * 1024 + tile * 128 + qq * 32;
            conv_item8(P.in[20] + (size_t)mt * 1024 * 2048, 2048, kb * 64, nsrc, (unsigned char*)(ws + WS_W1T) + (size_t)mt * 2048 * 1024, rb * 32, W1_SCALE, scr, lane); continue; } r -= I4;
        { const int mt = r / (16 * 32), q = r % (16 * 32), kb = q / 32, nbk = q % 32;
            conv_item8(P.in[22] + (size_t)mt * 1024 * 1024, 1024, kb * 64, nbk * 32, (unsigned char*)(ws + WS_W2T) + (size_t)mt * 1024 * 1024, nbk * 32, W2_SCALE, scr, lane); }
    }
}

__device__ __forceinline__ void store_h_row(unsigned char* hrow, const f32x4 (&v)[4], const float* shift, const float* scale, int lane) {
#pragma unroll
    for (int j = 0; j < 4; ++j) { const int col = 4 * lane + 256 * j;
        const f32x4 sh = *(const f32x4*)(shift + col), sc = *(const f32x4*)(scale + col);
        *(unsigned*)(hrow + col) = pk4_fp8((v[j].x * (1.f + sc.x) + sh.x) * H8_SCALE, (v[j].y * (1.f + sc.y) + sh.y) * H8_SCALE, (v[j].z * (1.f + sc.z) + sh.z) * H8_SCALE, (v[j].w * (1.f + sc.w) + sh.w) * H8_SCALE); }
}

__device__ __forceinline__ void phase_prologue_b(const Params& P, int tid, int bid, int nb) {
    const int lane = tid & 63, wave = tid >> 6; unsigned char* ws = P.ws;
    const float* mods = (const float*)(ws + WS_MODS);
    for (int m = bid * NWAVES + wave; m < M; m += nb * NWAVES) {
        const float* src = (m < ML) ? P.in[0] + (size_t)m * D : P.in[2] + (size_t)(m - ML) * D;
        const int mb = (m < ML) ? (m >> 12) : 8;
        f32x4 v[4];
#pragma unroll
        for (int j = 0; j < 4; ++j) v[j] = *(const f32x4*)(src + 4 * lane + 256 * j);
        const float* md = mods + (size_t)(0 * 9 + mb) * 6144;
        store_h_row((unsigned char*)(ws + WS_H) + (size_t)m * D, v, md + 0, md + 1024, lane);
    }
}


namespace g8 {
constexpr int BM = 256, BK = 64, HALF = 128, HTB = HALF * BK * 2, STAGE_BYTES = 8 * HTB, NXCD = 8, WGM = 8, KDIM = 1024, NT = KDIM / BK;
__device__ __forceinline__ int lds_byte(int r, int c) { const int st = (r >> 4) * 2 + (c >> 5), rr = r & 15, cc = c & 31, ob = rr * 64 + cc * 2; return st * 1024 + (ob ^ (((ob >> 9) & 1) << 5)); }
__device__ __forceinline__ void stage_rc(int b, int& R, int& C) { const int st = b / 1024, sb = b % 1024, swz = sb ^ (((sb >> 9) & 1) << 5); R = (st >> 1) * 16 + swz / 64; C = (st & 1) * 32 + (swz % 64) / 2; }
template <bool FP8> __device__ __forceinline__ void stage_rcb(int b, int& R, int& CB) { const int st = b / 1024, sb = b % 1024, swz = sb ^ (((sb >> 9) & 1) << 5); R = (st >> 1) * 16 + swz / 64;
    CB = FP8 ? (2 * ((swz % 64) >> 4) + (st & 1)) * 16 : (st & 1) * 64 + (swz % 64); }
__device__ __forceinline__ int perm32(int rho) { const int n = rho >> 4, i = rho & 15; return 8 * (i >> 2) + 4 * n + (i & 3); }

struct Unit { int pm, pn, ui, e, nvalid; unsigned slot0; };
typedef int i32x8 __attribute__((ext_vector_type(8)));
typedef int i32x4 __attribute__((ext_vector_type(4)));
__device__ __forceinline__ i32x8 cat8(bf16x8 lo, bf16x8 hi) { const u32x4 a = __builtin_bit_cast(u32x4, lo), c = __builtin_bit_cast(u32x4, hi); return (i32x8){(int)a.x, (int)a.y, (int)a.z, (int)a.w, (int)c.x, (int)c.y, (int)c.z, (int)c.w}; }

template <class Prob, class Epi>
__device__ __forceinline__ void gemm_phase(LAS unsigned char* lds, const Prob& S, const Epi& E, int tid) {
    const int wid = __builtin_amdgcn_readfirstlane(tid >> 6), wr = wid >> 2, wc = wid & 3;
    constexpr int ROWB = Prob::FP8 ? KDIM : KDIM * 2;
    constexpr int NTK = Prob::FP8 ? NT / 2 : NT;
    unsigned voffB; { int R0, CB; stage_rcb<Prob::FP8>(tid * 16, R0, CB); const int Rb = Epi::PERM ? ((R0 & ~31) + perm32(R0 & 31)) : R0; voffB = (unsigned)(Rb * ROWB + CB); }
    constexpr size_t kstep = (size_t)(BK * 2);
    constexpr size_t hstep = (size_t)HALF * ROWB;
    constexpr size_t pstep = (size_t)64 * ROWB;
    const unsigned ldsw = (unsigned)wid * 1024u;
    int aoff, boff; { const int fr = tid & 15, fq = (tid >> 4) & 3; aoff = lds_byte(wr * 64 + fr, fq * 8); boff = lds_byte(wc * 32 + fr, fq * 8); }
#define PG8_SA(b, h) (((b) * 2 + (h)) * HTB)
#define PG8_SB(b, h) ((4 + (b) * 2 + (h)) * HTB)
#define PG8_GLDS2(sbase, voff, ldsoff) do { const char* _sb = (const char*)(sbase); asm volatile("" : "+s"(_sb)); unsigned _vo = (voff); asm volatile("" : "+v"(_vo)); __builtin_amdgcn_global_load_lds((const unsigned*)(_sb + _vo), (LAS unsigned*)(lds + (ldsoff)), 16, 0, 0); } while (0)
#define PG8_STAGE_B(bufoff, gbase) do { PG8_GLDS2((const char*)(gbase), voffB, (bufoff) + ldsw); PG8_GLDS2((const char*)(gbase) + pstep, voffB, (bufoff) + ldsw + 8192); } while (0)
#define PG8_STAGE_A(bufoff, gbase, h) do { if (Prob::GATHER) { PG8_GLDS2((const char*)(gbase), vA[h][0], (bufoff) + ldsw); PG8_GLDS2((const char*)(gbase), vA[h][1], (bufoff) + ldsw + 8192); } \
        else { PG8_GLDS2((const char*)(gbase) + (h) * hstep, vA[0][0], (bufoff) + ldsw); PG8_GLDS2((const char*)(gbase) + (h) * hstep + pstep, vA[0][0], (bufoff) + ldsw + 8192); } } while (0)
#define PG8_LDA(dst, b, h) do { _Pragma("unroll") for (int m = 0; m < 4; ++m) _Pragma("unroll") for (int k = 0; k < 2; ++k) dst[m][k] = *(const LAS bf16x8*)(lds + PG8_SA(b, h) + aoff + m * 2048 + k * 1024); } while (0)
#define PG8_LDB(dst, b, h) do { _Pragma("unroll") for (int n = 0; n < 2; ++n) _Pragma("unroll") for (int k = 0; k < 2; ++k) dst[n][k] = *(const LAS bf16x8*)(lds + PG8_SB(b, h) + boff + n * 2048 + k * 1024); } while (0)
#define PG8_MMA(ai, bj, At, Bt) do { __builtin_amdgcn_s_setprio(1); _Pragma("unroll") for (int m = 0; m < 4; ++m) _Pragma("unroll") for (int n = 0; n < 2; ++n) { \
        if constexpr (Prob::FP8) acc[ai][bj][m][n] = __builtin_amdgcn_mfma_scale_f32_16x16x128_f8f6f4(cat8(Bt[n][0], Bt[n][1]), cat8(At[m][0], At[m][1]), acc[ai][bj][m][n], 0, 0, 0, Prob::SCALE_B, 0, Prob::SCALE_A); \
        else { _Pragma("unroll") for (int k = 0; k < 2; ++k) acc[ai][bj][m][n] = __builtin_amdgcn_mfma_f32_16x16x32_bf16(Bt[n][k], At[m][k], acc[ai][bj][m][n], 0, 0, 0); } } __builtin_amdgcn_s_setprio(0); } while (0)
#define PG8_WAIT_V(n) asm volatile("s_waitcnt vmcnt(" #n ")" ::: "memory")
#define PG8_WAIT_L(n) asm volatile("s_waitcnt lgkmcnt(" #n ")" ::: "memory")
#define PG8_BAR __builtin_amdgcn_s_barrier()
#define PG8_SCHED __builtin_amdgcn_sched_barrier(0)
    Unit cur, nxt; int ui = 0;
    if (!S.next(0, cur)) return;
    f32x4 acc[2][2][4][2];
#pragma unroll
    for (int a = 0; a < 2; ++a)
#pragma unroll
        for (int b = 0; b < 2; ++b)
#pragma unroll
            for (int m = 0; m < 4; ++m)
#pragma unroll
                for (int n = 0; n < 2; ++n) acc[a][b][m][n] = (f32x4){0.f, 0.f, 0.f, 0.f};
    bf16x8 At[4][2], B0[2][2], B1[2][2];
    const char* cA = S.a_base(cur); const char* cB = S.b_base(cur);
    unsigned vA[2][2];
    S.a_voff(cur, tid, vA);
    PG8_STAGE_B(PG8_SB(0, 0), cB); PG8_STAGE_B(PG8_SB(0, 1), cB + hstep); PG8_STAGE_A(PG8_SA(0, 0), cA, 0); PG8_STAGE_A(PG8_SA(0, 1), cA, 1);
    if (wr == 1) PG8_BAR;
    PG8_WAIT_V(2); PG8_BAR;
    PG8_STAGE_B(PG8_SB(1, 0), cB + kstep); PG8_STAGE_A(PG8_SA(1, 0), cA + kstep, 0); PG8_STAGE_B(PG8_SB(1, 1), cB + hstep + kstep);
    PG8_WAIT_V(6); PG8_BAR;
    for (;;) {
        const bool has_next = S.next(ui + 1, nxt);
        const char* nA = cA; const char* nB = cB;
        unsigned vN[2];
        if (has_next) { nA = S.a_base(nxt); nB = S.b_base(nxt); if (Prob::GATHER) S.a_tok(nxt, tid, vN); }
#pragma unroll 1
        for (int t = 0; t < NTK; t += 2) {
            const bool last = (t == NTK - 2);
            const char* a1 = cA + (size_t)(t + 1) * kstep;
            const char* a2 = last ? nA : cA + (size_t)(t + 2) * kstep; const char* b2 = last ? nB : cB + (size_t)(t + 2) * kstep;
            const char* a3 = a2 + kstep; const char* b3 = b2 + kstep;
            PG8_LDB(B0, 0, 0); PG8_LDB(B1, 0, 1); PG8_SCHED; PG8_LDA(At, 0, 0); PG8_STAGE_A(PG8_SA(1, 1), a1, 1);
            PG8_WAIT_V(8); PG8_WAIT_L(0); PG8_BAR; PG8_MMA(0, 0, At, B0); PG8_MMA(0, 1, At, B1); PG8_BAR; PG8_SCHED;
            if (Prob::GATHER) { if (last && has_next) { int R0, CB; stage_rcb<Prob::FP8>(tid * 16, R0, CB); const unsigned c2 = (unsigned)CB; constexpr int SH = Prob::FP8 ? 10 : 11; vA[0][0] = ((vN[0] & 0xffffu) << SH) | c2; vA[0][1] = ((vN[0] >> 16) << SH) | c2; vA[1][0] = ((vN[1] & 0xffffu) << SH) | c2; vA[1][1] = ((vN[1] >> 16) << SH) | c2; } }
            PG8_LDA(At, 0, 1); PG8_STAGE_B(PG8_SB(0, 0), b2); PG8_STAGE_B(PG8_SB(0, 1), b2 + hstep); PG8_STAGE_A(PG8_SA(0, 0), a2, 0);
            PG8_WAIT_V(8); PG8_WAIT_L(0); PG8_BAR; PG8_MMA(1, 0, At, B0); PG8_MMA(1, 1, At, B1); PG8_BAR; PG8_SCHED;
            PG8_LDB(B0, 1, 0); PG8_LDB(B1, 1, 1); PG8_SCHED; PG8_LDA(At, 1, 0); PG8_STAGE_A(PG8_SA(0, 1), a2, 1);
            PG8_WAIT_V(8); PG8_WAIT_L(0); PG8_BAR; PG8_MMA(0, 0, At, B0); PG8_MMA(0, 1, At, B1); PG8_BAR; PG8_SCHED;
            PG8_LDA(At, 1, 1); PG8_STAGE_B(PG8_SB(1, 0), b3); PG8_STAGE_B(PG8_SB(1, 1), b3 + hstep); PG8_STAGE_A(PG8_SA(1, 0), a3, 0);
            PG8_WAIT_V(8); PG8_WAIT_L(0); PG8_BAR; PG8_MMA(1, 0, At, B0); PG8_MMA(1, 1, At, B1); PG8_BAR; PG8_SCHED;
        }
        if (wr == 0) PG8_BAR;
        { int t_e = tid; asm volatile("" : "+v"(t_e)); int fr_e = t_e & 15, fq_e = (t_e >> 4) & 3;
          E(acc, cur, wr, wc, fr_e, fq_e); }
        if (!has_next) break;
#pragma unroll
        for (int a = 0; a < 2; ++a)
#pragma unroll
            for (int b = 0; b < 2; ++b)
#pragma unroll
                for (int m = 0; m < 4; ++m)
#pragma unroll
                    for (int n = 0; n < 2; ++n) acc[a][b][m][n] = (f32x4){0.f, 0.f, 0.f, 0.f};
        cur = nxt; cA = nA; cB = nB; ++ui;
        if (wr == 1) PG8_BAR;
    }
    PG8_WAIT_V(0);
    PG8_BAR;
#undef PG8_SA
#undef PG8_SB
#undef PG8_GLDS2
#undef PG8_STAGE_A
#undef PG8_STAGE_B
#undef PG8_LDA
#undef PG8_LDB
#undef PG8_MMA
#undef PG8_WAIT_V
#undef PG8_WAIT_L
#undef PG8_BAR
#undef PG8_SCHED
}

template <bool F8>
struct DenseProb {
    const void* A; const void* Bt; int nM, nN, nwg, G, c;
    __device__ __forceinline__ void init(const void* A_, const void* Bt_, int Mrows, int Npad, int G_, int c_) { A = A_; Bt = Bt_; nM = Mrows / BM; nN = Npad / BM; nwg = nM * nN; G = G_; c = c_; }
    __device__ __forceinline__ bool next(int i, Unit& u) const {
        const long L = (long)i * G + c; if (L >= nwg) return false;
        int wgid = (int)L; { const int q = nwg / NXCD, r = nwg % NXCD, xcd = wgid % NXCD, off = wgid / NXCD; wgid = (xcd < r ? xcd * (q + 1) : r * (q + 1) + (xcd - r) * q) + off; }
        const int nig = WGM * nN, gid = wgid / nig, fm = gid * WGM, gsz = (nM - fm) < WGM ? (nM - fm) : WGM;
        u.pm = fm + ((wgid % nig) % gsz); u.pn = (wgid % nig) / gsz; u.ui = i; u.e = 0; u.nvalid = 256; u.slot0 = 0; return true;
    }
    static constexpr int RB_ = F8 ? KDIM : KDIM * 2;
    __device__ __forceinline__ const char* a_base(const Unit& u) const { return (const char*)A + (size_t)u.pm * BM * RB_; }
    __device__ __forceinline__ const char* b_base(const Unit& u) const { return (const char*)Bt + (size_t)u.pn * BM * RB_; }
    static constexpr bool GATHER = false, FP8 = F8; static constexpr int SCALE_A = H8_E8, SCALE_B = W1_E8;
    __device__ __forceinline__ void a_voff(const Unit&, int tid, unsigned (&v)[2][2]) const { int R0, CB; stage_rcb<F8>(tid * 16, R0, CB); v[0][0] = (unsigned)(R0 * RB_ + CB); }
    __device__ __forceinline__ void a_tok(const Unit&, int, unsigned (&)[2]) const {}
};

constexpr int MOE_IDX = STAGE_BYTES;
constexpr int MOE_MAXU = 40;
constexpr int MOE_TAB = MOE_IDX + MOE_MAXU * 512;
constexpr int TB_XN = 130, TB_XE = 138, TB_XUP = 394;
constexpr int MOE_UT = MOE_TAB + 2688;
template <int WHICH>
struct MoeProb {
    const unsigned char* A; const unsigned char* Wt; LAS unsigned char* lds; int nunits, G, c, xy; int same;
    static constexpr int nN = (WHICH == 1) ? 8 : 4;
    static constexpr bool FP8 = true; static constexpr int SCALE_A = (WHICH == 1) ? H8_E8 : ACT8_E8, SCALE_B = (WHICH == 1) ? W1_E8 : W2_E8;
    __device__ __forceinline__ void fill_units(int tid) const {
        if (tid < MOE_MAXU) { const LAS int* tab = (const LAS int*)(lds + MOE_TAB); int L = tid * G + c;
            if (xy >= 0) { const int x = xy & 7, y = xy >> 3, q = nunits >> 3, rr = nunits & 7, len = q + (x < rr ? 1 : 0), li = tid * (G >> 3) + y; L = (li < len) ? x * q + min(x, rr) + li : nunits; }
            i32x4 r = {-1, 0, 0, 0};
            if (L < nunits) { const int tt = L / nN, pn = L % nN; int e = 0;
                for (int q = 1; q < 32; ++q) e = (tab[32 + q] <= tt) ? q : e;
                const int tl = tt - tab[32 + e], cnt = tab[e];
                r = (i32x4){e | (pn << 8), tl, min(cnt - tl * 256, 256), tab[96 + e] + tl * 256}; }
            ((LAS i32x4*)(lds + MOE_UT))[tid] = r; }
    }
    __device__ __forceinline__ bool next(int i, Unit& u) const {
        if (i >= MOE_MAXU) return false;
        const i32x4 r = ((const LAS i32x4*)(lds + MOE_UT))[i];
        const int w0 = __builtin_amdgcn_readfirstlane(r.x); if (w0 < 0) return false;
        u.e = w0 & 255; u.pn = w0 >> 8; u.ui = i; u.pm = __builtin_amdgcn_readfirstlane(r.y); u.nvalid = __builtin_amdgcn_readfirstlane(r.z); u.slot0 = (unsigned)__builtin_amdgcn_readfirstlane(r.w); return true;
    }
    __device__ __forceinline__ const char* a_base(const Unit& u) const { return (WHICH == 1) ? (const char*)A : (const char*)A + (size_t)u.slot0 * KDIM; }
    __device__ __forceinline__ const char* b_base(const Unit& u) const { return same ? (const char*)Wt : (const char*)Wt + ((size_t)u.e * (nN * 256) + (size_t)u.pn * 256) * KDIM; }
    static constexpr bool GATHER = (WHICH == 1);
    __device__ __forceinline__ void a_voff(const Unit& u, int tid, unsigned (&v)[2][2]) const {
        int R0, CB; stage_rcb<true>(tid * 16, R0, CB);
        if (WHICH == 1) { const LAS unsigned short* idx = (const LAS unsigned short*)(lds + MOE_IDX) + u.ui * 256;
#pragma unroll
            for (int h = 0; h < 2; ++h)
#pragma unroll
                for (int i = 0; i < 2; ++i) v[h][i] = (unsigned)(idx[h * HALF + i * 64 + R0] * KDIM + CB);
        } else v[0][0] = (unsigned)(R0 * KDIM + CB);
    }
    __device__ __forceinline__ void a_tok(const Unit& u, int tid, unsigned (&v)[2]) const {
        if (WHICH == 1) { int R0, CB; stage_rcb<true>(tid * 16, R0, CB); const LAS unsigned short* idx = (const LAS unsigned short*)(lds + MOE_IDX) + u.ui * 256;
            v[0] = (unsigned)idx[R0] | ((unsigned)idx[64 + R0] << 16); v[1] = (unsigned)idx[HALF + R0] | ((unsigned)idx[HALF + 64 + R0] << 16); }
    }
};

struct EpiP {
    static constexpr bool PERM = true;
    bf16* out; int ncols; bf16* vt;
    __device__ __forceinline__ void operator()(const f32x4 (&acc)[2][2][4][2], const Unit& u, int wr, int wc, int fr, int fq) const {
        if (vt != nullptr && ncols == GLA_IN && u.pn >= 4 && u.pn < 8) {
            const int row0 = u.pm * BM;
#pragma unroll
            for (int bj = 0; bj < 2; ++bj) { const int e0 = u.pn * BM + bj * HALF + wc * 32 + 8 * fq - 1024;
#pragma unroll
                for (int ai = 0; ai < 2; ++ai)
#pragma unroll
                    for (int m = 0; m < 4; ++m) { const int rl = ai * HALF + wr * 64 + m * 16 + fr; const int c = (row0 + rl) >> 6, i = rl & 63;
                        bf16* p = vt + ((size_t)c * 1024 + e0) * 72 + i;
#pragma unroll
                        for (int n = 0; n < 2; ++n) { const unsigned w0 = pk2(acc[ai][bj][m][n][0], acc[ai][bj][m][n][1]), w1 = pk2(acc[ai][bj][m][n][2], acc[ai][bj][m][n][3]);
                            p[(4 * n + 0) * 72] = (bf16)(w0 & 0xffffu); p[(4 * n + 1) * 72] = (bf16)(w0 >> 16); p[(4 * n + 2) * 72] = (bf16)(w1 & 0xffffu); p[(4 * n + 3) * 72] = (bf16)(w1 >> 16); } } }
            return;
        }
        if (vt != nullptr && ncols == AB_IN && u.pn >= 7) {
            const int row0 = u.pm * BM;
            bf16* base; int tl, tok0;
            if (row0 < ML) { base = vt + (size_t)(row0 >> 12) * 12 * 64 * T; tl = T; tok0 = row0 & (T - 1); }
            else { base = vt + (size_t)(WS_VTC - WS_VT) / 2 + (size_t)((row0 - ML) >> 8) * 12 * 64 * NCTX; tl = NCTX; tok0 = 0; }
#pragma unroll
            for (int bj = 0; bj < 2; ++bj) { const int c = u.pn * BM + bj * HALF + wc * 32 + 8 * fq - 1792;
                bf16* cb = base + (size_t)c * tl + tok0 + wr * 64 + fr;
#pragma unroll
                for (int ai = 0; ai < 2; ++ai)
#pragma unroll
                    for (int m = 0; m < 4; ++m) { bf16* p = cb + ai * HALF + m * 16;
#pragma unroll
                        for (int n = 0; n < 2; ++n) { const unsigned w0 = pk2(acc[ai][bj][m][n][0], acc[ai][bj][m][n][1]), w1 = pk2(acc[ai][bj][m][n][2], acc[ai][bj][m][n][3]);
                            p[(size_t)(4 * n + 0) * tl] = (bf16)(w0 & 0xffffu); p[(size_t)(4 * n + 1) * tl] = (bf16)(w0 >> 16); p[(size_t)(4 * n + 2) * tl] = (bf16)(w1 & 0xffffu); p[(size_t)(4 * n + 3) * tl] = (bf16)(w1 >> 16); } } }
            return;
        }
#pragma unroll
        for (int ai = 0; ai < 2; ++ai)
#pragma unroll
            for (int m = 0; m < 4; ++m) { const size_t row = (size_t)u.pm * BM + ai * HALF + wr * 64 + m * 16 + fr;
#pragma unroll
                for (int bj = 0; bj < 2; ++bj) { const int col = u.pn * BM + bj * HALF + wc * 32 + 8 * fq;
                    if (col < ncols) { const f32x4 v0 = acc[ai][bj][m][0], v1 = acc[ai][bj][m][1];
                        u32x4 w; w.x = pk2(v0[0], v0[1]); w.y = pk2(v0[2], v0[3]); w.z = pk2(v1[0], v1[1]); w.w = pk2(v1[2], v1[3]);
                        *(u32x4*)(out + row * ncols + col) = w; } } }
    }
};
struct EpiResid {
    static constexpr bool PERM = false;
    float* X; const float* gate_base;
    __device__ __forceinline__ void operator()(const f32x4 (&acc)[2][2][4][2], const Unit& u, int wr, int wc, int fr, int fq) const {
#pragma unroll
        for (int ai = 0; ai < 2; ++ai)
#pragma unroll
            for (int m = 0; m < 4; ++m) { const size_t row = (size_t)u.pm * BM + ai * HALF + wr * 64 + m * 16 + fr; const int mb = (row < (size_t)ML) ? (int)(row >> 12) : 8;
#pragma unroll
                for (int bj = 0; bj < 2; ++bj)
#pragma unroll
                    for (int n = 0; n < 2; ++n) { const int col = u.pn * BM + bj * HALF + wc * 32 + n * 16 + 4 * fq;
                        const f32x4 g = *(const f32x4*)(gate_base + (size_t)mb * 6144 + col); float* xp = X + row * D + col; const f32x4 x = *(const f32x4*)xp;
                        *(f32x4*)xp = x * DN_ALPHA + g * acc[ai][bj][m][n]; } }
    }
};
struct EpiSwiglu {
    static constexpr bool PERM = true;
    unsigned char* act; const float* b1_base; int dbg;
    __device__ __forceinline__ void operator()(const f32x4 (&acc)[2][2][4][2], const Unit& u, int wr, int wc, int fr, int fq) const {
        if (dbg & 2) return;
        const float* b1 = b1_base + (size_t)u.e * 2048; const int gcol = u.pn * HALF + wc * 32 + 8 * fq;
        f32x4 bg[2], bl[2];
#pragma unroll
        for (int n = 0; n < 2; ++n) { if (dbg & 8) { bg[n] = (f32x4){0.f, 0.f, 0.f, 0.f}; bl[n] = bg[n]; } else { bg[n] = *(const f32x4*)(b1 + gcol + 4 * n); bl[n] = *(const f32x4*)(b1 + 1024 + gcol + 4 * n); } }
        __builtin_amdgcn_s_waitcnt(0x0F70);
#pragma unroll
        for (int ai = 0; ai < 2; ++ai)
#pragma unroll
            for (int m = 0; m < 4; ++m) { const int rl = ai * HALF + wr * 64 + m * 16 + fr;
                if (rl < u.nvalid) { float o[8];
#pragma unroll
                    for (int n = 0; n < 2; ++n)
#pragma unroll
                        for (int jp = 0; jp < 2; ++jp) {
                            f32x2 g = (f32x2){acc[ai][0][m][n][2 * jp], acc[ai][0][m][n][2 * jp + 1]} + (f32x2){bg[n][2 * jp], bg[n][2 * jp + 1]};
                            f32x2 l = (f32x2){acc[ai][1][m][n][2 * jp], acc[ai][1][m][n][2 * jp + 1]} + (f32x2){bl[n][2 * jp], bl[n][2 * jp + 1]};
                            if (dbg & 1) { o[4 * n + 2 * jp] = g.x + l.x; o[4 * n + 2 * jp + 1] = g.y + l.y; } else {
                                g.x = fminf(g.x, 7.0f); g.y = fminf(g.y, 7.0f); l.x = fminf(fmaxf(l.x, -7.0f), 7.0f); l.y = fminf(fmaxf(l.y, -7.0f), 7.0f);
                                const f32x2 t = g * (f32x2){-1.702f * 1.44269504f, -1.702f * 1.44269504f};
                                const f32x2 a = (f32x2){__builtin_amdgcn_exp2f(t.x), __builtin_amdgcn_exp2f(t.y)} + (f32x2){1.f, 1.f};
                                const f32x2 sg = g * (f32x2){__builtin_amdgcn_rcpf(a.x), __builtin_amdgcn_rcpf(a.y)};
                                const f32x2 ov = sg * (l * (f32x2){ACT8_SCALE, ACT8_SCALE} + (f32x2){ACT8_SCALE, ACT8_SCALE});
                                o[4 * n + 2 * jp] = ov.x; o[4 * n + 2 * jp + 1] = ov.y; } }
                    u32x2 w; w.x = pk4_fp8_nc(o[0], o[1], o[2], o[3]); w.y = pk4_fp8_nc(o[4], o[5], o[6], o[7]);
                    if (!(dbg & 4) || w.x == 0x12345u) *(u32x2*)(act + ((size_t)u.slot0 + rl) * 1024 + gcol) = w; }
                __builtin_amdgcn_sched_barrier(0); }
    }
};
struct EpiYs {
    static constexpr bool PERM = true;
    bf16* ys; const float* b2_base;
    __device__ __forceinline__ void operator()(const f32x4 (&acc)[2][2][4][2], const Unit& u, int wr, int wc, int fr, int fq) const {
        const float* b2 = b2_base + (size_t)u.e * 1024;
        f32x4 bb[2][2];
#pragma unroll
        for (int bj = 0; bj < 2; ++bj)
#pragma unroll
            for (int n = 0; n < 2; ++n) bb[bj][n] = *(const f32x4*)(b2 + u.pn * BM + bj * HALF + wc * 32 + 8 * fq + 4 * n);
        __builtin_amdgcn_s_waitcnt(0x0F70);
#pragma unroll
        for (int ai = 0; ai < 2; ++ai)
#pragma unroll
            for (int m = 0; m < 4; ++m) { const int rl = ai * HALF + wr * 64 + m * 16 + fr;
                if (rl < u.nvalid) {
#pragma unroll
                    for (int bj = 0; bj < 2; ++bj) { const int col = u.pn * BM + bj * HALF + wc * 32 + 8 * fq;
                        const f32x4 v0 = acc[ai][bj][m][0] + bb[bj][0], v1 = acc[ai][bj][m][1] + bb[bj][1];
                        u32x4 w; w.x = pk2(v0[0], v0[1]); w.y = pk2(v0[2], v0[3]); w.z = pk2(v1[0], v1[1]); w.w = pk2(v1[2], v1[3]);
                        *(u32x4*)(ys + ((size_t)u.slot0 + rl) * 1024 + col) = w; } } }
    }
};
}

template <int KIND>
__device__ __forceinline__ void phase_gemm_dense(const Params& P, LAS unsigned char* lds, int tid, int bid, int nb, const void* A, const void* Wt, int Mrows, int N, int layer) {
    unsigned char* ws = P.ws;
    if (KIND == 0) { g8::DenseProb<true> S; S.init(A, Wt, Mrows, (N + 255) & ~255, nb, bid);
        g8::EpiP e{(bf16*)(ws + WS_P), N, (N == AB_IN) ? (bf16*)(ws + WS_VT) : (bf16*)(ws + WS_GVT)}; g8::gemm_phase(lds, S, e, tid); }
    else { g8::DenseProb<false> S; S.init(A, Wt, Mrows, (N + 255) & ~255, nb, bid);
        g8::EpiP e{(bf16*)(ws + WS_P), 1024, (bf16*)nullptr}; g8::gemm_phase(lds, S, e, tid); }
}

template <int NN>
__device__ __forceinline__ void moe_tables(const Params& P, LAS unsigned char* lds, int tid, int layer) {
    LAS int* tab = (LAS int*)(lds + g8::MOE_TAB);
    __syncthreads();
    if (tid < 32) tab[tid] = (int)__hip_atomic_load((const unsigned*)(P.ws + WS_CTL) + CW_CNT + layer * 32 + tid, __ATOMIC_RELAXED, __HIP_MEMORY_SCOPE_AGENT);
    __syncthreads();
    if (tid == 0) { int tp = 0, rb = 0;
        for (int e = 0; e < 32; ++e) { const int c = tab[e]; tab[32 + e] = tp; tab[96 + e] = rb; tp += (c + 255) >> 8; rb += c; }
        tab[32 + 32] = tp; tab[96 + 32] = rb;
        if (NN > 0) {
            int load[8]; unsigned taken = 0u;
            for (int x = 0; x < 8; ++x) { load[x] = 0; tab[g8::TB_XN + x] = 0; tab[g8::TB_XUP + x * 33] = 0; }
            for (int it = 0; it < 32; ++it) { int be = -1, bt = -1;
                for (int e = 0; e < 32; ++e) { const int t = (tab[e] + 255) >> 8; if (!((taken >> e) & 1u) && t > bt) { bt = t; be = e; } }
                taken |= 1u << be;
                int bx = 0; for (int x = 1; x < 8; ++x) if (load[x] < load[bx]) bx = x;
                const int n = tab[g8::TB_XN + bx]; tab[g8::TB_XE + bx * 32 + n] = be; tab[g8::TB_XUP + bx * 33 + n + 1] = tab[g8::TB_XUP + bx * 33 + n] + bt * NN; tab[g8::TB_XN + bx] = n + 1; load[bx] += bt; } } }
    __syncthreads();
}
template <int WHICH>
__device__ __forceinline__ void phase_moe_gemm(const Params& P, LAS unsigned char* lds, int tid, int bid, int nb, int layer, int dbg = 0) {
    unsigned char* ws = P.ws;
    moe_tables<0>(P, lds, tid, layer);
    const LAS int* tab = (const LAS int*)(lds + g8::MOE_TAB);
    g8::MoeProb<WHICH> S; S.lds = lds; S.G = nb; S.c = bid; S.xy = ((nb & 7) == 0) ? bid : -1;        S.same = (dbg & 16) ? 1 : 0; S.nunits = __builtin_amdgcn_readfirstlane(tab[64]) * g8::MoeProb<WHICH>::nN;
    S.fill_units(tid); __syncthreads();
    if (WHICH == 1) {
        S.A = (const unsigned char*)(ws + WS_H8); S.Wt = (const unsigned char*)(ws + WS_W1T) + (size_t)layer * 32 * 2048 * 1024;
        const int* list = (const int*)(ws + WS_LIST); LAS unsigned short* idx = (LAS unsigned short*)(lds + g8::MOE_IDX);
        { const LAS g8::i32x4* ut = (const LAS g8::i32x4*)(lds + g8::MOE_UT);
#pragma unroll 4
          for (int ent = tid; ent < g8::MOE_MAXU * 256; ent += NTHREADS) { const int i = ent >> 8, r = ent & 255; const g8::i32x4 q = ut[i];
              if (q.x >= 0) idx[ent] = (unsigned short)((r < q.z) ? list[(size_t)(q.x & 255) * M + q.y * 256 + r] : 0); } }
        __syncthreads();
        g8::EpiSwiglu e{(unsigned char*)(ws + WS_ACT), P.in[21] + (size_t)layer * 32 * 2048, dbg};
        g8::gemm_phase(lds, S, e, tid);
    } else {
        S.A = (const unsigned char*)(ws + WS_ACT); S.Wt = (const unsigned char*)(ws + WS_W2T) + (size_t)layer * 32 * 1024 * 1024;
        g8::EpiYs e{(bf16*)(ws + WS_YS), P.in[23] + (size_t)layer * 32 * 1024};
        g8::gemm_phase(lds, S, e, tid);
    }
}

constexpr int NA_RPB_OFF = 102400;
constexpr int NA_KC_OFF = 0, NA_VC_OFF = 32768, NA_VC_PITCH = 544, NA_KW_OFF = 67584, NA_KW_PITCH = 144, NA_KW_ROW = 64 * 144, NA_RPB2 = NA_KW_OFF + 9 * NA_KW_ROW;
template <bool ISCTX, bool CTXLDS>
__device__ __forceinline__ void na_wave_unit(const Params& P, LAS unsigned char* lds, int v, int lane) {
    const bf16* PB = (const bf16*)(P.ws + WS_P);
    bf16* A2 = (bf16*)(P.ws + WS_A2);
    const int fr = lane & 15, fq = lane >> 4;
    int b, h, r = 0, jb = 0; size_t mq0;
    if (!ISCTX) { jb = v & 3; r = (v >> 2) & 63; h = (v >> 8) % 12; b = v / (256 * 12); mq0 = (size_t)b * T + r * 64 + jb * 16; }
    else { const int qb = v & 15; h = (v >> 4) % 12; b = v / (16 * 12); mq0 = (size_t)ML + b * NCTX + qb * 16; }
    const int row_start = min(max(r - 4, 0), 56);
    const int band_start = min(max(jb * 16 - 8, 0), 32);
    const int kap = 8 * (fr >> 2) + (fr & 3);
    const bf16* kwin = PB + ((size_t)b * T + (size_t)row_start * 64 + band_start + kap) * AB_IN + 1024 + h * 64 + fq * 8;
    const bf16* kctx = PB + ((size_t)ML + (size_t)b * NCTX + kap) * AB_IN + 1024 + h * 64 + fq * 8;
    const bf16* vtl = (const bf16*)(P.ws + WS_VT) + ((size_t)(b * 12 + h) * 64 + fr) * T + (size_t)row_start * 64 + band_start + 8 * fq;
    const bf16* vtc = (const bf16*)(P.ws + WS_VTC) + ((size_t)(b * 12 + h) * 64 + fr) * NCTX + 8 * fq;
    const bf16* qp = PB + (mq0 + fr) * AB_IN + 256 + h * 64 + fq * 8;
    const bf16x8 qf0 = *(const bf16x8*)qp, qf1 = *(const bf16x8*)(qp + 32);
    const f32x4 zero4 = {0.f, 0.f, 0.f, 0.f};
    const LAS float* rpb = CTXLDS ? (const LAS float*)(lds + NA_RPB2) : (const LAS float*)(lds + NA_RPB_OFF) + h * 15 * 31;
    const int qcol = jb * 16 + fr, wstart = min(max(qcol - 8, 0), 48);
    constexpr int C0 = ISCTX ? 4 : 0;
    bf16x8 kf[4][2], vf[2][4];
#define NA_LOAD_KV(c) do { _Pragma("unroll") for (int s_ = 0; s_ < 2; ++s_) { _Pragma("unroll") for (int hh = 0; hh < 2; ++hh) { \
        if (CTXLDS && (c) >= 4) { const int key_ = (2 * ((c) - 4) + s_) * 32 + 4 * hh + kap; const LAS unsigned char* kl_ = lds + NA_KC_OFF + key_ * 128; \
            kf[2 * s_ + hh][0] = *(const LAS bf16x8*)(kl_ + ((fq ^ (key_ & 7)) << 4)); kf[2 * s_ + hh][1] = *(const LAS bf16x8*)(kl_ + (((4 + fq) ^ (key_ & 7)) << 4)); } \
        else if (CTXLDS) { const LAS unsigned char* kl_ = lds + NA_KW_OFF + ((row_start + 2 * (c) + s_) % 9) * NA_KW_ROW + (band_start + 4 * hh + kap) * NA_KW_PITCH + fq * 16; \
            kf[2 * s_ + hh][0] = *(const LAS bf16x8*)kl_; kf[2 * s_ + hh][1] = *(const LAS bf16x8*)(kl_ + 64); } \
        else { const bf16* kp_ = ((c) < 4) ? kwin + (size_t)((2 * (c) + s_) * 64 + 4 * hh) * AB_IN : kctx + (size_t)((2 * ((c) - 4) + s_) * 32 + 4 * hh) * AB_IN; \
            kf[2 * s_ + hh][0] = *(const bf16x8*)kp_; kf[2 * s_ + hh][1] = *(const bf16x8*)(kp_ + 32); } } \
        _Pragma("unroll") for (int dt = 0; dt < 4; ++dt) { \
            if (CTXLDS && (c) >= 4) vf[s_][dt] = *(const LAS bf16x8*)(lds + NA_VC_OFF + (dt * 16 + fr) * NA_VC_PITCH + ((2 * ((c) - 4) + s_) * 32 + 8 * fq) * 2); \
            else vf[s_][dt] = ((c) < 4) ? *(const bf16x8*)(vtl + (size_t)(dt * 16) * T + (2 * (c) + s_) * 64) : *(const bf16x8*)(vtc + (size_t)(dt * 16) * NCTX + (2 * ((c) - 4) + s_) * 32); } } } while (0)
    float mrun = -3.0e38f, lrun = 0.f;
    f32x4 o[4];
#pragma unroll
    for (int dt = 0; dt < 4; ++dt) o[dt] = zero4;
#pragma unroll
    for (int c = C0; c < 8; ++c) {
        NA_LOAD_KV(c);
        f32x4 s[4];
#pragma unroll
        for (int t = 0; t < 4; ++t) { f32x4 a = mfma16(kf[t][0], qf0, zero4); s[t] = mfma16(kf[t][1], qf1, a); }
        float mx = mrun;
        if (c < 4) {
#pragma unroll
            for (int t = 0; t < 4; ++t) { const int kr = 2 * c + (t >> 1), hh = t & 1; const int drow = row_start + kr - r + 7;
#pragma unroll
                for (int i = 0; i < 4; ++i) { const int kcol = band_start + 8 * fq + 4 * hh + i; const bool ok = (kcol >= wstart) && (kcol < wstart + 16);
                    const int dcol = min(max(kcol - qcol + 15, 0), 30);
                    const float lg = ok ? (s[t][i] * 0.125f + rpb[drow * 31 + dcol]) : -1.0e30f; s[t][i] = lg; mx = fmaxf(mx, lg); } }
        } else {
#pragma unroll
            for (int t = 0; t < 4; ++t)
#pragma unroll
                for (int i = 0; i < 4; ++i) { const float lg = s[t][i] * 0.125f; s[t][i] = lg; mx = fmaxf(mx, lg); }
        }
        mx = xmax_16_32(mx);
        const float corr = __expf(mrun - mx); mrun = mx;
        float sum = 0.f;
#pragma unroll
        for (int t = 0; t < 4; ++t)
#pragma unroll
            for (int i = 0; i < 4; ++i) { const float p = __expf(s[t][i] - mx); s[t][i] = p; sum += p; }
        sum = xsum_16_32(sum);
        lrun = lrun * corr + sum;
#pragma unroll
        for (int dt = 0; dt < 4; ++dt) o[dt] = o[dt] * corr;
#pragma unroll
        for (int s_ = 0; s_ < 2; ++s_) { const int ta = 2 * s_, tb = 2 * s_ + 1;
            const bf16x8 pf = mk_frag(pk2(s[ta][0], s[ta][1]), pk2(s[ta][2], s[ta][3]), pk2(s[tb][0], s[tb][1]), pk2(s[tb][2], s[tb][3]));
#pragma unroll
            for (int dt = 0; dt < 4; ++dt) o[dt] = mfma16(vf[s_][dt], pf, o[dt]); }
    }
#undef NA_LOAD_KV
    const float inv = 1.0f / lrun;
#pragma unroll
    for (int dt = 0; dt < 4; ++dt) { u32x2 w; w.x = pk2(o[dt].x * inv, o[dt].y * inv); w.y = pk2(o[dt].z * inv, o[dt].w * inv);
        *(u32x2*)(A2 + (mq0 + fr) * D + 256 + h * 64 + dt * 16 + 4 * fq) = w; }
}

__device__ __forceinline__ void pool_units(const Params& P, LAS unsigned char* lds, int j_even, int tid, int bid, int nb) {
    const bf16* PB = (const bf16*)(P.ws + WS_P);
    bf16* A2 = (bf16*)(P.ws + WS_A2);
    const int lane = tid & 63, wave = tid >> 6, fr = lane & 15, fq = lane >> 4;
    LAS bf16* pwT = (LAS bf16*)lds;
    LAS bf16* pooled = (LAS bf16*)(lds + 36864);
    LAS bf16* U = (LAS bf16*)(lds + 128000);
    for (int idx = tid; idx < 4 * 64 * 64; idx += NTHREADS) { const int g = idx >> 12, d = (idx >> 6) & 63, e = idx & 63;
        pwT[(g * 64 + e) * 72 + d] = (bf16)f2bf(P.in[9][(size_t)j_even * 4 * 64 * 64 + idx]); }
    for (int u = bid; u < 1088; u += nb) {
        size_t seq0; int t0, TL;
        if (u < 1024) { const int b = u >> 7; t0 = (u & 127) * 32; seq0 = (size_t)b * T; TL = T; }
        else { const int q = u - 1024; const int b = q >> 3; t0 = (q & 7) * 32; seq0 = (size_t)ML + (size_t)b * NCTX; TL = NCTX; }
        __syncthreads();
        for (int c = tid; c < 48 * 32; c += NTHREADS) { const int rr = c >> 5, ck = c & 31; const int t = t0 - 8 + rr;
            if (t >= 0 && t < TL) *(LAS u32x4*)(U + rr * 256 + ck * 8) = *(const u32x4*)(PB + (seq0 + t) * AB_IN + ck * 8); }
        __syncthreads();
        for (int idx = tid; idx < 32 * 256; idx += NTHREADS) { const int ti = idx >> 8, ch = idx & 255, g = ch >> 6, w = 2 << g; const int t = t0 + ti;
            const int lo = max(t - w / 2, 0), hi = min(t - w / 2 + w, TL);
            float sum = 0.f;
            for (int sx = lo; sx < hi; ++sx) sum += bf2f(U[(sx - t0 + 8) * 256 + ch]);
            pooled[ti * 272 + ch] = (bf16)f2bf(sum / (float)(hi - lo) - bf2f(U[(ti + 8) * 256 + ch])); }
        __syncthreads();
        { const int g = wave >> 1, tt = wave & 1;
          const size_t mrow = seq0 + t0 + tt * 16 + fr;
#pragma unroll
          for (int et = 0; et < 4; ++et) { f32x4 a = {0.f, 0.f, 0.f, 0.f};
#pragma unroll
              for (int ks = 0; ks < 2; ++ks) { const bf16x8 wf = *(const LAS bf16x8*)(pwT + (g * 64 + et * 16 + fr) * 72 + ks * 32 + fq * 8); const bf16x8 pf = *(const LAS bf16x8*)(pooled + (tt * 16 + fr) * 272 + g * 64 + ks * 32 + fq * 8);
                  a = mfma16(wf, pf, a); }
              const int col = g * 64 + et * 16 + 4 * fq; const f32x4 sc = *(const f32x4*)(P.in[10] + j_even * 256 + col);
              u32x2 w; w.x = pk2(a.x * sc.x, a.y * sc.y); w.y = pk2(a.z * sc.z, a.w * sc.w); *(u32x2*)(A2 + mrow * D + col) = w; } }
    }
    __syncthreads();
}

__device__ __forceinline__ void phase_even_mixer(const Params& P, LAS unsigned char* lds, int j_even, int tid, int bid, int nb) {
    const int lane = tid & 63, wave = tid >> 6;
    if (nb != 256) for (int idx = tid; idx < 12 * 15 * 31; idx += NTHREADS) ((LAS float*)(lds + NA_RPB_OFF))[idx] = P.in[11][(size_t)j_even * 12 * 15 * 31 + idx];
    pool_units(P, lds, j_even, tid, bid, nb);
    const int gw = bid * NWAVES + wave, NGW = nb * NWAVES;
    if (nb == 256) {
        const bf16* PB = (const bf16*)(P.ws + WS_P);
        int bh_cur = -1, res_hi = 0;
        u32x4 pre[2]; int pre_lo = 0, pre_n = 0;
        const int it_end = bid * 12 + 12;
        for (int it = bid * 12; it < it_end; ++it) { const int bh = it >> 5, b = bh / 12, h = bh % 12;
            const int r0 = (it & 31) * 2, lo_need = min(max(r0 - 4, 0), 56), hi_need = min(max(r0 + 1 - 4, 0), 56) + 7;
            const int key = tid >> 3, c8 = tid & 7;
            __syncthreads();
            if (bh != bh_cur) { bh_cur = bh; res_hi = lo_need; pre_n = 0;
                for (int ch = tid; ch < 256 * 8; ch += NTHREADS) { const int kk = ch >> 3, cc = ch & 7;
                    *(LAS u32x4*)(lds + NA_KC_OFF + kk * 128 + ((cc ^ (kk & 7)) << 4)) = *(const u32x4*)(PB + ((size_t)ML + (size_t)b * NCTX + kk) * AB_IN + 1024 + h * 64 + cc * 8); }
                const bf16* vtc = (const bf16*)(P.ws + WS_VTC) + (size_t)(b * 12 + h) * 64 * NCTX;
                for (int ch = tid; ch < 64 * 32; ch += NTHREADS) { const int dh = ch >> 5, cc = ch & 31;
                    *(LAS u32x4*)(lds + NA_VC_OFF + dh * NA_VC_PITCH + cc * 16) = *(const u32x4*)(vtc + (size_t)dh * NCTX + cc * 8); }
                for (int idx = tid; idx < 15 * 31; idx += NTHREADS) ((LAS float*)(lds + NA_RPB2))[idx] = P.in[11][((size_t)j_even * 12 + h) * 15 * 31 + idx]; }
            { const int first = max(res_hi, lo_need);
              if (pre_n > 0 && pre_lo == first && pre_lo + pre_n == hi_need + 1) {
#pragma unroll
                  for (int q = 0; q < 2; ++q) if (q < pre_n) *(LAS u32x4*)(lds + NA_KW_OFF + ((pre_lo + q) % 9) * NA_KW_ROW + key * NA_KW_PITCH + c8 * 16) = pre[q];
              } else
                  for (int R = first; R <= hi_need; ++R)
                      *(LAS u32x4*)(lds + NA_KW_OFF + (R % 9) * NA_KW_ROW + key * NA_KW_PITCH + c8 * 16) = *(const u32x4*)(PB + ((size_t)b * T + (size_t)R * 64 + key) * AB_IN + 1024 + h * 64 + c8 * 8); }
            res_hi = hi_need + 1; pre_n = 0;
            __syncthreads();
            if (it + 1 < it_end && ((it + 1) >> 5) == bh) {
                const int r1 = ((it + 1) & 31) * 2, lo1 = min(max(r1 - 4, 0), 56), hi1 = min(max(r1 + 1 - 4, 0), 56) + 7; const int f1 = max(res_hi, lo1);
                if (hi1 - f1 + 1 >= 1 && hi1 - f1 + 1 <= 2) { pre_lo = f1; pre_n = hi1 - f1 + 1;
#pragma unroll
                    for (int q = 0; q < 2; ++q) if (q < pre_n) pre[q] = *(const u32x4*)(PB + ((size_t)b * T + (size_t)(f1 + q) * 64 + key) * AB_IN + 1024 + h * 64 + c8 * 8); } }
            na_wave_unit<false, true>(P, lds, bh * 256 + (it & 31) * 8 + wave, lane); }
        __syncthreads();
    } else {
        for (int v = gw; v < 24576; v += NGW) na_wave_unit<false, false>(P, lds, v, lane);
    }
    for (int v = gw; v < 1536; v += NGW) na_wave_unit<true, false>(P, lds, v, lane);
}

constexpr int GP_G = 0;
constexpr int GP_SEG = 8192;
constexpr int GP_B = 12288;
constexpr int GP_QD = 45056;
constexpr int GP_KD = 62464;
constexpr int GP_KLT = 79872;
constexpr int GP_ATT = 98304;
constexpr int GP_VT = 107520;
__device__ __forceinline__ void phase_gla_prepass(const Params& P, LAS unsigned char* lds, int j_odd, int tid, int bid, int nb, int dbg = 0) {
    const bf16* PB = (const bf16*)(P.ws + WS_P);
    const int lane = tid & 63, wave = tid >> 6, fr = lane & 15, fq = lane >> 4;
    LAS float* G = (LAS float*)(lds + GP_G); LAS float* SEG = (LAS float*)(lds + GP_SEG); LAS float* BC = (LAS float*)(lds + GP_B);
    LAS bf16* QD = (LAS bf16*)(lds + GP_QD); LAS bf16* KD = (LAS bf16*)(lds + GP_KD); LAS bf16* KLT = (LAS bf16*)(lds + GP_KLT); LAS bf16* ATT = (LAS bf16*)(lds + GP_ATT); LAS bf16* VTs = (LAS bf16*)(lds + GP_VT);
    const float* ROPEC = (const float*)(P.ws + WS_ROPE); const float* ROPES = ROPEC + T * 64;
    const f32x4 zero4 = {0.f, 0.f, 0.f, 0.f};
    const int f = tid & 63, seg = tid >> 6;
    const int ri = tid >> 3, rg = tid & 7;
    for (int unit = bid; unit < 544 * 4; unit += nb) {
        const int c = unit >> 2, h = unit & 3;
        const bool latent = c < 512;
        const size_t m0 = latent ? (size_t)c * 64 : (size_t)ML + (size_t)(c - 512) * 64;
        const int t0 = (c & 63) * 64;
        float gv[4];
#pragma unroll
        for (int q = 0; q < 4; ++q) { const int idx = tid + NTHREADS * q; gv[q] = bf2f(PB[(m0 + (idx >> 5)) * GLA_IN + 3072 + (idx & 31)]); }
        const bf16* rowp = PB + (m0 + ri) * GLA_IN + h * 128 + rg * 8;
        const u32x4 q1r = *(const u32x4*)rowp, q2r = *(const u32x4*)(rowp + 64), k1r = *(const u32x4*)(rowp + 512), k2r = *(const u32x4*)(rowp + 576);
        f32x4 cs4[4];
        if (latent) { const float* cp = ROPEC + (size_t)(t0 + ri) * 64 + rg * 8; const float* sp = ROPES + (size_t)(t0 + ri) * 64 + rg * 8;
            cs4[0] = *(const f32x4*)cp; cs4[1] = *(const f32x4*)(cp + 4); cs4[2] = *(const f32x4*)sp; cs4[3] = *(const f32x4*)(sp + 4); }
        else { cs4[0] = cs4[1] = (f32x4){1.f, 1.f, 1.f, 1.f}; cs4[2] = cs4[3] = zero4; }
        __syncthreads();
#pragma unroll
        for (int q = 0; q < 4; ++q) G[tid + NTHREADS * q] = gv[q];
        float qa[8], qb[8], ka[8], kb[8];
        { const unsigned qw1[4] = {q1r.x, q1r.y, q1r.z, q1r.w}, qw2[4] = {q2r.x, q2r.y, q2r.z, q2r.w}, kw1[4] = {k1r.x, k1r.y, k1r.z, k1r.w}, kw2[4] = {k2r.x, k2r.y, k2r.z, k2r.w};
#pragma unroll
          for (int e = 0; e < 8; ++e) { const int sh = (e & 1) * 16;
              const float x1 = bf2f((qw1[e >> 1] >> sh) & 0xffffu), x2 = bf2f((qw2[e >> 1] >> sh) & 0xffffu), y1 = bf2f((kw1[e >> 1] >> sh) & 0xffffu), y2 = bf2f((kw2[e >> 1] >> sh) & 0xffffu);
              const float cn = cs4[e >> 2][e & 3], sn = cs4[2 + (e >> 2)][e & 3];
              qa[e] = (x1 * cn - x2 * sn) * 0.08838834764831845f; qb[e] = (x1 * sn + x2 * cn) * 0.08838834764831845f; ka[e] = y1 * cn - y2 * sn; kb[e] = y1 * sn + y2 * cn; } }
        __syncthreads();
#pragma unroll 1
        for (int z = 0; z < 2; ++z) {
            const size_t u = ((size_t)c * 4 + h) * 2 + z;
            float bb1[8], bb2[8];
            { float wg1[16], wg2[16];
#pragma unroll
              for (int rr = 0; rr < 16; ++rr) { const float* wp = P.in[14] + ((size_t)(j_odd * 2 + z) * 16 + rr) * 512 + h * 128 + f; wg1[rr] = wp[0]; wg2[rr] = wp[64]; }
              const float bg1 = P.in[15][(size_t)(j_odd * 2 + z) * 512 + h * 128 + f], bg2 = P.in[15][(size_t)(j_odd * 2 + z) * 512 + h * 128 + 64 + f];
              float run1 = 0.f, run2 = 0.f;
#pragma unroll
              for (int ii = 0; ii < 8; ++ii) { const int ip = seg * 8 + ii, i = z ? 63 - ip : ip; float x1 = bg1, x2 = bg2;
                  if (!(dbg & 2))
#pragma unroll
                  for (int r4 = 0; r4 < 4; ++r4) { const f32x4 g4 = *(const LAS f32x4*)(G + i * 32 + z * 16 + r4 * 4);
                      x1 += g4.x * wg1[4 * r4] + g4.y * wg1[4 * r4 + 1] + g4.z * wg1[4 * r4 + 2] + g4.w * wg1[4 * r4 + 3];
                      x2 += g4.x * wg2[4 * r4] + g4.y * wg2[4 * r4 + 1] + g4.z * wg2[4 * r4 + 2] + g4.w * wg2[4 * r4 + 3]; }
                  run1 += (fminf(x1, 0.f) - __logf(1.0f + __expf(-fabsf(x1)))) * (1.0f / 16.0f); run2 += (fminf(x2, 0.f) - __logf(1.0f + __expf(-fabsf(x2)))) * (1.0f / 16.0f);
                  bb1[ii] = run1; bb2[ii] = run2; }
              SEG[seg * 128 + f] = run1; SEG[seg * 128 + 64 + f] = run2; }
            __syncthreads();
            { float off1 = 0.f, off2 = 0.f, tot1 = 0.f, tot2 = 0.f;
#pragma unroll
              for (int sg = 0; sg < 8; ++sg) { const float a1 = SEG[sg * 128 + f], a2 = SEG[sg * 128 + 64 + f]; tot1 += a1; tot2 += a2; if (sg < seg) { off1 += a1; off2 += a2; } }
              if (seg == 0) { float* dec = (float*)(P.ws + WS_GDEC) + u * 128; dec[f] = __expf(tot1); dec[64 + f] = __expf(tot2); }
#pragma unroll
              for (int ii = 0; ii < 8; ++ii) { BC[(seg * 8 + ii) * 128 + f] = bb1[ii] + off1; BC[(seg * 8 + ii) * 128 + 64 + f] = bb2[ii] + off2; } }
            __syncthreads();
            { const int ip = z ? 63 - ri : ri;
              const LAS float* bp = BC + ip * 128 + rg * 8; const LAS float* lp = BC + 63 * 128 + rg * 8;
              float ba[8], bbv[8], la[8], lb[8];
#pragma unroll
              for (int q4 = 0; q4 < 2; ++q4) { const f32x4 x = *(const LAS f32x4*)(bp + 4 * q4), y = *(const LAS f32x4*)(bp + 64 + 4 * q4), lx = *(const LAS f32x4*)(lp + 4 * q4), ly = *(const LAS f32x4*)(lp + 64 + 4 * q4);
#pragma unroll
                  for (int e = 0; e < 4; ++e) { ba[4 * q4 + e] = x[e]; bbv[4 * q4 + e] = y[e]; la[4 * q4 + e] = lx[e]; lb[4 * q4 + e] = ly[e]; } }
              float qda[8], qdb[8], kda[8], kdb[8];
#pragma unroll
              for (int e = 0; e < 8; ++e) { qda[e] = qa[e] * __expf(ba[e]); qdb[e] = qb[e] * __expf(bbv[e]); kda[e] = ka[e] * __expf(-ba[e]); kdb[e] = kb[e] * __expf(-bbv[e]);
                  KLT[(rg * 8 + e) * 72 + ip] = (bf16)f2bf(ka[e] * __expf(la[e] - ba[e])); KLT[(64 + rg * 8 + e) * 72 + ip] = (bf16)f2bf(kb[e] * __expf(lb[e] - bbv[e])); }
              u32x4 w;
              w.x = pk2(qda[0], qda[1]); w.y = pk2(qda[2], qda[3]); w.z = pk2(qda[4], qda[5]); w.w = pk2(qda[6], qda[7]); *(LAS u32x4*)(QD + ip * 136 + rg * 8) = w;
              w.x = pk2(qdb[0], qdb[1]); w.y = pk2(qdb[2], qdb[3]); w.z = pk2(qdb[4], qdb[5]); w.w = pk2(qdb[6], qdb[7]); *(LAS u32x4*)(QD + ip * 136 + 64 + rg * 8) = w;
              w.x = pk2(kda[0], kda[1]); w.y = pk2(kda[2], kda[3]); w.z = pk2(kda[4], kda[5]); w.w = pk2(kda[6], kda[7]); *(LAS u32x4*)(KD + ip * 136 + rg * 8) = w;
              w.x = pk2(kdb[0], kdb[1]); w.y = pk2(kdb[2], kdb[3]); w.z = pk2(kdb[4], kdb[5]); w.w = pk2(kdb[6], kdb[7]); *(LAS u32x4*)(KD + ip * 136 + 64 + rg * 8) = w; }
            __syncthreads();
#pragma unroll
            for (int tt = 0; tt < 2; ++tt) { const int id = wave * 2 + tt, ti = id >> 2, ts = id & 3;
                f32x4 a = zero4;
                if (ts <= ti && !(dbg & 4)) {
#pragma unroll
                    for (int kk = 0; kk < 4; ++kk) { const bf16x8 qf = *(const LAS bf16x8*)(QD + (ti * 16 + fr) * 136 + kk * 32 + fq * 8); const bf16x8 kf = *(const LAS bf16x8*)(KD + (ts * 16 + fr) * 136 + kk * 32 + fq * 8);
                        a = mfma16(kf, qf, a); }
#pragma unroll
                    for (int jx = 0; jx < 4; ++jx) if (ts * 16 + 4 * fq + jx > ti * 16 + fr) a[jx] = 0.f;
                }
                u32x2 w; w.x = pk2(a.x, a.y); w.y = pk2(a.z, a.w); *(LAS u32x2*)(ATT + (ti * 16 + fr) * 72 + ts * 16 + 4 * fq) = w; }
            __syncthreads();
            if (!(dbg & 8)) { bf16* QDG = (bf16*)(P.ws + WS_GQD) + u * 22528; bf16* KLG = QDG + 64 * 136; bf16* ATG = KLG + 128 * 72;
              for (int ch = tid; ch < 64 * 136 / 8; ch += NTHREADS) *(u32x4*)(QDG + ch * 8) = *(const LAS u32x4*)(QD + ch * 8);
              for (int ch = tid; ch < 128 * 72 / 8; ch += NTHREADS) *(u32x4*)(KLG + ch * 8) = *(const LAS u32x4*)(KLT + ch * 8);
              for (int ch = tid; ch < 64 * 72 / 8; ch += NTHREADS) *(u32x4*)(ATG + ch * 8) = *(const LAS u32x4*)(ATT + ch * 8); }
            __syncthreads();
        }
    }
}

constexpr int GS_X = 54272, GS_QD = 0, GS_KLT = 17408, GS_ATT = 35840, GS_VT = 45056, GS_ST = 2 * GS_X, GS_STB = 17408;
__device__ __forceinline__ bf16x8 rev8(bf16x8 v) {
    const u32x4 x = __builtin_bit_cast(u32x4, v); u32x4 y;
    y.x = __builtin_amdgcn_alignbit(x.w, x.w, 16); y.y = __builtin_amdgcn_alignbit(x.z, x.z, 16); y.z = __builtin_amdgcn_alignbit(x.y, x.y, 16); y.w = __builtin_amdgcn_alignbit(x.x, x.x, 16);
    return __builtin_bit_cast(bf16x8, y);
}
__device__ __forceinline__ int gla_chunk(int b, int z, int cs) { return (cs < 4) ? 512 + b * 4 + (z ? 3 - cs : cs) : b * 64 + (z ? 63 - (cs - 4) : (cs - 4)); }
struct GlaStage { u32x4 r[7]; };
__device__ __forceinline__ void gla_stage_load(const Params& P, GlaStage& R, int b, int h, int z, int dvs, int cs, int tid, int wave, int fq) {
    const int c = gla_chunk(b, z, cs); const size_t u = ((size_t)c * 4 + h) * 2 + z;
    const unsigned char* IMG = P.ws + WS_GQD + u * 45056;
    const unsigned char* VTG = P.ws + WS_GVT + ((size_t)c * 1024 + h * 256 + dvs * 64) * 144 - (size_t)2816 * 16;
#pragma unroll
    for (int q = 0; q < 5; ++q) R.r[q] = *(const u32x4*)(IMG + (tid + 512 * q) * 16);
    { const int g = tid + 2560; R.r[5] = *(const u32x4*)((g < 2816 ? IMG : VTG) + g * 16); }
    { const int g = min(tid + 3072, 3391); R.r[6] = *(const u32x4*)(VTG + g * 16); }
}
__device__ __forceinline__ f32x4 gla_dec_load(const Params& P, int b, int h, int z, int cs, int wave, int fq) {
    const int c = gla_chunk(b, z, cs); const size_t u = ((size_t)c * 4 + h) * 2 + z; return *(const f32x4*)((const float*)(P.ws + WS_GDEC) + u * 128 + wave * 16 + 4 * fq);
}
__device__ __forceinline__ void gla_stage_store(LAS unsigned char* xb, const GlaStage& R, int tid) {
#pragma unroll
    for (int q = 0; q < 7; ++q) { const int g = tid + 512 * q; if (q < 6 || g < 3392) *(LAS u32x4*)(xb + g * 16) = R.r[q]; }
}
__device__ __forceinline__ void phase_gla_scan(const Params& P, LAS unsigned char* lds, int tid, int bid, int nb) {
    const int lane = tid & 63, wave = tid >> 6, fr = lane & 15, fq = lane >> 4;
    for (int cb = bid; cb < 256; cb += nb) {
        const int xcd = cb & 7, kq = cb >> 3, g = xcd * 8 + (kq >> 2), dvs = kq & 3;
        const int b = g >> 3, h = (g >> 1) & 3, z = g & 1;
        bf16* O = (bf16*)(P.ws + (z ? WS_OB : WS_OF));
        f32x4 Sacc[4];
#pragma unroll
        for (int te = 0; te < 4; ++te) Sacc[te] = (f32x4){0.f, 0.f, 0.f, 0.f};
        GlaStage R;
        gla_stage_load(P, R, b, h, z, dvs, 0, tid, wave, fq);
        __syncthreads();
        for (int idx = tid; idx < 2 * GS_STB / 4; idx += NTHREADS) ((LAS unsigned*)(lds + GS_ST))[idx] = 0u;
        gla_stage_store(lds, R, tid);
        gla_stage_load(P, R, b, h, z, dvs, 1, tid, wave, fq);
        __syncthreads();
#pragma unroll 1
        for (int cs = 0; cs < 68; ++cs) {
            const LAS unsigned char* xb = lds + (cs & 1) * GS_X;
            const f32x4 dec_cur = gla_dec_load(P, b, h, z, cs, wave, fq);
            if (cs + 1 < 68) gla_stage_store(lds + ((cs + 1) & 1) * GS_X, R, tid);
            if (cs + 2 < 68) gla_stage_load(P, R, b, h, z, dvs, cs + 2, tid, wave, fq);
            const int c = gla_chunk(b, z, cs); const int ti = wave >> 1;
            const LAS bf16* STr = (const LAS bf16*)(lds + GS_ST + (cs & 1) * GS_STB);
            LAS bf16* STw = (LAS bf16*)(lds + GS_ST + ((cs + 1) & 1) * GS_STB);
            const LAS bf16* QDl = (const LAS bf16*)(xb + GS_QD); const LAS bf16* KLl = (const LAS bf16*)(xb + GS_KLT); const LAS bf16* ATl = (const LAS bf16*)(xb + GS_ATT); const LAS bf16* VTl = (const LAS bf16*)(xb + GS_VT);
            bf16x8 vt[4][2];
#pragma unroll
            for (int te = 0; te < 4; ++te)
#pragma unroll
                for (int kk = 0; kk < 2; ++kk) { const bf16x8 v = *(const LAS bf16x8*)(VTl + (te * 16 + fr) * 72 + (z ? (56 - kk * 32 - fq * 8) : (kk * 32 + fq * 8))); vt[te][kk] = z ? rev8(v) : v; }
            const size_t m0 = (c < 512) ? (size_t)c * 64 : (size_t)ML + (size_t)(c - 512) * 64;
            const int ip = ti * 16 + fr; const size_t mrow = m0 + (z ? 63 - ip : ip);
            bf16x8 qd[4], at[2];
#pragma unroll
            for (int kk = 0; kk < 4; ++kk) qd[kk] = *(const LAS bf16x8*)(QDl + ip * 136 + kk * 32 + fq * 8);
#pragma unroll
            for (int kk = 0; kk < 2; ++kk) at[kk] = *(const LAS bf16x8*)(ATl + ip * 72 + kk * 32 + fq * 8);
#pragma unroll
            for (int tt = 0; tt < 2; ++tt) { const int te = (wave & 1) * 2 + tt;
                f32x4 a = {0.f, 0.f, 0.f, 0.f};
#pragma unroll
                for (int kk = 0; kk < 4; ++kk) { const bf16x8 sf = *(const LAS bf16x8*)(STr + (te * 16 + fr) * 136 + kk * 32 + fq * 8); a = mfma16(sf, qd[kk], a); }
                bf16x8 v0 = *(const LAS bf16x8*)(VTl + (te * 16 + fr) * 72 + (z ? (56 - fq * 8) : (fq * 8))), v1 = *(const LAS bf16x8*)(VTl + (te * 16 + fr) * 72 + (z ? (24 - fq * 8) : (32 + fq * 8)));
                if (z) { v0 = rev8(v0); v1 = rev8(v1); }
                a = mfma16(v0, at[0], a); a = mfma16(v1, at[1], a);
                { u32x2 w; w.x = pk2(a.x, a.y); w.y = pk2(a.z, a.w); *(u32x2*)(O + mrow * D + h * 256 + dvs * 64 + te * 16 + 4 * fq) = w; } }
            { const bf16x8 kl0 = *(const LAS bf16x8*)(KLl + (wave * 16 + fr) * 72 + fq * 8), kl1 = *(const LAS bf16x8*)(KLl + (wave * 16 + fr) * 72 + 32 + fq * 8);
#pragma unroll
              for (int te = 0; te < 4; ++te) { f32x4 a = Sacc[te] * dec_cur; a = mfma16(kl0, vt[te][0], a); a = mfma16(kl1, vt[te][1], a); Sacc[te] = a;
                  u32x2 w; w.x = pk2(a.x, a.y); w.y = pk2(a.z, a.w); *(LAS u32x2*)(STw + (te * 16 + fr) * 136 + wave * 16 + 4 * fq) = w; } }
            __syncthreads();
        }
    }
}

__device__ __forceinline__ void phase_gla_out(const Params& P, int j_odd, int tid, int bid, int nb, int Mrows) {
    const int lane = tid & 63, wave = tid >> 6; unsigned char* ws = P.ws;
    const bf16* PB = (const bf16*)(ws + WS_P); bf16* A2 = (bf16*)(ws + WS_A2);
    const bf16* OF = (const bf16*)(ws + WS_OF); const bf16* OB = (const bf16*)(ws + WS_OB);
    const f32x4 ng = *(const f32x4*)(P.in[16] + j_odd * 256 + 4 * lane);
    for (int m0 = (bid * NWAVES + wave) * 2; m0 < Mrows; m0 += nb * NWAVES * 2) {
        u32x2 of[2][4], ob[2][4], rr[2][4];
#pragma unroll
        for (int q = 0; q < 2; ++q) { const int m = min(m0 + q, Mrows - 1);
#pragma unroll
            for (int h = 0; h < 4; ++h) { const int col = h * 256 + 4 * lane;
                of[q][h] = *(const u32x2*)(OF + (size_t)m * D + col); ob[q][h] = *(const u32x2*)(OB + (size_t)m * D + col); rr[q][h] = *(const u32x2*)(PB + (size_t)m * GLA_IN + 2048 + col); } }
#pragma unroll
        for (int q = 0; q < 2; ++q) { const int m = m0 + q;
            if (m < Mrows) {
#pragma unroll
                for (int h = 0; h < 4; ++h) { const int col = h * 256 + 4 * lane;
                    const f32x4 o = {bf2f(of[q][h].x & 0xffffu) + bf2f(ob[q][h].x & 0xffffu), bf2f(of[q][h].x >> 16) + bf2f(ob[q][h].x >> 16), bf2f(of[q][h].y & 0xffffu) + bf2f(ob[q][h].y & 0xffffu), bf2f(of[q][h].y >> 16) + bf2f(ob[q][h].y >> 16)};
                    const float ss = wave_sum(o.x * o.x + o.y * o.y + o.z * o.z + o.w * o.w);
                    const float rs = rsqrtf(ss * (1.0f / 256.0f) + 1e-6f);
                    const float r0 = bf2f(rr[q][h].x & 0xffffu), r1 = bf2f(rr[q][h].x >> 16), r2 = bf2f(rr[q][h].y & 0xffffu), r3 = bf2f(rr[q][h].y >> 16);
                    u32x2 w; w.x = pk2(o.x * rs * ng.x * silu_f(r0), o.y * rs * ng.y * silu_f(r1)); w.y = pk2(o.z * rs * ng.z * silu_f(r2), o.w * rs * ng.w * silu_f(r3));
                    *(u32x2*)(A2 + (size_t)m * D + col) = w; } } }
    }
}

constexpr int L1_HP = 1040;
constexpr int L1_HHI = 0, L1_HLO = 16 * L1_HP * 2;
constexpr int L1_PART = 2 * 16 * L1_HP * 2;
constexpr int L1_SEL = L1_PART + 16384;
constexpr int L1_MAXROWS = 136;
constexpr int L1_VEC = L1_SEL + 8192;
template <bool B> struct BTag { static constexpr bool value = B; };
template <bool L0> struct L1XSel { typedef f32x4 type; };
template <> struct L1XSel<false> { typedef u32x2 type; };
__device__ __forceinline__ f32x4 l1_xval(const f32x4& x) { return x; }
__device__ __forceinline__ f32x4 l1_xval(const u32x2& w) { return (f32x4){bf2f(w.x & 0xffffu), bf2f(w.x >> 16), bf2f(w.y & 0xffffu), bf2f(w.y >> 16)}; }
__device__ __forceinline__ void phase_ln1_router(const Params& P, LAS unsigned char* lds, int layer, int tid, int bid, int nb, int Mrows, bool dry = false) {
    const int lane = tid & 63, wave = tid >> 6, fr = lane & 15, fq = lane >> 4; unsigned char* ws = P.ws;
    LAS bf16* HHI = (LAS bf16*)(lds + L1_HHI); LAS bf16* HLO = (LAS bf16*)(lds + L1_HLO); LAS float* PART = (LAS float*)(lds + L1_PART);
    LAS int* SELE = (LAS int*)(lds + L1_SEL); LAS int* SELP = SELE + L1_MAXROWS * 4; LAS float* SELG = (LAS float*)(SELP + L1_MAXROWS * 4);
    LAS int* hist = (LAS int*)(SELG + L1_MAXROWS * 4); LAS int* base = hist + 32;
    __syncthreads();
    LAS float* RB = (LAS float*)(base + 32);
    if (tid < 32) { hist[tid] = 0; RB[tid] = P.in[19][layer * 32 + tid]; }
    bf16x8 whi[2][4], wlo[2][4];
    { const bf16* rwt = (const bf16*)(ws + WS_RWT) + (size_t)layer * 2 * 32 * 1024;
#pragma unroll
      for (int et = 0; et < 2; ++et)
#pragma unroll
          for (int ks = 0; ks < 4; ++ks) { const bf16* p = rwt + (size_t)(et * 16 + fr) * 1024 + wave * 128 + ks * 32 + fq * 8; whi[et][ks] = *(const bf16x8*)p; wlo[et][ks] = *(const bf16x8*)(p + 32 * 1024); } }
    const int rpb = (Mrows + nb - 1) / nb;
    const int row_lo = bid * rpb, row_hi = min(row_lo + rpb, Mrows);
    const float* mods = (const float*)(ws + WS_MODS) + (size_t)layer * 9 * 6144;
    LAS float* VEC = (LAS float*)(lds + L1_VEC);
    const int mb0 = (row_lo < ML) ? (row_lo >> 12) : 8, mb1 = (row_hi - 1 < ML) ? ((row_hi - 1) >> 12) : 8;
    for (int idx = tid; idx < 8 * 1024; idx += NTHREADS) { const int vsel = idx >> 10, col = idx & 1023; float x;
        if (vsel == 0) x = P.in[6][(size_t)(layer * 2 + 0) * D + col]; else if (vsel == 1) x = P.in[7][(size_t)(layer * 2 + 0) * D + col];
        else { const int set = (vsel - 2) / 3, what = (vsel - 2) % 3; x = mods[(size_t)(set ? mb1 : mb0) * 6144 + (what == 0 ? 3 : what == 1 ? 4 : 2) * 1024 + col]; }
        VEC[idx] = x; }
    const bf16* X2 = (const bf16*)(ws + WS_X); bf16* Xo = (bf16*)(ws + WS_OB); unsigned char* H8o        = (unsigned char*)(ws + (dry ? WS_A2 : WS_H8));
    const bf16* OPR = (const bf16*)(ws + WS_P);
    const f32x4 zero4 = {0.f, 0.f, 0.f, 0.f};
    __syncthreads();
    auto run = [&](auto l0tag) __attribute__((always_inline)) {
        constexpr bool L0 = decltype(l0tag)::value;
        typedef typename L1XSel<L0>::type XT;
        XT xA[2][4], xB[2][4]; u32x2 oA[2][4], oB[2][4];
        auto load_rows = [&](int pp, XT (&xs)[2][4], u32x2 (&os)[2][4]) __attribute__((always_inline)) {
#pragma unroll
            for (int rr = 0; rr < 2; ++rr) { const int m = min(pp + wave * 2 + rr, row_hi - 1);
#pragma unroll
                for (int j = 0; j < 4; ++j) {
                    if constexpr (L0) { const float* xsrc = (m < ML) ? P.in[0] + (size_t)m * D : P.in[2] + (size_t)(m - ML) * D; xs[rr][j] = *(const f32x4*)(xsrc + 4 * lane + 256 * j); }
                    else xs[rr][j] = *(const u32x2*)(X2 + (size_t)m * D + 4 * lane + 256 * j);
                    os[rr][j] = *(const u32x2*)(OPR + (size_t)m * D + 4 * lane + 256 * j); } } };
        auto pass = [&](int p0, XT (&xs)[2][4], u32x2 (&os)[2][4]) __attribute__((always_inline)) {
#pragma unroll
        for (int rr = 0; rr < 2; ++rr) { const int lr16 = wave * 2 + rr, m = p0 + lr16;
            if (m < row_hi) {
                const int mb = (m < ML) ? (m >> 12) : 8; const LAS float* VS = VEC + 2048 + ((mb == mb0) ? 0 : 3072);
                f32x4 v[4]; float s = 0.f;
#pragma unroll
                for (int j = 0; j < 4; ++j) { const int col = 4 * lane + 256 * j; const u32x2 ow = os[rr][j]; const f32x4 g1 = *(const LAS f32x4*)(VS + 2048 + col);
                    const f32x4 o = {bf2f(ow.x & 0xffffu), bf2f(ow.x >> 16), bf2f(ow.y & 0xffffu), bf2f(ow.y >> 16)};
                    const f32x4 xv = l1_xval(xs[rr][j]);
                    v[j] = xv * DN_ALPHA + g1 * o; s += (v[j].x + v[j].y) + (v[j].z + v[j].w); }
                const float mean = wave_sum(s) * (1.f / D); float s2 = 0.f;
#pragma unroll
                for (int j = 0; j < 4; ++j) { v[j] = v[j] - mean; s2 += (v[j].x * v[j].x + v[j].y * v[j].y) + (v[j].z * v[j].z + v[j].w * v[j].w); }
                const float rstd = rsqrtf(wave_sum(s2) * (1.f / D) + LN_EPS);
#pragma unroll
                for (int j = 0; j < 4; ++j) { const int col = 4 * lane + 256 * j; const f32x4 g = *(const LAS f32x4*)(VEC + col), bb = *(const LAS f32x4*)(VEC + 1024 + col);
                    v[j] = v[j] * rstd * g + bb; { u32x2 xw; xw.x = pk2(v[j].x, v[j].y); xw.y = pk2(v[j].z, v[j].w); *(u32x2*)(Xo + (size_t)m * D + col) = xw; }
                    const f32x4 sh = *(const LAS f32x4*)(VS + col), sc = *(const LAS f32x4*)(VS + 1024 + col);
                    const f32x4 hq = v[j] * (1.f + sc) + sh;
                    *(unsigned*)(H8o + (size_t)m * D + col) = pk4_fp8(hq.x * H8_SCALE, hq.y * H8_SCALE, hq.z * H8_SCALE, hq.w * H8_SCALE);
                    const unsigned h01 = pk2(hq.x, hq.y), h23 = pk2(hq.z, hq.w);
                    const unsigned l01 = pk2(hq.x - bf2f(h01 & 0xffffu), hq.y - bf2f(h01 >> 16)), l23 = pk2(hq.z - bf2f(h23 & 0xffffu), hq.w - bf2f(h23 >> 16));
                    u32x2 wh = {h01, h23}, wl = {l01, l23};
                    *(LAS u32x2*)(HHI + lr16 * L1_HP + col) = wh; *(LAS u32x2*)(HLO + lr16 * L1_HP + col) = wl; }
            } }
        __syncthreads();
        { f32x4 acc[2] = {zero4, zero4};
#pragma unroll
          for (int ks = 0; ks < 4; ++ks) { const bf16x8 hh = *(const LAS bf16x8*)(HHI + fr * L1_HP + wave * 128 + ks * 32 + fq * 8), hl = *(const LAS bf16x8*)(HLO + fr * L1_HP + wave * 128 + ks * 32 + fq * 8);
#pragma unroll
              for (int et = 0; et < 2; ++et) { acc[et] = mfma16(whi[et][ks], hh, acc[et]); acc[et] = mfma16(whi[et][ks], hl, acc[et]); acc[et] = mfma16(wlo[et][ks], hh, acc[et]); } }
#pragma unroll
          for (int et = 0; et < 2; ++et) *(LAS f32x4*)(PART + (wave * 16 + fr) * 32 + et * 16 + 4 * fq) = acc[et]; }
        __syncthreads();
        { const int hl = lane & 31, lr16 = wave * 2 + (lane >> 5), m = p0 + lr16;
          float lgv = RB[hl];
#pragma unroll
          for (int w8 = 0; w8 < 8; ++w8) lgv += PART[(w8 * 16 + lr16) * 32 + hl];
          int se[4]; float sv[4];
#pragma unroll
          for (int k = 0; k < 4; ++k) {
              float mx = lgv;
              mx = fmaxf(mx, __builtin_bit_cast(float, __builtin_amdgcn_update_dpp(0, __builtin_bit_cast(int, mx), 0x128, 0xf, 0xf, false)));
              mx = fmaxf(mx, __builtin_bit_cast(float, __builtin_amdgcn_update_dpp(0, __builtin_bit_cast(int, mx), 0x124, 0xf, 0xf, false)));
              mx = fmaxf(mx, __builtin_bit_cast(float, __builtin_amdgcn_update_dpp(0, __builtin_bit_cast(int, mx), 0x122, 0xf, 0xf, false)));
              mx = fmaxf(mx, __builtin_bit_cast(float, __builtin_amdgcn_update_dpp(0, __builtin_bit_cast(int, mx), 0x121, 0xf, 0xf, false)));
              mx = fmaxf(mx, __builtin_bit_cast(float, __builtin_amdgcn_ds_bpermute((lane ^ 16) << 2, __builtin_bit_cast(int, mx))));
              const unsigned long long bal = __ballot(lgv == mx);
              const unsigned hm = (unsigned)(bal >> (lane & 32));
              const int bi = __builtin_ctz(hm);
              se[k] = bi; sv[k] = mx;
              lgv = (hl == bi) ? -3.0e38f : lgv; }
          const float e1 = __expf(sv[1] - sv[0]), e2 = __expf(sv[2] - sv[0]), e3 = __expf(sv[3] - sv[0]); const float inv = 1.f / (1.f + e1 + e2 + e3);
          if ((lane & 31) == 0 && m < row_hi) { const int lr = m - row_lo;
              const float gt[4] = {inv, e1 * inv, e2 * inv, e3 * inv};
#pragma unroll
              for (int k = 0; k < 4; ++k) { const int pos = atomicAdd((int*)(hist + se[k]), 1); SELE[lr * 4 + k] = se[k]; SELP[lr * 4 + k] = pos; SELG[lr * 4 + k] = gt[k]; } } }
        };
        load_rows(row_lo, xA, oA);
        for (int p0 = row_lo; p0 < row_hi; p0 += 32) {
            const bool more = p0 + 16 < row_hi;
            if (more) load_rows(p0 + 16, xB, oB);
            pass(p0, xA, oA);
            if (more) { if (p0 + 32 < row_hi) load_rows(p0 + 32, xA, oA); pass(p0 + 16, xB, oB); }
        }
    };
    if (layer == 0) run(BTag<true>{}); else run(BTag<false>{});
    __syncthreads();
    if (dry) return;
    if (tid < 32) { unsigned* cnt = (unsigned*)(ws + WS_CTL) + CW_CNT + layer * 32; const int hc = hist[tid]; base[tid] = hc ? (int)__hip_atomic_fetch_add(cnt + tid, (unsigned)hc, __ATOMIC_RELAXED, __HIP_MEMORY_SCOPE_AGENT) : 0; }
    __syncthreads();
    const int nrows = row_hi - row_lo;
    int* TOKE = (int*)(ws + WS_TOKE); int* TOKP = (int*)(ws + WS_TOKP); float* TOKG = (float*)(ws + WS_TOKG); int* LIST = (int*)(ws + WS_LIST);
    for (int idx = tid; idx < nrows * 4; idx += NTHREADS) { const int lr = idx >> 2; const int m = row_lo + lr; const int e = SELE[idx], pos = base[e] + SELP[idx];
        TOKE[(size_t)m * 4 + (idx & 3)] = e; TOKP[(size_t)m * 4 + (idx & 3)] = pos; TOKG[(size_t)m * 4 + (idx & 3)] = SELG[idx]; LIST[(size_t)e * M + pos] = m; }
}

__device__ __forceinline__ void phase_ln2_combine(const Params& P, LAS unsigned char* lds, int layer, int tid, int bid, int nb, int Mrows, bool dry = false) {
    const int lane = tid & 63, wave = tid >> 6; unsigned char* ws = P.ws;
    moe_tables<0>(P, lds, tid, layer);
    const LAS int* tab = (const LAS int*)(lds + g8::MOE_TAB);
    const float* mods = (const float*)(ws + WS_MODS) + (size_t)layer * 9 * 6144;
    const float* modn = (const float*)(ws + WS_MODS) + (size_t)(layer + 1) * 9 * 6144;
    const bf16* X = (const bf16*)(ws + WS_OB); bf16* X2 = (bf16*)(ws + WS_X); const bf16* YS = (const bf16*)(ws + WS_YS);
    const int* TOKE = (const int*)(ws + WS_TOKE); const int* TOKP = (const int*)(ws + WS_TOKP); const float* TOKG = (const float*)(ws + WS_TOKG);
    const int rpb = (Mrows + nb - 1) / nb;
    const int row_lo = bid * rpb, row_hi = min(row_lo + rpb, Mrows);
    LAS float* VEC = (LAS float*)lds;
    const int mb0 = (row_lo < ML) ? (row_lo >> 12) : 8, mb1 = (row_hi - 1 < ML) ? ((row_hi - 1) >> 12) : 8;
    const bool has_next = layer < DEPTH - 1;
    for (int idx = tid; idx < 8 * 1024; idx += NTHREADS) { const int vsel = idx >> 10, col = idx & 1023; float x;
        if (vsel == 0) x = P.in[6][(size_t)(layer * 2 + 1) * D + col]; else if (vsel == 1) x = P.in[7][(size_t)(layer * 2 + 1) * D + col];
        else { const int set = (vsel - 2) / 3, what = (vsel - 2) % 3; const int mbs = set ? mb1 : mb0;
            x = (what == 0) ? mods[(size_t)mbs * 6144 + 5 * 1024 + col] : (has_next ? modn[(size_t)mbs * 6144 + (what == 1 ? 0 : 1024) + col] : 0.f); }
        VEC[idx] = x; }
    __syncthreads();
    for (int m0 = row_lo + wave * 2; m0 < row_hi; m0 += 2 * NWAVES) {
        int te[2][4], tp[2][4]; float tg[2][4];
#pragma unroll
        for (int rr = 0; rr < 2; ++rr) { const int m = min(m0 + rr, row_hi - 1);
#pragma unroll
            for (int k = 0; k < 4; ++k) { te[rr][k] = TOKE[(size_t)m * 4 + k]; tp[rr][k] = TOKP[(size_t)m * 4 + k]; tg[rr][k] = TOKG[(size_t)m * 4 + k]; } }
        u32x2 xr[2][4]; u32x2 yr[2][4][4];
#pragma unroll
        for (int rr = 0; rr < 2; ++rr) { const int m = min(m0 + rr, row_hi - 1);
#pragma unroll
            for (int j = 0; j < 4; ++j) xr[rr][j] = *(const u32x2*)(X + (size_t)m * D + 4 * lane + 256 * j);
#pragma unroll
            for (int k = 0; k < 4; ++k) { const bf16* yp = YS + ((size_t)tab[96 + te[rr][k]] + tp[rr][k]) * 1024 + 4 * lane;
#pragma unroll
                for (int j = 0; j < 4; ++j) yr[rr][k][j] = *(const u32x2*)(yp + 256 * j); } }
#pragma unroll
        for (int rr = 0; rr < 2; ++rr) { const int m = m0 + rr;
            if (m < row_hi) {
                const int mb = (m < ML) ? (m >> 12) : 8; const LAS float* VS = VEC + 2048 + ((mb == mb0) ? 0 : 3072);
                f32x4 v[4]; float s = 0.f;
#pragma unroll
                for (int j = 0; j < 4; ++j) { const int col = 4 * lane + 256 * j; f32x4 y = {0.f, 0.f, 0.f, 0.f};
#pragma unroll
                    for (int k = 0; k < 4; ++k) { const u32x2 rw = yr[rr][k][j]; const float gt = tg[rr][k];
                        y.x += gt * bf2f(rw.x & 0xffffu); y.y += gt * bf2f(rw.x >> 16); y.z += gt * bf2f(rw.y & 0xffffu); y.w += gt * bf2f(rw.y >> 16); }
                    const f32x4 g2 = *(const LAS f32x4*)(VS + col);
                    const u32x2 xw = xr[rr][j]; const f32x4 xv = {bf2f(xw.x & 0xffffu), bf2f(xw.x >> 16), bf2f(xw.y & 0xffffu), bf2f(xw.y >> 16)};
                    v[j] = xv * DN_ALPHA + g2 * y; s += (v[j].x + v[j].y) + (v[j].z + v[j].w); }
                const float mean = wave_sum(s) * (1.f / D); float s2 = 0.f;
#pragma unroll
                for (int j = 0; j < 4; ++j) { v[j] = v[j] - mean; s2 += (v[j].x * v[j].x + v[j].y * v[j].y) + (v[j].z * v[j].z + v[j].w * v[j].w); }
                const float rstd = rsqrtf(wave_sum(s2) * (1.f / D) + LN_EPS);
#pragma unroll
                for (int j = 0; j < 4; ++j) { const int col = 4 * lane + 256 * j; const f32x4 g = *(const LAS f32x4*)(VEC + col), bb = *(const LAS f32x4*)(VEC + 1024 + col);
                    v[j] = v[j] * rstd * g + bb;
                    if (dry) *(f32x4*)((float*)(ws + WS_OB) + (size_t)m * D + col) = v[j]; else if (has_next) { u32x2 xo; xo.x = pk2(v[j].x, v[j].y); xo.y = pk2(v[j].z, v[j].w); *(u32x2*)(X2 + (size_t)m * D + col) = xo; } else *(f32x4*)(P.out + (size_t)m * D + col) = v[j];
                    if (has_next) { const f32x4 sh = *(const LAS f32x4*)(VS + 1024 + col), sc = *(const LAS f32x4*)(VS + 2048 + col);
                        *(unsigned*)((unsigned char*)(ws + (dry ? WS_A2 : WS_H)) + (size_t)m * D + col) = pk4_fp8((v[j].x * (1.f + sc.x) + sh.x) * H8_SCALE, (v[j].y * (1.f + sc.y) + sh.y) * H8_SCALE, (v[j].z * (1.f + sc.z) + sh.z) * H8_SCALE, (v[j].w * (1.f + sc.w) + sh.w) * H8_SCALE); } }
            } }
    }
}

#define XB_TMO      128
#define XB_XCNT(j)  (256  + 64 * (j))
#define XB_XSUB(j)  (1280 + 64 * (j))
#define XB_XGEN(j)  (2304 + 64 * (j))
#define XB_TOP      3328
#define XB_TOPGEN   3392
#define XCD_BAR_WORDS 3456
#define XB_SPIN_CAP (1u << 20)

__device__ __forceinline__ unsigned xb_ld(unsigned* p)              { return __hip_atomic_load(p, __ATOMIC_RELAXED, __HIP_MEMORY_SCOPE_AGENT); }
__device__ __forceinline__ unsigned xb_add(unsigned* p, unsigned v) { return __hip_atomic_fetch_add(p, v, __ATOMIC_RELAXED, __HIP_MEMORY_SCOPE_AGENT); }
__device__ __forceinline__ unsigned xb_xcc_id() { return (unsigned)__builtin_amdgcn_s_getreg((3 << 11) | 20) & 0xFu; }
#define XB_SPIN(cond, bar) do { unsigned _sp = 0; while (cond) { __builtin_amdgcn_s_sleep(1); \
    if ((++_sp & 255u) == 0u) { if (xb_ld(&(bar)[XB_TMO])) break; if (_sp > XB_SPIN_CAP) { atomicAdd(&(bar)[XB_TMO], 1u); break; } } } } while (0)

struct XcdBarrier {
    unsigned* bar; unsigned x;
    volatile LAS unsigned* st;
};

__device__ __forceinline__ XcdBarrier xcd_barrier_post(unsigned* bar, volatile LAS unsigned* st) {
    XcdBarrier b; b.bar = bar; b.x = xb_xcc_id(); b.st = st;
    if (threadIdx.x == 0) (void)xb_add(&bar[XB_XCNT(b.x)], 1u);
    return b;
}
__device__ __forceinline__ void xcd_barrier_complete(unsigned* bar, unsigned x, unsigned& nloc, unsigned& nx) {
    const unsigned G = gridDim.x * gridDim.y * gridDim.z;
    unsigned sum, cnt, mine, sp = 0u;
    for (;;) {
        sum = 0u; cnt = 0u; mine = 0u;
#pragma unroll
        for (unsigned j = 0; j < 16; ++j) { const unsigned c = xb_ld(&bar[XB_XCNT(j)]); sum += c; cnt += (c > 0u) ? 1u : 0u; mine = (j == x) ? c : mine; }
        if (sum == G) break;
        __builtin_amdgcn_s_sleep(1);
        if ((++sp & 255u) == 0u) { if (xb_ld(&bar[XB_TMO])) break; if (sp > XB_SPIN_CAP) { atomicAdd(&bar[XB_TMO], 1u); break; } }
    }
    nloc = mine > 0u ? mine : 1u; nx = cnt > 0u ? cnt : 1u;
}

__device__ __forceinline__ void xcd_barrier(const XcdBarrier& b) {
    asm volatile("s_waitcnt vmcnt(0)" ::: "memory");
    __syncthreads();
    if (threadIdx.x == 0) {
        unsigned* bar = b.bar;
        __builtin_amdgcn_s_waitcnt(0);
        unsigned nloc = b.st[0], nx = b.st[1];
        if (nloc == 0u) { xcd_barrier_complete(bar, b.x, nloc, nx); b.st[0] = nloc; b.st[1] = nx; }
        const unsigned old = xb_add(&bar[XB_XSUB(b.x)], 1u);
        const unsigned gen = old / nloc;
        if (old + 1u == (gen + 1u) * nloc) {
            __builtin_amdgcn_fence(__ATOMIC_RELEASE, "agent");
            asm volatile("s_waitcnt vmcnt(0)" ::: "memory");
            const unsigned og = xb_add(&bar[XB_TOP], 1u);
            const unsigned tg = og / nx;
            if (og + 1u == (tg + 1u) * nx) xb_add(&bar[XB_TOPGEN], 1u);
            else XB_SPIN(xb_ld(&bar[XB_TOPGEN]) == tg, bar);
            __builtin_amdgcn_fence(__ATOMIC_ACQUIRE, "agent");
            xb_add(&bar[XB_XGEN(b.x)], 1u);
            asm volatile("s_waitcnt vmcnt(0)" ::: "memory");
        } else {
            XB_SPIN(xb_ld(&bar[XB_XGEN(b.x)]) == gen, bar);
            __builtin_amdgcn_fence(__ATOMIC_ACQUIRE, "agent");
            asm volatile("s_waitcnt vmcnt(0)" ::: "memory");
        }
    }
    __syncthreads();
}


constexpr int NPHASES = 2 + 8 * DEPTH;
__global__ void __launch_bounds__(NTHREADS, 2) fwd_kernel(Params P) {
    extern __shared__ __attribute__((aligned(16))) unsigned char lds_raw[];
    LAS unsigned char* lds = (LAS unsigned char*)lds_raw;
    const int tid = threadIdx.x, bid = blockIdx.x, nb = gridDim.x;
    const int lo = P.ph_lo, hi = P.ph_hi;
    volatile LAS unsigned* misc = (volatile LAS unsigned*)(lds + LDS_MISC);
    if (tid < 4) misc[tid] = 0u;
    __syncthreads();
    XcdBarrier bar; bar.bar = (unsigned*)(P.ws + WS_CTL) + CW_BAR; bar.x = 0; bar.st = misc;
    if (hi - lo > 1) bar = xcd_barrier_post((unsigned*)(P.ws + WS_CTL) + CW_BAR, misc);
#define IN(k) (lo <= (k) && (k) < hi)
#define GRIDBAR() do { XcdBarrier b2_ = bar; int z2_ = 0; asm volatile("" : "+s"(z2_)); b2_.bar = bar.bar + z2_; xcd_barrier(b2_); } while (0)
#define SEAM(k) do { if (lo <= (k) && (k) + 1 < hi) GRIDBAR(); } while (0)
#define DUP(bit, call) do { if (PROBE_DUP & (bit)) { GRIDBAR(); call; } } while (0)
    if (IN(0)) { phase_prologue_a(P, lds, tid, bid, nb); DUP(1, phase_prologue_a(P, lds, tid, bid, nb)); SEAM(0); }
    if (IN(1)) { phase_prologue_b(P, tid, bid, nb); SEAM(1); }
#pragma unroll 1
    for (int i = 0; i < DEPTH; ++i) {
        const int pb = 2 + 8 * i, j = i >> 1;
        Params Pl = P; { int z_ = 0; asm volatile("" : "+s"(z_)); Pl.ws = P.ws + z_; }
        int tid_l = threadIdx.x, bid_l = blockIdx.x; asm volatile("" : "+v"(tid_l)); asm volatile("" : "+s"(bid_l));
        const bool last = (i == DEPTH - 1);
        const int Mres = last ? ML : M;
        if ((i & 1) == 0) {
            if (IN(pb + 0)) { phase_gemm_dense<0>(Pl, lds, tid_l, bid_l, nb, (const void*)(Pl.ws + WS_H), (const void*)(Pl.ws + WS_WABIN + (size_t)j * AB_IN * 1024), M, AB_IN, i); DUP(2, phase_gemm_dense<0>(Pl, lds, tid_l, bid_l, nb, (const void*)(Pl.ws + WS_H), (const void*)(Pl.ws + WS_WABIN + (size_t)j * AB_IN * 1024), M, AB_IN, i)); SEAM(pb + 0); }
            if (IN(pb + 1)) { phase_even_mixer(Pl, lds, j, tid_l, bid_l, nb); DUP(4, phase_even_mixer(Pl, lds, j, tid_l, bid_l, nb)); SEAM(pb + 1); }
            if (IN(pb + 3)) { phase_gemm_dense<1>(Pl, lds, tid_l, bid_l, nb, (const bf16*)(Pl.ws + WS_A2), (const bf16*)(Pl.ws + WS_WABOUT) + (size_t)j * 1024 * 1024, Mres, 1024, i); SEAM(pb + 3); }
        } else {
            if (IN(pb + 0)) { phase_gemm_dense<0>(Pl, lds, tid_l, bid_l, nb, (const void*)(Pl.ws + WS_H), (const void*)(Pl.ws + WS_WGIN + (size_t)j * WGIN_STRIDE), M, GLA_IN, i); DUP(2, phase_gemm_dense<0>(Pl, lds, tid_l, bid_l, nb, (const void*)(Pl.ws + WS_H), (const void*)(Pl.ws + WS_WGIN + (size_t)j * WGIN_STRIDE), M, GLA_IN, i)); SEAM(pb + 0); }
            if (IN(pb + 1)) { if (PROBE_DUP & (1 << 16)) { phase_gla_prepass(Pl, lds, j, tid_l, bid_l, nb, (PROBE_DUP >> 17) & 15); GRIDBAR(); } phase_gla_prepass(Pl, lds, j, tid_l, bid_l, nb); DUP(128, phase_gla_prepass(Pl, lds, j, tid_l, bid_l, nb)); GRIDBAR(); phase_gla_scan(Pl, lds, tid_l, bid_l, nb); DUP(8, phase_gla_scan(Pl, lds, tid_l, bid_l, nb)); SEAM(pb + 1); }
            if (IN(pb + 2)) { phase_gla_out(Pl, j, tid_l, bid_l, nb, Mres); DUP(64, phase_gla_out(Pl, j, tid_l, bid_l, nb, Mres)); SEAM(pb + 2); }
            if (IN(pb + 3)) { phase_gemm_dense<1>(Pl, lds, tid_l, bid_l, nb, (const bf16*)(Pl.ws + WS_A2), (const bf16*)(Pl.ws + WS_WGOUT) + (size_t)j * 1024 * 1024, Mres, 1024, i); SEAM(pb + 3); }
        }
        if (IN(pb + 4)) { if (PROBE_DUP & 256) { phase_ln1_router(Pl, lds, i, tid_l, bid_l, nb, Mres, true); GRIDBAR(); } phase_ln1_router(Pl, lds, i, tid_l, bid_l, nb, Mres); SEAM(pb + 4); }
        if (IN(pb + 5)) { if (PROBE_DUP & (1024 | 2048 | 4096 | 8192 | 16384 | 32768)) { phase_moe_gemm<1>(Pl, lds, tid_l, bid_l, nb, i, (PROBE_DUP >> 10) & 63); GRIDBAR(); } phase_moe_gemm<1>(Pl, lds, tid_l, bid_l, nb, i); DUP(16, phase_moe_gemm<1>(Pl, lds, tid_l, bid_l, nb, i)); SEAM(pb + 5); }
        if (IN(pb + 6)) { phase_moe_gemm<2>(Pl, lds, tid_l, bid_l, nb, i); DUP(32, phase_moe_gemm<2>(Pl, lds, tid_l, bid_l, nb, i)); SEAM(pb + 6); }
        if (IN(pb + 7)) { if (PROBE_DUP & 512) { phase_ln2_combine(Pl, lds, i, tid_l, bid_l, nb, Mres, true); GRIDBAR(); } phase_ln2_combine(Pl, lds, i, tid_l, bid_l, nb, Mres); SEAM(pb + 7); }
    }
#undef IN
#undef SEAM
#undef GRIDBAR
}

extern "C" void kernel_launch(void* const* d_in, const int* in_sizes, int n_in, void* d_out, int out_size, void* d_ws, size_t ws_size, hipStream_t stream) {
    static int grid = 0;
    if (grid == 0) {
        if (n_in != 24 || out_size != ML * D || ws_size < WS_END) { fprintf(stderr, "kernel_launch: unexpected problem (n_in %d, out %d, ws %zu < %zu)\n", n_in, out_size, ws_size, (size_t)WS_END); grid = -1; return; }
        int dev = 0, cus = 0, per_cu = 0;
        if (hipGetDevice(&dev) != hipSuccess || hipDeviceGetAttribute(&cus, hipDeviceAttributeMultiprocessorCount, dev) != hipSuccess) { grid = -1; return; }
        if (hipFuncSetAttribute((const void*)fwd_kernel, hipFuncAttributeMaxDynamicSharedMemorySize, LDS_BYTES) != hipSuccess) { fprintf(stderr, "kernel_launch: hipFuncSetAttribute failed\n"); grid = -1; return; }
        if (hipOccupancyMaxActiveBlocksPerMultiprocessor(&per_cu, (const void*)fwd_kernel, NTHREADS, LDS_BYTES) != hipSuccess || per_cu < 1) { fprintf(stderr, "kernel_launch: occupancy query says %d blocks per CU\n", per_cu); }
        (void)hipGetLastError();
        grid = cus;
    }
    if (grid < 0) return;
    (void)hipMemsetAsync((char*)d_ws + WS_CTL, 0, CTL_ZERO_BYTES, stream);
    Params p{};
    for (int i = 0; i < 24; ++i) p.in[i] = (const float*)d_in[i];
    p.out = (float*)d_out; p.ws = (unsigned char*)d_ws;
#if MK_PER_PHASE
    for (int ph = 0; ph < NPHASES; ++ph) {
        if (ph >= 2 && ((ph - 2) & 7) == 2 && ((((ph - 2) >> 3) & 1) == 0)) continue;
        p.ph_lo = ph; p.ph_hi = ph + 1;
        hipLaunchKernelGGL(fwd_kernel, dim3(grid), dim3(NTHREADS), LDS_BYTES, stream, p);
    }
#else
    p.ph_lo = 0; p.ph_hi = NPHASES;
    hipLaunchKernelGGL(fwd_kernel, dim3(grid), dim3(NTHREADS), LDS_BYTES, stream, p);
#endif
    const hipError_t le = hipPeekAtLastError();
    if (le != hipSuccess) fprintf(stderr, "kernel_launch: launch failed: %s\n", hipGetErrorName(le));
}
```

```cpp
#include <hip/hip_runtime.h>
#include <cstdio>
#include <cstdint>

#ifndef MK_PER_PHASE
#define MK_PER_PHASE 0
#endif

#ifndef PROBE_DUP
#define PROBE_DUP 0
#endif
#define LAS __attribute__((address_space(3)))
typedef unsigned short bf16;
typedef short bf16x8 __attribute__((ext_vector_type(8)));
typedef float f32x4 __attribute__((ext_vector_type(4)));
typedef unsigned u32x4 __attribute__((ext_vector_type(4)));
typedef unsigned u32x2 __attribute__((ext_vector_type(2)));

constexpr int D = 1024, NBATCH = 8, T = 4096, NCTX = 256, DEPTH = 4;
constexpr int ML = NBATCH * T, MC = NBATCH * NCTX, M = ML + MC;
constexpr int AB_IN = 2560, GLA_IN = 3104, NE = 32;
constexpr int NSLOT = M * 4;
constexpr float DN_ALPHA = 1.6817928305074292f;
constexpr float LN_EPS = 1e-5f;
constexpr int NTHREADS = 512, NWAVES = 8;

constexpr size_t MiB = 1ull << 20;
constexpr size_t WS_CTL = 0, CTL_ZERO_BYTES = 1 * MiB;
constexpr size_t WS_MODS = 1 * MiB;
constexpr size_t WS_WABIN = 2 * MiB;
constexpr size_t WS_WABOUT = 12 * MiB;
constexpr size_t WS_WGIN = 16 * MiB, WGIN_STRIDE = (size_t)3328 * 1024;
constexpr size_t WS_WGOUT = 29 * MiB;
constexpr size_t WS_W1T = 33 * MiB;
constexpr size_t WS_W2T = 545 * MiB;
constexpr size_t WS_X = 801 * MiB;
constexpr size_t WS_H = 937 * MiB;
constexpr size_t WS_P = 1005 * MiB;
constexpr size_t WS_A2 = 1213 * MiB;
constexpr size_t WS_OF = 1281 * MiB;
constexpr size_t WS_OB = 1417 * MiB;
constexpr size_t WS_ACT = 1553 * MiB;
constexpr size_t WS_YS = 1827 * MiB;
constexpr size_t WS_LIST = 2101 * MiB;
constexpr size_t WS_TOKE = 2106 * MiB;
constexpr size_t WS_TOKP = 2107 * MiB;
constexpr size_t WS_TOKG = 2108 * MiB;
constexpr size_t WS_VT = 2109 * MiB;
constexpr size_t WS_VTC = WS_VT + 48 * MiB;
constexpr size_t WS_GQD = 2165 * MiB;
constexpr size_t WS_GKLT = 2241 * MiB;
constexpr size_t WS_GATT = 2319 * MiB;
constexpr size_t WS_GDEC = 2359 * MiB;
constexpr size_t WS_GVT = 2362 * MiB;
constexpr size_t WS_ROPE = 2440 * MiB;
constexpr size_t WS_H8 = 2442 * MiB;
constexpr size_t WS_RWT = 2477 * MiB;
constexpr size_t WS_END = 2478 * MiB;
constexpr int CW_BAR = 4096;
constexpr int CW_CNT = 8192;

constexpr int LDS_BYTES = 155648;
constexpr int LDS_MISC = 155648 - 256;

struct Params {
    const float* in[24];
    float* out;
    unsigned char* ws;
    int ph_lo, ph_hi;
};

#define LDS_WAIT() asm volatile("s_waitcnt lgkmcnt(0)" ::: "memory")
#define LDS_BARRIER() asm volatile("s_waitcnt lgkmcnt(0)\n\ts_barrier" ::: "memory")
__device__ __forceinline__ unsigned f2bf(float f) { unsigned u = __builtin_bit_cast(unsigned, f); return (u + 0x7fffu + ((u >> 16) & 1u)) >> 16; }
__device__ __forceinline__ float bf2f(unsigned h) { return __builtin_bit_cast(float, h << 16); }
typedef float f32x2 __attribute__((ext_vector_type(2)));
typedef __bf16 bf16x2_t __attribute__((ext_vector_type(2)));
__device__ __forceinline__ unsigned pk2(float lo, float hi) { const f32x2 v = {lo, hi}; const bf16x2_t b = __builtin_convertvector(v, bf16x2_t); return __builtin_bit_cast(unsigned, b); }
template <int CTRL> __device__ __forceinline__ float dppf(float x) { return __builtin_bit_cast(float, __builtin_amdgcn_update_dpp(0, __builtin_bit_cast(int, x), CTRL, 0xf, 0xf, false)); }
__device__ __forceinline__ void swap16(float x, float& a, float& b) { const unsigned u = __builtin_bit_cast(unsigned, x); const auto r = __builtin_amdgcn_permlane16_swap(u, u, false, false); const unsigned r0 = r[0], r1 = r[1]; a = __builtin_bit_cast(float, r0); b = __builtin_bit_cast(float, r1); }
__device__ __forceinline__ void swap32(float x, float& a, float& b) { const unsigned u = __builtin_bit_cast(unsigned, x); const auto r = __builtin_amdgcn_permlane32_swap(u, u, false, false); const unsigned r0 = r[0], r1 = r[1]; a = __builtin_bit_cast(float, r0); b = __builtin_bit_cast(float, r1); }
__device__ __forceinline__ float xsum_16_32(float v) { float a, b; swap16(v, a, b); v = a + b; swap32(v, a, b); return a + b; }
__device__ __forceinline__ float xmax_16_32(float v) { float a, b; swap16(v, a, b); v = fmaxf(a, b); swap32(v, a, b); return fmaxf(a, b); }
__device__ __forceinline__ float wave_sum(float v) {
    v += dppf<0xB1>(v);
    v += dppf<0x4E>(v);
    v += dppf<0x141>(v);
    v += dppf<0x140>(v);
    return xsum_16_32(v);
}
__device__ __forceinline__ f32x4 mfma16(bf16x8 a, bf16x8 b, f32x4 c) { return __builtin_amdgcn_mfma_f32_16x16x32_bf16(a, b, c, 0, 0, 0); }
__device__ __forceinline__ bf16x8 mk_frag(unsigned a, unsigned b, unsigned c, unsigned d) { u32x4 v = {a, b, c, d}; return __builtin_bit_cast(bf16x8, v); }
__device__ __forceinline__ unsigned pk4_fp8(float a, float b, float c, float d) {
    a = fminf(fmaxf(a, -448.f), 448.f); b = fminf(fmaxf(b, -448.f), 448.f); c = fminf(fmaxf(c, -448.f), 448.f); d = fminf(fmaxf(d, -448.f), 448.f);
    int w = 0; w = __builtin_amdgcn_cvt_pk_fp8_f32(a, b, w, false); w = __builtin_amdgcn_cvt_pk_fp8_f32(c, d, w, true); return (unsigned)w; }
__device__ __forceinline__ unsigned pk4_fp8_nc(float a, float b, float c, float d) { int w = 0; w = __builtin_amdgcn_cvt_pk_fp8_f32(a, b, w, false); w = __builtin_amdgcn_cvt_pk_fp8_f32(c, d, w, true); return (unsigned)w; }
constexpr float H8_SCALE = 16.f, ACT8_SCALE = 4.f, W1_SCALE = 256.f, W2_SCALE = 512.f;
constexpr int H8_E8 = 0x7B7B7B7B, ACT8_E8 = 0x7D7D7D7D, W1_E8 = 0x77777777, W2_E8 = 0x76767676;
__device__ __forceinline__ float silu_f(float x) { return x / (1.f + __expf(-x)); }


__device__ __forceinline__ void conv_item(const float* W, int N, int k0, int nsrc, bf16* WT, int ndst, LAS float* scr, int lane) {
#pragma unroll 8
    for (int i = 0; i < 32; ++i) { const int kk = 2 * i + (lane >> 5); scr[kk * 33 + (lane & 31)] = W[(size_t)(k0 + kk) * N + nsrc + (lane & 31)]; }
    LDS_WAIT(); asm volatile("" ::: "memory");
    const int c = lane & 7;
#pragma unroll
    for (int j = 0; j < 4; ++j) { const int n = (lane >> 3) + 8 * j; const LAS float* s = scr + (8 * c) * 33 + n;
        u32x4 o; o.x = pk2(s[0 * 33], s[1 * 33]); o.y = pk2(s[2 * 33], s[3 * 33]); o.z = pk2(s[4 * 33], s[5 * 33]); o.w = pk2(s[6 * 33], s[7 * 33]);
        *(u32x4*)(WT + (size_t)(ndst + n) * 1024 + k0 + 8 * c) = o; }
    LDS_WAIT(); asm volatile("" ::: "memory");
}

__device__ __forceinline__ void conv_item8(const float* W, int N, int k0, int nsrc, unsigned char* WT8, int ndst, float scale, LAS float* scr, int lane) {
#pragma unroll 8
    for (int i = 0; i < 32; ++i) { const int kk = 2 * i + (lane >> 5); scr[kk * 33 + (lane & 31)] = W[(size_t)(k0 + kk) * N + nsrc + (lane & 31)]; }
    LDS_WAIT(); asm volatile("" ::: "memory");
    const int c = lane & 7;
#pragma unroll
    for (int j = 0; j < 4; ++j) { const int n = (lane >> 3) + 8 * j; const LAS float* s = scr + (8 * c) * 33 + n;
        u32x2 o; o.x = pk4_fp8(s[0 * 33] * scale, s[1 * 33] * scale, s[2 * 33] * scale, s[3 * 33] * scale); o.y = pk4_fp8(s[4 * 33] * scale, s[5 * 33] * scale, s[6 * 33] * scale, s[7 * 33] * scale);
        *(u32x2*)(WT8 + (size_t)(ndst + n) * 1024 + k0 + 8 * c) = o; }
    LDS_WAIT(); asm volatile("" ::: "memory");
}

__device__ __forceinline__ void phase_prologue_a(const Params& P, LAS unsigned char* lds, int tid, int bid, int nb) {
    const int lane = tid & 63, wave = tid >> 6;
    unsigned char* ws = P.ws;
    for (int idx = bid * NTHREADS + tid; idx < T * 64; idx += nb * NTHREADS) { const int t = idx >> 6, f = idx & 63;
        const float pos = (f < 32) ? (float)(t >> 6) : (float)(t & 63); const float freq = expf(-(float)(f & 31) * (9.210340371976184f / 32.0f));
        float sn, cn; sincosf(pos * freq, &sn, &cn); ((float*)(ws + WS_ROPE))[idx] = cn; ((float*)(ws + WS_ROPE))[T * 64 + idx] = sn; }
    for (int idx = bid * NTHREADS + tid; idx < DEPTH * 32 * 1024; idx += nb * NTHREADS) { const int l = idx >> 15, e = (idx >> 10) & 31, k = idx & 1023;
        const float w = P.in[18][((size_t)l * 1024 + k) * 32 + e]; const unsigned hi = f2bf(w); const unsigned lo = f2bf(w - bf2f(hi));
        bf16* rwt = (bf16*)(ws + WS_RWT) + (size_t)l * 2 * 32 * 1024; rwt[e * 1024 + k] = (bf16)hi; rwt[32 * 1024 + e * 1024 + k] = (bf16)lo; }
    for (int u = bid; u < 4 * 48; u += nb) {
        const int l = u / 48, j0 = (u % 48) * 128;
        LAS float* sc = (LAS float*)lds;
        LAS float* red = (LAS float*)(lds + 9 * 1024 * 4);
        for (int idx = tid; idx < 9 * 1024; idx += NTHREADS) { const int r = idx >> 10, k = idx & 1023; const float c = (r < 8) ? P.in[1][r * 1024 + k] : P.in[3][k]; sc[idx] = silu_f(c); }
        __syncthreads();
        const int c = tid & 127, kq = tid >> 7;
        float acc[9];
#pragma unroll
        for (int r = 0; r < 9; ++r) acc[r] = 0.f;
        const float* w = P.in[4] + (size_t)l * 1024 * 6144 + j0 + c;
        for (int k = kq * 256; k < kq * 256 + 256; ++k) { const float wv = w[(size_t)k * 6144];
#pragma unroll
            for (int r = 0; r < 9; ++r) acc[r] += sc[r * 1024 + k] * wv; }
#pragma unroll
        for (int r = 0; r < 9; ++r) red[(kq * 9 + r) * 128 + c] = acc[r];
        __syncthreads();
        float* mods = (float*)(ws + WS_MODS);
        for (int idx = tid; idx < 9 * 128; idx += NTHREADS) { const int r = idx >> 7, cc = idx & 127;
            const float s = (red[(0 * 9 + r) * 128 + cc] + red[(1 * 9 + r) * 128 + cc]) + (red[(2 * 9 + r) * 128 + cc] + red[(3 * 9 + r) * 128 + cc]);
            mods[(size_t)(l * 9 + r) * 6144 + j0 + cc] = s + P.in[5][l * 6144 + j0 + cc]; }
        __syncthreads();
    }
    LAS float* scr = (LAS float*)(lds + wave * 16384);
    const int gw = bid * NWAVES + wave, NGW = nb * NWAVES;
    constexpr int I0 = 2 * 16 * 80, I1 = 2 * 16 * 32, I2 = 2 * 16 * 97, I3 = 2 * 16 * 32, I4 = 128 * 16 * 64, I5 = 128 * 16 * 32;
    constexpr int NITEMS = I0 + I1 + I2 + I3 + I4 + I5;
    for (int it = gw; it < NITEMS; it += NGW) {
        int r = it;
        if (r < I0) { const int mt = r / (16 * 80), q = r % (16 * 80), kb = q / 80, nbk = q % 80;
            conv_item8(P.in[8] + (size_t)mt * 1024 * AB_IN, AB_IN, kb * 64, nbk * 32, (unsigned char*)(ws + WS_WABIN) + (size_t)mt * AB_IN * 1024, nbk * 32, W1_SCALE, scr, lane); continue; } r -= I0;
        if (r < I1) { const int mt = r / (16 * 32), q = r % (16 * 32), kb = q / 32, nbk = q % 32;
            conv_item(P.in[12] + (size_t)mt * 1024 * 1024, 1024, kb * 64, nbk * 32, (bf16*)(ws + WS_WABOUT) + (size_t)mt * 1024 * 1024, nbk * 32, scr, lane); continue; } r -= I1;
        if (r < I2) { const int mt = r / (16 * 97), q = r % (16 * 97), kb = q / 97, nbk = q % 97;
            conv_item8(P.in[13] + (size_t)mt * 1024 * GLA_IN, GLA_IN, kb * 64, nbk * 32, (unsigned char*)(ws + WS_WGIN) + (size_t)mt * WGIN_STRIDE, nbk * 32, W1_SCALE, scr, lane); continue; } r -= I2;
        if (r < I3) { const int mt = r / (16 * 32), q = r % (16 * 32), kb = q / 32, nbk = q % 32;
            conv_item(P.in[17] + (size_t)mt * 1024 * 1024, 1024, kb * 64, nbk * 32, (bf16*)(ws + WS_WGOUT) + (size_t)mt * 1024 * 1024, nbk * 32, scr, lane); continue; } r -= I3;
        if (r < I4) { const int mt = r / (16 * 64), q = r % (16 * 64), kb = q / 64, rb = q % 64;
            const int tile = rb >> 3, half = (rb >> 2) & 1, qq = rb & 3; const int nsrc = half * 1024 + tile * 128 + qq * 32;
            conv_item8(P.in[20] + (size_t)mt * 1024 * 2048, 2048, kb * 64, nsrc, (unsigned char*)(ws + WS_W1T) + (size_t)mt * 2048 * 1024, rb * 32, W1_SCALE, scr, lane); continue; } r -= I4;
        { const int mt = r / (16 * 32), q = r % (16 * 32), kb = q / 32, nbk = q % 32;
            conv_item8(P.in[22] + (size_t)mt * 1024 * 1024, 1024, kb * 64, nbk * 32, (unsigned char*)(ws + WS_W2T) + (size_t)mt * 1024 * 1024, nbk * 32, W2_SCALE, scr, lane); }
    }
}

__device__ __forceinline__ void store_h_row(unsigned char* hrow, const f32x4 (&v)[4], const float* shift, const float* scale, int lane) {
#pragma unroll
    for (int j = 0; j < 4; ++j) { const int col = 4 * lane + 256 * j;
        const f32x4 sh = *(const f32x4*)(shift + col), sc = *(const f32x4*)(scale + col);
        *(unsigned*)(hrow + col) = pk4_fp8((v[j].x * (1.f + sc.x) + sh.x) * H8_SCALE, (v[j].y * (1.f + sc.y) + sh.y) * H8_SCALE, (v[j].z * (1.f + sc.z) + sh.z) * H8_SCALE, (v[j].w * (1.f + sc.w) + sh.w) * H8_SCALE); }
}

__device__ __forceinline__ void phase_prologue_b(const Params& P, int tid, int bid, int nb) {
    const int lane = tid & 63, wave = tid >> 6; unsigned char* ws = P.ws;
    const float* mods = (const float*)(ws + WS_MODS);
    for (int m = bid * NWAVES + wave; m < M; m += nb * NWAVES) {
        const float* src = (m < ML) ? P.in[0] + (size_t)m * D : P.in[2] + (size_t)(m - ML) * D;
        const int mb = (m < ML) ? (m >> 12) : 8;
        f32x4 v[4];
#pragma unroll
        for (int j = 0; j < 4; ++j) v[j] = *(const f32x4*)(src + 4 * lane + 256 * j);
        const float* md = mods + (size_t)(0 * 9 + mb) * 6144;
        store_h_row((unsigned char*)(ws + WS_H) + (size_t)m * D, v, md + 0, md + 1024, lane);
    }
}


namespace g8 {
constexpr int BM = 256, BK = 64, HALF = 128, HTB = HALF * BK * 2, STAGE_BYTES = 8 * HTB, NXCD = 8, WGM = 8, KDIM = 1024, NT = KDIM / BK;
__device__ __forceinline__ int lds_byte(int r, int c) { const int st = (r >> 4) * 2 + (c >> 5), rr = r & 15, cc = c & 31, ob = rr * 64 + cc * 2; return st * 1024 + (ob ^ (((ob >> 9) & 1) << 5)); }
__device__ __forceinline__ void stage_rc(int b, int& R, int& C) { const int st = b / 1024, sb = b % 1024, swz = sb ^ (((sb >> 9) & 1) << 5); R = (st >> 1) * 16 + swz / 64; C = (st & 1) * 32 + (swz % 64) / 2; }
template <bool FP8> __device__ __forceinline__ void stage_rcb(int b, int& R, int& CB) { const int st = b / 1024, sb = b % 1024, swz = sb ^ (((sb >> 9) & 1) << 5); R = (st >> 1) * 16 + swz / 64;
    CB = FP8 ? (2 * ((swz % 64) >> 4) + (st & 1)) * 16 : (st & 1) * 64 + (swz % 64); }
__device__ __forceinline__ int perm32(int rho) { const int n = rho >> 4, i = rho & 15; return 8 * (i >> 2) + 4 * n + (i & 3); }

struct Unit { int pm, pn, ui, e, nvalid; unsigned slot0; };
typedef int i32x8 __attribute__((ext_vector_type(8)));
typedef int i32x4 __attribute__((ext_vector_type(4)));
__device__ __forceinline__ i32x8 cat8(bf16x8 lo, bf16x8 hi) { const u32x4 a = __builtin_bit_cast(u32x4, lo), c = __builtin_bit_cast(u32x4, hi); return (i32x8){(int)a.x, (int)a.y, (int)a.z, (int)a.w, (int)c.x, (int)c.y, (int)c.z, (int)c.w}; }

template <class Prob, class Epi>
__device__ __forceinline__ void gemm_phase(LAS unsigned char* lds, const Prob& S, const Epi& E, int tid) {
    const int wid = __builtin_amdgcn_readfirstlane(tid >> 6), wr = wid >> 2, wc = wid & 3;
    constexpr int ROWB = Prob::FP8 ? KDIM : KDIM * 2;
    constexpr int NTK = Prob::FP8 ? NT / 2 : NT;
    unsigned voffB; { int R0, CB; stage_rcb<Prob::FP8>(tid * 16, R0, CB); const int Rb = Epi::PERM ? ((R0 & ~31) + perm32(R0 & 31)) : R0; voffB = (unsigned)(Rb * ROWB + CB); }
    constexpr size_t kstep = (size_t)(BK * 2);
    constexpr size_t hstep = (size_t)HALF * ROWB;
    constexpr size_t pstep = (size_t)64 * ROWB;
    const unsigned ldsw = (unsigned)wid * 1024u;
    int aoff, boff; { const int fr = tid & 15, fq = (tid >> 4) & 3; aoff = lds_byte(wr * 64 + fr, fq * 8); boff = lds_byte(wc * 32 + fr, fq * 8); }
#define PG8_SA(b, h) (((b) * 2 + (h)) * HTB)
#define PG8_SB(b, h) ((4 + (b) * 2 + (h)) * HTB)
#define PG8_GLDS2(sbase, voff, ldsoff) do { const char* _sb = (const char*)(sbase); asm volatile("" : "+s"(_sb)); unsigned _vo = (voff); asm volatile("" : "+v"(_vo)); __builtin_amdgcn_global_load_lds((const unsigned*)(_sb + _vo), (LAS unsigned*)(lds + (ldsoff)), 16, 0, 0); } while (0)
#define PG8_STAGE_B(bufoff, gbase) do { PG8_GLDS2((const char*)(gbase), voffB, (bufoff) + ldsw); PG8_GLDS2((const char*)(gbase) + pstep, voffB, (bufoff) + ldsw + 8192); } while (0)
#define PG8_STAGE_A(bufoff, gbase, h) do { if (Prob::GATHER) { PG8_GLDS2((const char*)(gbase), vA[h][0], (bufoff) + ldsw); PG8_GLDS2((const char*)(gbase), vA[h][1], (bufoff) + ldsw + 8192); } \
        else { PG8_GLDS2((const char*)(gbase) + (h) * hstep, vA[0][0], (bufoff) + ldsw); PG8_GLDS2((const char*)(gbase) + (h) * hstep + pstep, vA[0][0], (bufoff) + ldsw + 8192); } } while (0)
#define PG8_LDA(dst, b, h) do { _Pragma("unroll") for (int m = 0; m < 4; ++m) _Pragma("unroll") for (int k = 0; k < 2; ++k) dst[m][k] = *(const LAS bf16x8*)(lds + PG8_SA(b, h) + aoff + m * 2048 + k * 1024); } while (0)
#define PG8_LDB(dst, b, h) do { _Pragma("unroll") for (int n = 0; n < 2; ++n) _Pragma("unroll") for (int k = 0; k < 2; ++k) dst[n][k] = *(const LAS bf16x8*)(lds + PG8_SB(b, h) + boff + n * 2048 + k * 1024); } while (0)
#define PG8_MMA(ai, bj, At, Bt) do { __builtin_amdgcn_s_setprio(1); _Pragma("unroll") for (int m = 0; m < 4; ++m) _Pragma("unroll") for (int n = 0; n < 2; ++n) { \
        if constexpr (Prob::FP8) acc[ai][bj][m][n] = __builtin_amdgcn_mfma_scale_f32_16x16x128_f8f6f4(cat8(Bt[n][0], Bt[n][1]), cat8(At[m][0], At[m][1]), acc[ai][bj][m][n], 0, 0, 0, Prob::SCALE_B, 0, Prob::SCALE_A); \
        else { _Pragma("unroll") for (int k = 0; k < 2; ++k) acc[ai][bj][m][n] = __builtin_amdgcn_mfma_f32_16x16x32_bf16(Bt[n][k], At[m][k], acc[ai][bj][m][n], 0, 0, 0); } } __builtin_amdgcn_s_setprio(0); } while (0)
#define PG8_WAIT_V(n) asm volatile("s_waitcnt vmcnt(" #n ")" ::: "memory")
#define PG8_WAIT_L(n) asm volatile("s_waitcnt lgkmcnt(" #n ")" ::: "memory")
#define PG8_BAR __builtin_amdgcn_s_barrier()
#define PG8_SCHED __builtin_amdgcn_sched_barrier(0)
    Unit cur, nxt; int ui = 0;
    if (!S.next(0, cur)) return;
    f32x4 acc[2][2][4][2];
#pragma unroll
    for (int a = 0; a < 2; ++a)
#pragma unroll
        for (int b = 0; b < 2; ++b)
#pragma unroll
            for (int m = 0; m < 4; ++m)
#pragma unroll
                for (int n = 0; n < 2; ++n) acc[a][b][m][n] = (f32x4){0.f, 0.f, 0.f, 0.f};
    bf16x8 At[4][2], B0[2][2], B1[2][2];
    const char* cA = S.a_base(cur); const char* cB = S.b_base(cur);
    unsigned vA[2][2];
    S.a_voff(cur, tid, vA);
    PG8_STAGE_B(PG8_SB(0, 0), cB); PG8_STAGE_B(PG8_SB(0, 1), cB + hstep); PG8_STAGE_A(PG8_SA(0, 0), cA, 0); PG8_STAGE_A(PG8_SA(0, 1), cA, 1);
    if (wr == 1) PG8_BAR;
    PG8_WAIT_V(2); PG8_BAR;
    PG8_STAGE_B(PG8_SB(1, 0), cB + kstep); PG8_STAGE_A(PG8_SA(1, 0), cA + kstep, 0); PG8_STAGE_B(PG8_SB(1, 1), cB + hstep + kstep);
    PG8_WAIT_V(6); PG8_BAR;
    for (;;) {
        const bool has_next = S.next(ui + 1, nxt);
        const char* nA = cA; const char* nB = cB;
        unsigned vN[2];
        if (has_next) { nA = S.a_base(nxt); nB = S.b_base(nxt); if (Prob::GATHER) S.a_tok(nxt, tid, vN); }
#pragma unroll 1
        for (int t = 0; t < NTK; t += 2) {
            const bool last = (t == NTK - 2);
            const char* a1 = cA + (size_t)(t + 1) * kstep;
            const char* a2 = last ? nA : cA + (size_t)(t + 2) * kstep; const char* b2 = last ? nB : cB + (size_t)(t + 2) * kstep;
            const char* a3 = a2 + kstep; const char* b3 = b2 + kstep;
            PG8_LDB(B0, 0, 0); PG8_LDB(B1, 0, 1); PG8_SCHED; PG8_LDA(At, 0, 0); PG8_STAGE_A(PG8_SA(1, 1), a1, 1);
            PG8_WAIT_V(8); PG8_WAIT_L(0); PG8_BAR; PG8_MMA(0, 0, At, B0); PG8_MMA(0, 1, At, B1); PG8_BAR; PG8_SCHED;
            if (Prob::GATHER) { if (last && has_next) { int R0, CB; stage_rcb<Prob::FP8>(tid * 16, R0, CB); const unsigned c2 = (unsigned)CB; constexpr int SH = Prob::FP8 ? 10 : 11; vA[0][0] = ((vN[0] & 0xffffu) << SH) | c2; vA[0][1] = ((vN[0] >> 16) << SH) | c2; vA[1][0] = ((vN[1] & 0xffffu) << SH) | c2; vA[1][1] = ((vN[1] >> 16) << SH) | c2; } }
            PG8_LDA(At, 0, 1); PG8_STAGE_B(PG8_SB(0, 0), b2); PG8_STAGE_B(PG8_SB(0, 1), b2 + hstep); PG8_STAGE_A(PG8_SA(0, 0), a2, 0);
            PG8_WAIT_V(8); PG8_WAIT_L(0); PG8_BAR; PG8_MMA(1, 0, At, B0); PG8_MMA(1, 1, At, B1); PG8_BAR; PG8_SCHED;
            PG8_LDB(B0, 1, 0); PG8_LDB(B1, 1, 1); PG8_SCHED; PG8_LDA(At, 1, 0); PG8_STAGE_A(PG8_SA(0, 1), a2, 1);
            PG8_WAIT_V(8); PG8_WAIT_L(0); PG8_BAR; PG8_MMA(0, 0, At, B0); PG8_MMA(0, 1, At, B1); PG8_BAR; PG8_SCHED;
            PG8_LDA(At, 1, 1); PG8_STAGE_B(PG8_SB(1, 0), b3); PG8_STAGE_B(PG8_SB(1, 1), b3 + hstep); PG8_STAGE_A(PG8_SA(1, 0), a3, 0);
            PG8_WAIT_V(8); PG8_WAIT_L(0); PG8_BAR; PG8_MMA(1, 0, At, B0); PG8_MMA(1, 1, At, B1); PG8_BAR; PG8_SCHED;
        }
        if (wr == 0) PG8_BAR;
        { int t_e = tid; asm volatile("" : "+v"(t_e)); int fr_e = t_e & 15, fq_e = (t_e >> 4) & 3;
          E(acc, cur, wr, wc, fr_e, fq_e); }
        if (!has_next) break;
#pragma unroll
        for (int a = 0; a < 2; ++a)
#pragma unroll
            for (int b = 0; b < 2; ++b)
#pragma unroll
                for (int m = 0; m < 4; ++m)
#pragma unroll
                    for (int n = 0; n < 2; ++n) acc[a][b][m][n] = (f32x4){0.f, 0.f, 0.f, 0.f};
        cur = nxt; cA = nA; cB = nB; ++ui;
        if (wr == 1) PG8_BAR;
    }
    PG8_WAIT_V(0);
    PG8_BAR;
#undef PG8_SA
#undef PG8_SB
#undef PG8_GLDS2
#undef PG8_STAGE_A
#undef PG8_STAGE_B
#undef PG8_LDA
#undef PG8_LDB
#undef PG8_MMA
#undef PG8_WAIT_V
#undef PG8_WAIT_L
#undef PG8_BAR
#undef PG8_SCHED
}

template <bool F8>
struct DenseProb {
    const void* A; const void* Bt; int nM, nN, nwg, G, c;
    __device__ __forceinline__ void init(const void* A_, const void* Bt_, int Mrows, int Npad, int G_, int c_) { A = A_; Bt = Bt_; nM = Mrows / BM; nN = Npad / BM; nwg = nM * nN; G = G_; c = c_; }
    __device__ __forceinline__ bool next(int i, Unit& u) const {
        const long L = (long)i * G + c; if (L >= nwg) return false;
        int wgid = (int)L; { const int q = nwg / NXCD, r = nwg % NXCD, xcd = wgid % NXCD, off = wgid / NXCD; wgid = (xcd < r ? xcd * (q + 1) : r * (q + 1) + (xcd - r) * q) + off; }
        const int nig = WGM * nN, gid = wgid / nig, fm = gid * WGM, gsz = (nM - fm) < WGM ? (nM - fm) : WGM;
        u.pm = fm + ((wgid % nig) % gsz); u.pn = (wgid % nig) / gsz; u.ui = i; u.e = 0; u.nvalid = 256; u.slot0 = 0; return true;
    }
    static constexpr int RB_ = F8 ? KDIM : KDIM * 2;
    __device__ __forceinline__ const char* a_base(const Unit& u) const { return (const char*)A + (size_t)u.pm * BM * RB_; }
    __device__ __forceinline__ const char* b_base(const Unit& u) const { return (const char*)Bt + (size_t)u.pn * BM * RB_; }
    static constexpr bool GATHER = false, FP8 = F8; static constexpr int SCALE_A = H8_E8, SCALE_B = W1_E8;
    __device__ __forceinline__ void a_voff(const Unit&, int tid, unsigned (&v)[2][2]) const { int R0, CB; stage_rcb<F8>(tid * 16, R0, CB); v[0][0] = (unsigned)(R0 * RB_ + CB); }
    __device__ __forceinline__ void a_tok(const Unit&, int, unsigned (&)[2]) const {}
};

constexpr int MOE_IDX = STAGE_BYTES;
constexpr int MOE_MAXU = 40;
constexpr int MOE_TAB = MOE_IDX + MOE_MAXU * 512;
constexpr int TB_XN = 130, TB_XE = 138, TB_XUP = 394;
constexpr int MOE_UT = MOE_TAB + 2688;
template <int WHICH>
struct MoeProb {
    const unsigned char* A; const unsigned char* Wt; LAS unsigned char* lds; int nunits, G, c, xy; int same;
    static constexpr int nN = (WHICH == 1) ? 8 : 4;
    static constexpr bool FP8 = true; static constexpr int SCALE_A = (WHICH == 1) ? H8_E8 : ACT8_E8, SCALE_B = (WHICH == 1) ? W1_E8 : W2_E8;
    __device__ __forceinline__ void fill_units(int tid) const {
        if (tid < MOE_MAXU) { const LAS int* tab = (const LAS int*)(lds + MOE_TAB); int L = tid * G + c;
            if (xy >= 0) { const int x = xy & 7, y = xy >> 3, q = nunits >> 3, rr = nunits & 7, len = q + (x < rr ? 1 : 0), li = tid * (G >> 3) + y; L = (li < len) ? x * q + min(x, rr) + li : nunits; }
            i32x4 r = {-1, 0, 0, 0};
            if (L < nunits) { const int tt = L / nN, pn = L % nN; int e = 0;
                for (int q = 1; q < 32; ++q) e = (tab[32 + q] <= tt) ? q : e;
                const int tl = tt - tab[32 + e], cnt = tab[e];
                r = (i32x4){e | (pn << 8), tl, min(cnt - tl * 256, 256), tab[96 + e] + tl * 256}; }
            ((LAS i32x4*)(lds + MOE_UT))[tid] = r; }
    }
    __device__ __forceinline__ bool next(int i, Unit& u) const {
        if (i >= MOE_MAXU) return false;
        const i32x4 r = ((const LAS i32x4*)(lds + MOE_UT))[i];
        const int w0 = __builtin_amdgcn_readfirstlane(r.x); if (w0 < 0) return false;
        u.e = w0 & 255; u.pn = w0 >> 8; u.ui = i; u.pm = __builtin_amdgcn_readfirstlane(r.y); u.nvalid = __builtin_amdgcn_readfirstlane(r.z); u.slot0 = (unsigned)__builtin_amdgcn_readfirstlane(r.w); return true;
    }
    __device__ __forceinline__ const char* a_base(const Unit& u) const { return (WHICH == 1) ? (const char*)A : (const char*)A + (size_t)u.slot0 * KDIM; }
    __device__ __forceinline__ const char* b_base(const Unit& u) const { return same ? (const char*)Wt : (const char*)Wt + ((size_t)u.e * (nN * 256) + (size_t)u.pn * 256) * KDIM; }
    static constexpr bool GATHER = (WHICH == 1);
    __device__ __forceinline__ void a_voff(const Unit& u, int tid, unsigned (&v)[2][2]) const {
        int R0, CB; stage_rcb<true>(tid * 16, R0, CB);
        if (WHICH == 1) { const LAS unsigned short* idx = (const LAS unsigned short*)(lds + MOE_IDX) + u.ui * 256;
#pragma unroll
            for (int h = 0; h < 2; ++h)
#pragma unroll
                for (int i = 0; i < 2; ++i) v[h][i] = (unsigned)(idx[h * HALF + i * 64 + R0] * KDIM + CB);
        } else v[0][0] = (unsigned)(R0 * KDIM + CB);
    }
    __device__ __forceinline__ void a_tok(const Unit& u, int tid, unsigned (&v)[2]) const {
        if (WHICH == 1) { int R0, CB; stage_rcb<true>(tid * 16, R0, CB); const LAS unsigned short* idx = (const LAS unsigned short*)(lds + MOE_IDX) + u.ui * 256;
            v[0] = (unsigned)idx[R0] | ((unsigned)idx[64 + R0] << 16); v[1] = (unsigned)idx[HALF + R0] | ((unsigned)idx[HALF + 64 + R0] << 16); }
    }
};

struct EpiP {
    static constexpr bool PERM = true;
    bf16* out; int ncols; bf16* vt;
    __device__ __forceinline__ void operator()(const f32x4 (&acc)[2][2][4][2], const Unit& u, int wr, int wc, int fr, int fq) const {
        if (vt != nullptr && ncols == GLA_IN && u.pn >= 4 && u.pn < 8) {
            const int row0 = u.pm * BM;
#pragma unroll
            for (int bj = 0; bj < 2; ++bj) { const int e0 = u.pn * BM + bj * HALF + wc * 32 + 8 * fq - 1024;
#pragma unroll
                for (int ai = 0; ai < 2; ++ai)
#pragma unroll
                    for (int m = 0; m < 4; ++m) { const int rl = ai * HALF + wr * 64 + m * 16 + fr; const int c = (row0 + rl) >> 6, i = rl & 63;
                        bf16* p = vt + ((size_t)c * 1024 + e0) * 72 + i;
#pragma unroll
                        for (int n = 0; n < 2; ++n) { const unsigned w0 = pk2(acc[ai][bj][m][n][0], acc[ai][bj][m][n][1]), w1 = pk2(acc[ai][bj][m][n][2], acc[ai][bj][m][n][3]);
                            p[(4 * n + 0) * 72] = (bf16)(w0 & 0xffffu); p[(4 * n + 1) * 72] = (bf16)(w0 >> 16); p[(4 * n + 2) * 72] = (bf16)(w1 & 0xffffu); p[(4 * n + 3) * 72] = (bf16)(w1 >> 16); } } }
            return;
        }
        if (vt != nullptr && ncols == AB_IN && u.pn >= 7) {
            const int row0 = u.pm * BM;
            bf16* base; int tl, tok0;
            if (row0 < ML) { base = vt + (size_t)(row0 >> 12) * 12 * 64 * T; tl = T; tok0 = row0 & (T - 1); }
            else { base = vt + (size_t)(WS_VTC - WS_VT) / 2 + (size_t)((row0 - ML) >> 8) * 12 * 64 * NCTX; tl = NCTX; tok0 = 0; }
#pragma unroll
            for (int bj = 0; bj < 2; ++bj) { const int c = u.pn * BM + bj * HALF + wc * 32 + 8 * fq - 1792;
                bf16* cb = base + (size_t)c * tl + tok0 + wr * 64 + fr;
#pragma unroll
                for (int ai = 0; ai < 2; ++ai)
#pragma unroll
                    for (int m = 0; m < 4; ++m) { bf16* p = cb + ai * HALF + m * 16;
#pragma unroll
                        for (int n = 0; n < 2; ++n) { const unsigned w0 = pk2(acc[ai][bj][m][n][0], acc[ai][bj][m][n][1]), w1 = pk2(acc[ai][bj][m][n][2], acc[ai][bj][m][n][3]);
                            p[(size_t)(4 * n + 0) * tl] = (bf16)(w0 & 0xffffu); p[(size_t)(4 * n + 1) * tl] = (bf16)(w0 >> 16); p[(size_t)(4 * n + 2) * tl] = (bf16)(w1 & 0xffffu); p[(size_t)(4 * n + 3) * tl] = (bf16)(w1 >> 16); } } }
            return;
        }
#pragma unroll
        for (int ai = 0; ai < 2; ++ai)
#pragma unroll
            for (int m = 0; m < 4; ++m) { const size_t row = (size_t)u.pm * BM + ai * HALF + wr * 64 + m * 16 + fr;
#pragma unroll
                for (int bj = 0; bj < 2; ++bj) { const int col = u.pn * BM + bj * HALF + wc * 32 + 8 * fq;
                    if (col < ncols) { const f32x4 v0 = acc[ai][bj][m][0], v1 = acc[ai][bj][m][1];
                        u32x4 w; w.x = pk2(v0[0], v0[1]); w.y = pk2(v0[2], v0[3]); w.z = pk2(v1[0], v1[1]); w.w = pk2(v1[2], v1[3]);
                        *(u32x4*)(out + row * ncols + col) = w; } } }
    }
};
struct EpiResid {
    static constexpr bool PERM = false;
    float* X; const float* gate_base;
    __device__ __forceinline__ void operator()(const f32x4 (&acc)[2][2][4][2], const Unit& u, int wr, int wc, int fr, int fq) const {
#pragma unroll
        for (int ai = 0; ai < 2; ++ai)
#pragma unroll
            for (int m = 0; m < 4; ++m) { const size_t row = (size_t)u.pm * BM + ai * HALF + wr * 64 + m * 16 + fr; const int mb = (row < (size_t)ML) ? (int)(row >> 12) : 8;
#pragma unroll
                for (int bj = 0; bj < 2; ++bj)
#pragma unroll
                    for (int n = 0; n < 2; ++n) { const int col = u.pn * BM + bj * HALF + wc * 32 + n * 16 + 4 * fq;
                        const f32x4 g = *(const f32x4*)(gate_base + (size_t)mb * 6144 + col); float* xp = X + row * D + col; const f32x4 x = *(const f32x4*)xp;
                        *(f32x4*)xp = x * DN_ALPHA + g * acc[ai][bj][m][n]; } }
    }
};
struct EpiSwiglu {
    static constexpr bool PERM = true;
    unsigned char* act; const float* b1_base; int dbg;
    __device__ __forceinline__ void operator()(const f32x4 (&acc)[2][2][4][2], const Unit& u, int wr, int wc, int fr, int fq) const {
        if (dbg & 2) return;
        const float* b1 = b1_base + (size_t)u.e * 2048; const int gcol = u.pn * HALF + wc * 32 + 8 * fq;
        f32x4 bg[2], bl[2];
#pragma unroll
        for (int n = 0; n < 2; ++n) { if (dbg & 8) { bg[n] = (f32x4){0.f, 0.f, 0.f, 0.f}; bl[n] = bg[n]; } else { bg[n] = *(const f32x4*)(b1 + gcol + 4 * n); bl[n] = *(const f32x4*)(b1 + 1024 + gcol + 4 * n); } }
        __builtin_amdgcn_s_waitcnt(0x0F70);
#pragma unroll
        for (int ai = 0; ai < 2; ++ai)
#pragma unroll
            for (int m = 0; m < 4; ++m) { const int rl = ai * HALF + wr * 64 + m * 16 + fr;
                if (rl < u.nvalid) { float o[8];
#pragma unroll
                    for (int n = 0; n < 2; ++n)
#pragma unroll
                        for (int jp = 0; jp < 2; ++jp) {
                            f32x2 g = (f32x2){acc[ai][0][m][n][2 * jp], acc[ai][0][m][n][2 * jp + 1]} + (f32x2){bg[n][2 * jp], bg[n][2 * jp + 1]};
                            f32x2 l = (f32x2){acc[ai][1][m][n][2 * jp], acc[ai][1][m][n][2 * jp + 1]} + (f32x2){bl[n][2 * jp], bl[n][2 * jp + 1]};
                            if (dbg & 1) { o[4 * n + 2 * jp] = g.x + l.x; o[4 * n + 2 * jp + 1] = g.y + l.y; } else {
                                g.x = fminf(g.x, 7.0f); g.y = fminf(g.y, 7.0f); l.x = fminf(fmaxf(l.x, -7.0f), 7.0f); l.y = fminf(fmaxf(l.y, -7.0f), 7.0f);
                                const f32x2 t = g * (f32x2){-1.702f * 1.44269504f, -1.702f * 1.44269504f};
                                const f32x2 a = (f32x2){__builtin_amdgcn_exp2f(t.x), __builtin_amdgcn_exp2f(t.y)} + (f32x2){1.f, 1.f};
                                const f32x2 sg = g * (f32x2){__builtin_amdgcn_rcpf(a.x), __builtin_amdgcn_rcpf(a.y)};
                                const f32x2 ov = sg * (l * (f32x2){ACT8_SCALE, ACT8_SCALE} + (f32x2){ACT8_SCALE, ACT8_SCALE});
                                o[4 * n + 2 * jp] = ov.x; o[4 * n + 2 * jp + 1] = ov.y; } }
                    u32x2 w; w.x = pk4_fp8_nc(o[0], o[1], o[2], o[3]); w.y = pk4_fp8_nc(o[4], o[5], o[6], o[7]);
                    if (!(dbg & 4) || w.x == 0x12345u) *(u32x2*)(act + ((size_t)u.slot0 + rl) * 1024 + gcol) = w; }
                __builtin_amdgcn_sched_barrier(0); }
    }
};
struct EpiYs {
    static constexpr bool PERM = true;
    bf16* ys; const float* b2_base;
    __device__ __forceinline__ void operator()(const f32x4 (&acc)[2][2][4][2], const Unit& u, int wr, int wc, int fr, int fq) const {
        const float* b2 = b2_base + (size_t)u.e * 1024;
        f32x4 bb[2][2];
#pragma unroll
        for (int bj = 0; bj < 2; ++bj)
#pragma unroll
            for (int n = 0; n < 2; ++n) bb[bj][n] = *(const f32x4*)(b2 + u.pn * BM + bj * HALF + wc * 32 + 8 * fq + 4 * n);
        __builtin_amdgcn_s_waitcnt(0x0F70);
#pragma unroll
        for (int ai = 0; ai < 2; ++ai)
#pragma unroll
            for (int m = 0; m < 4; ++m) { const int rl = ai * HALF + wr * 64 + m * 16 + fr;
                if (rl < u.nvalid) {
#pragma unroll
                    for (int bj = 0; bj < 2; ++bj) { const int col = u.pn * BM + bj * HALF + wc * 32 + 8 * fq;
                        const f32x4 v0 = acc[ai][bj][m][0] + bb[bj][0], v1 = acc[ai][bj][m][1] + bb[bj][1];
                        u32x4 w; w.x = pk2(v0[0], v0[1]); w.y = pk2(v0[2], v0[3]); w.z = pk2(v1[0], v1[1]); w.w = pk2(v1[2], v1[3]);
                        *(u32x4*)(ys + ((size_t)u.slot0 + rl) * 1024 + col) = w; } } }
    }
};
}

template <int KIND>
__device__ __forceinline__ void phase_gemm_dense(const Params& P, LAS unsigned char* lds, int tid, int bid, int nb, const void* A, const void* Wt, int Mrows, int N, int layer) {
    unsigned char* ws = P.ws;
    if (KIND == 0) { g8::DenseProb<true> S; S.init(A, Wt, Mrows, (N + 255) & ~255, nb, bid);
        g8::EpiP e{(bf16*)(ws + WS_P), N, (N == AB_IN) ? (bf16*)(ws + WS_VT) : (bf16*)(ws + WS_GVT)}; g8::gemm_phase(lds, S, e, tid); }
    else { g8::DenseProb<false> S; S.init(A, Wt, Mrows, (N + 255) & ~255, nb, bid);
        g8::EpiP e{(bf16*)(ws + WS_P), 1024, (bf16*)nullptr}; g8::gemm_phase(lds, S, e, tid); }
}

template <int NN>
__device__ __forceinline__ void moe_tables(const Params& P, LAS unsigned char* lds, int tid, int layer) {
    LAS int* tab = (LAS int*)(lds + g8::MOE_TAB);
    __syncthreads();
    if (tid < 32) tab[tid] = (int)__hip_atomic_load((const unsigned*)(P.ws + WS_CTL) + CW_CNT + layer * 32 + tid, __ATOMIC_RELAXED, __HIP_MEMORY_SCOPE_AGENT);
    __syncthreads();
    if (tid == 0) { int tp = 0, rb = 0;
        for (int e = 0; e < 32; ++e) { const int c = tab[e]; tab[32 + e] = tp; tab[96 + e] = rb; tp += (c + 255) >> 8; rb += c; }
        tab[32 + 32] = tp; tab[96 + 32] = rb;
        if (NN > 0) {
            int load[8]; unsigned taken = 0u;
            for (int x = 0; x < 8; ++x) { load[x] = 0; tab[g8::TB_XN + x] = 0; tab[g8::TB_XUP + x * 33] = 0; }
            for (int it = 0; it < 32; ++it) { int be = -1, bt = -1;
                for (int e = 0; e < 32; ++e) { const int t = (tab[e] + 255) >> 8; if (!((taken >> e) & 1u) && t > bt) { bt = t; be = e; } }
                taken |= 1u << be;
                int bx = 0; for (int x = 1; x < 8; ++x) if (load[x] < load[bx]) bx = x;
                const int n = tab[g8::TB_XN + bx]; tab[g8::TB_XE + bx * 32 + n] = be; tab[g8::TB_XUP + bx * 33 + n + 1] = tab[g8::TB_XUP + bx * 33 + n] + bt * NN; tab[g8::TB_XN + bx] = n + 1; load[bx] += bt; } } }
    __syncthreads();
}
template <int WHICH>
__device__ __forceinline__ void phase_moe_gemm(const Params& P, LAS unsigned char* lds, int tid, int bid, int nb, int layer, int dbg = 0) {
    unsigned char* ws = P.ws;
    moe_tables<0>(P, lds, tid, layer);
    const LAS int* tab = (const LAS int*)(lds + g8::MOE_TAB);
    g8::MoeProb<WHICH> S; S.lds = lds; S.G = nb; S.c = bid; S.xy = ((nb & 7) == 0) ? bid : -1;        S.same = (dbg & 16) ? 1 : 0; S.nunits = __builtin_amdgcn_readfirstlane(tab[64]) * g8::MoeProb<WHICH>::nN;
    S.fill_units(tid); __syncthreads();
    if (WHICH == 1) {
        S.A = (const unsigned char*)(ws + WS_H8); S.Wt = (const unsigned char*)(ws + WS_W1T) + (size_t)layer * 32 * 2048 * 1024;
        const int* list = (const int*)(ws + WS_LIST); LAS unsigned short* idx = (LAS unsigned short*)(lds + g8::MOE_IDX);
        { const LAS g8::i32x4* ut = (const LAS g8::i32x4*)(lds + g8::MOE_UT);
#pragma unroll 4
          for (int ent = tid; ent < g8::MOE_MAXU * 256; ent += NTHREADS) { const int i = ent >> 8, r = ent & 255; const g8::i32x4 q = ut[i];
              if (q.x >= 0) idx[ent] = (unsigned short)((r < q.z) ? list[(size_t)(q.x & 255) * M + q.y * 256 + r] : 0); } }
        __syncthreads();
        g8::EpiSwiglu e{(unsigned char*)(ws + WS_ACT), P.in[21] + (size_t)layer * 32 * 2048, dbg};
        g8::gemm_phase(lds, S, e, tid);
    } else {
        S.A = (const unsigned char*)(ws + WS_ACT); S.Wt = (const unsigned char*)(ws + WS_W2T) + (size_t)layer * 32 * 1024 * 1024;
        g8::EpiYs e{(bf16*)(ws + WS_YS), P.in[23] + (size_t)layer * 32 * 1024};
        g8::gemm_phase(lds, S, e, tid);
    }
}

constexpr int NA_RPB_OFF = 102400;
constexpr int NA_KC_OFF = 0, NA_VC_OFF = 32768, NA_VC_PITCH = 544, NA_KW_OFF = 67584, NA_KW_PITCH = 144, NA_KW_ROW = 64 * 144, NA_RPB2 = NA_KW_OFF + 9 * NA_KW_ROW;
template <bool ISCTX, bool CTXLDS>
__device__ __forceinline__ void na_wave_unit(const Params& P, LAS unsigned char* lds, int v, int lane) {
    const bf16* PB = (const bf16*)(P.ws + WS_P);
    bf16* A2 = (bf16*)(P.ws + WS_A2);
    const int fr = lane & 15, fq = lane >> 4;
    int b, h, r = 0, jb = 0; size_t mq0;
    if (!ISCTX) { jb = v & 3; r = (v >> 2) & 63; h = (v >> 8) % 12; b = v / (256 * 12); mq0 = (size_t)b * T + r * 64 + jb * 16; }
    else { const int qb = v & 15; h = (v >> 4) % 12; b = v / (16 * 12); mq0 = (size_t)ML + b * NCTX + qb * 16; }
    const int row_start = min(max(r - 4, 0), 56);
    const int band_start = min(max(jb * 16 - 8, 0), 32);
    const int kap = 8 * (fr >> 2) + (fr & 3);
    const bf16* kwin = PB + ((size_t)b * T + (size_t)row_start * 64 + band_start + kap) * AB_IN + 1024 + h * 64 + fq * 8;
    const bf16* kctx = PB + ((size_t)ML + (size_t)b * NCTX + kap) * AB_IN + 1024 + h * 64 + fq * 8;
    const bf16* vtl = (const bf16*)(P.ws + WS_VT) + ((size_t)(b * 12 + h) * 64 + fr) * T + (size_t)row_start * 64 + band_start + 8 * fq;
    const bf16* vtc = (const bf16*)(P.ws + WS_VTC) + ((size_t)(b * 12 + h) * 64 + fr) * NCTX + 8 * fq;
    const bf16* qp = PB + (mq0 + fr) * AB_IN + 256 + h * 64 + fq * 8;
    const bf16x8 qf0 = *(const bf16x8*)qp, qf1 = *(const bf16x8*)(qp + 32);
    const f32x4 zero4 = {0.f, 0.f, 0.f, 0.f};
    const LAS float* rpb = CTXLDS ? (const LAS float*)(lds + NA_RPB2) : (const LAS float*)(lds + NA_RPB_OFF) + h * 15 * 31;
    const int qcol = jb * 16 + fr, wstart = min(max(qcol - 8, 0), 48);
    constexpr int C0 = ISCTX ? 4 : 0;
    bf16x8 kf[4][2], vf[2][4];
#define NA_LOAD_KV(c) do { _Pragma("unroll") for (int s_ = 0; s_ < 2; ++s_) { _Pragma("unroll") for (int hh = 0; hh < 2; ++hh) { \
        if (CTXLDS && (c) >= 4) { const int key_ = (2 * ((c) - 4) + s_) * 32 + 4 * hh + kap; const LAS unsigned char* kl_ = lds + NA_KC_OFF + key_ * 128; \
            kf[2 * s_ + hh][0] = *(const LAS bf16x8*)(kl_ + ((fq ^ (key_ & 7)) << 4)); kf[2 * s_ + hh][1] = *(const LAS bf16x8*)(kl_ + (((4 + fq) ^ (key_ & 7)) << 4)); } \
        else if (CTXLDS) { const LAS unsigned char* kl_ = lds + NA_KW_OFF + ((row_start + 2 * (c) + s_) % 9) * NA_KW_ROW + (band_start + 4 * hh + kap) * NA_KW_PITCH + fq * 16; \
            kf[2 * s_ + hh][0] = *(const LAS bf16x8*)kl_; kf[2 * s_ + hh][1] = *(const LAS bf16x8*)(kl_ + 64); } \
        else { const bf16* kp_ = ((c) < 4) ? kwin + (size_t)((2 * (c) + s_) * 64 + 4 * hh) * AB_IN : kctx + (size_t)((2 * ((c) - 4) + s_) * 32 + 4 * hh) * AB_IN; \
            kf[2 * s_ + hh][0] = *(const bf16x8*)kp_; kf[2 * s_ + hh][1] = *(const bf16x8*)(kp_ + 32); } } \
        _Pragma("unroll") for (int dt = 0; dt < 4; ++dt) { \
            if (CTXLDS && (c) >= 4) vf[s_][dt] = *(const LAS bf16x8*)(lds + NA_VC_OFF + (dt * 16 + fr) * NA_VC_PITCH + ((2 * ((c) - 4) + s_) * 32 + 8 * fq) * 2); \
            else vf[s_][dt] = ((c) < 4) ? *(const bf16x8*)(vtl + (size_t)(dt * 16) * T + (2 * (c) + s_) * 64) : *(const bf16x8*)(vtc + (size_t)(dt * 16) * NCTX + (2 * ((c) - 4) + s_) * 32); } } } while (0)
    float mrun = -3.0e38f, lrun = 0.f;
    f32x4 o[4];
#pragma unroll
    for (int dt = 0; dt < 4; ++dt) o[dt] = zero4;
#pragma unroll
    for (int c = C0; c < 8; ++c) {
        NA_LOAD_KV(c);
        f32x4 s[4];
#pragma unroll
        for (int t = 0; t < 4; ++t) { f32x4 a = mfma16(kf[t][0], qf0, zero4); s[t] = mfma16(kf[t][1], qf1, a); }
        float mx = mrun;
        if (c < 4) {
#pragma unroll
            for (int t = 0; t < 4; ++t) { const int kr = 2 * c + (t >> 1), hh = t & 1; const int drow = row_start + kr - r + 7;
#pragma unroll
                for (int i = 0; i < 4; ++i) { const int kcol = band_start + 8 * fq + 4 * hh + i; const bool ok = (kcol >= wstart) && (kcol < wstart + 16);
                    const int dcol = min(max(kcol - qcol + 15, 0), 30);
                    const float lg = ok ? (s[t][i] * (0.125f * 1.44269504f) + rpb[drow * 31 + dcol]) : -1.0e30f; s[t][i] = lg; mx = fmaxf(mx, lg); } }
        } else {
#pragma unroll
            for (int t = 0; t < 4; ++t)
#pragma unroll
                for (int i = 0; i < 4; ++i) { const float lg = s[t][i] * (0.125f * 1.44269504f); s[t][i] = lg; mx = fmaxf(mx, lg); }
        }
        mx = xmax_16_32(mx);
        const float corr = __builtin_amdgcn_exp2f(mrun - mx); mrun = mx;
        float sum = 0.f;
#pragma unroll
        for (int t = 0; t < 4; ++t)
#pragma unroll
            for (int i = 0; i < 4; ++i) { const float p = __builtin_amdgcn_exp2f(s[t][i] - mx); s[t][i] = p; sum += p; }
        sum = xsum_16_32(sum);
        lrun = lrun * corr + sum;
#pragma unroll
        for (int dt = 0; dt < 4; ++dt) o[dt] = o[dt] * corr;
#pragma unroll
        for (int s_ = 0; s_ < 2; ++s_) { const int ta = 2 * s_, tb = 2 * s_ + 1;
            const bf16x8 pf = mk_frag(pk2(s[ta][0], s[ta][1]), pk2(s[ta][2], s[ta][3]), pk2(s[tb][0], s[tb][1]), pk2(s[tb][2], s[tb][3]));
#pragma unroll
            for (int dt = 0; dt < 4; ++dt) o[dt] = mfma16(vf[s_][dt], pf, o[dt]); }
    }
#undef NA_LOAD_KV
    const float inv = 1.0f / lrun;
#pragma unroll
    for (int dt = 0; dt < 4; ++dt) { u32x2 w; w.x = pk2(o[dt].x * inv, o[dt].y * inv); w.y = pk2(o[dt].z * inv, o[dt].w * inv);
        *(u32x2*)(A2 + (mq0 + fr) * D + 256 + h * 64 + dt * 16 + 4 * fq) = w; }
}

__device__ __forceinline__ void pool_units(const Params& P, LAS unsigned char* lds, int j_even, int tid, int bid, int nb) {
    const bf16* PB = (const bf16*)(P.ws + WS_P);
    bf16* A2 = (bf16*)(P.ws + WS_A2);
    const int lane = tid & 63, wave = tid >> 6, fr = lane & 15, fq = lane >> 4;
    LAS bf16* pwT = (LAS bf16*)lds;
    LAS bf16* pooled = (LAS bf16*)(lds + 36864);
    LAS bf16* U = (LAS bf16*)(lds + 128000);
    for (int idx = tid; idx < 4 * 64 * 64; idx += NTHREADS) { const int g = idx >> 12, d = (idx >> 6) & 63, e = idx & 63;
        pwT[(g * 64 + e) * 72 + d] = (bf16)f2bf(P.in[9][(size_t)j_even * 4 * 64 * 64 + idx]); }
    for (int u = bid; u < 1088; u += nb) {
        size_t seq0; int t0, TL;
        if (u < 1024) { const int b = u >> 7; t0 = (u & 127) * 32; seq0 = (size_t)b * T; TL = T; }
        else { const int q = u - 1024; const int b = q >> 3; t0 = (q & 7) * 32; seq0 = (size_t)ML + (size_t)b * NCTX; TL = NCTX; }
        __syncthreads();
        for (int c = tid; c < 48 * 32; c += NTHREADS) { const int rr = c >> 5, ck = c & 31; const int t = t0 - 8 + rr;
            if (t >= 0 && t < TL) *(LAS u32x4*)(U + rr * 256 + ck * 8) = *(const u32x4*)(PB + (seq0 + t) * AB_IN + ck * 8); }
        __syncthreads();
        for (int idx = tid; idx < 32 * 256; idx += NTHREADS) { const int ti = idx >> 8, ch = idx & 255, g = ch >> 6, w = 2 << g; const int t = t0 + ti;
            const int lo = max(t - w / 2, 0), hi = min(t - w / 2 + w, TL);
            float sum = 0.f;
            for (int sx = lo; sx < hi; ++sx) sum += bf2f(U[(sx - t0 + 8) * 256 + ch]);
            pooled[ti * 272 + ch] = (bf16)f2bf(sum / (float)(hi - lo) - bf2f(U[(ti + 8) * 256 + ch])); }
        __syncthreads();
        { const int g = wave >> 1, tt = wave & 1;
          const size_t mrow = seq0 + t0 + tt * 16 + fr;
#pragma unroll
          for (int et = 0; et < 4; ++et) { f32x4 a = {0.f, 0.f, 0.f, 0.f};
#pragma unroll
              for (int ks = 0; ks < 2; ++ks) { const bf16x8 wf = *(const LAS bf16x8*)(pwT + (g * 64 + et * 16 + fr) * 72 + ks * 32 + fq * 8); const bf16x8 pf = *(const LAS bf16x8*)(pooled + (tt * 16 + fr) * 272 + g * 64 + ks * 32 + fq * 8);
                  a = mfma16(wf, pf, a); }
              const int col = g * 64 + et * 16 + 4 * fq; const f32x4 sc = *(const f32x4*)(P.in[10] + j_even * 256 + col);
              u32x2 w; w.x = pk2(a.x * sc.x, a.y * sc.y); w.y = pk2(a.z * sc.z, a.w * sc.w); *(u32x2*)(A2 + mrow * D + col) = w; } }
    }
    __syncthreads();
}

__device__ __forceinline__ void phase_even_mixer(const Params& P, LAS unsigned char* lds, int j_even, int tid, int bid, int nb) {
    const int lane = tid & 63, wave = tid >> 6;
    if (nb != 256) for (int idx = tid; idx < 12 * 15 * 31; idx += NTHREADS) ((LAS float*)(lds + NA_RPB_OFF))[idx] = P.in[11][(size_t)j_even * 12 * 15 * 31 + idx] * 1.44269504f;
    pool_units(P, lds, j_even, tid, bid, nb);
    const int gw = bid * NWAVES + wave, NGW = nb * NWAVES;
    if (nb == 256) {
        const bf16* PB = (const bf16*)(P.ws + WS_P);
        int bh_cur = -1, res_hi = 0;
        u32x4 pre[2]; int pre_lo = 0, pre_n = 0;
        const int it_end = bid * 12 + 12;
        for (int it = bid * 12; it < it_end; ++it) { const int bh = it >> 5, b = bh / 12, h = bh % 12;
            const int r0 = (it & 31) * 2, lo_need = min(max(r0 - 4, 0), 56), hi_need = min(max(r0 + 1 - 4, 0), 56) + 7;
            const int key = tid >> 3, c8 = tid & 7;
            __syncthreads();
            if (bh != bh_cur) { bh_cur = bh; res_hi = lo_need; pre_n = 0;
                for (int ch = tid; ch < 256 * 8; ch += NTHREADS) { const int kk = ch >> 3, cc = ch & 7;
                    *(LAS u32x4*)(lds + NA_KC_OFF + kk * 128 + ((cc ^ (kk & 7)) << 4)) = *(const u32x4*)(PB + ((size_t)ML + (size_t)b * NCTX + kk) * AB_IN + 1024 + h * 64 + cc * 8); }
                const bf16* vtc = (const bf16*)(P.ws + WS_VTC) + (size_t)(b * 12 + h) * 64 * NCTX;
                for (int ch = tid; ch < 64 * 32; ch += NTHREADS) { const int dh = ch >> 5, cc = ch & 31;
                    *(LAS u32x4*)(lds + NA_VC_OFF + dh * NA_VC_PITCH + cc * 16) = *(const u32x4*)(vtc + (size_t)dh * NCTX + cc * 8); }
                for (int idx = tid; idx < 15 * 31; idx += NTHREADS) ((LAS float*)(lds + NA_RPB2))[idx] = P.in[11][((size_t)j_even * 12 + h) * 15 * 31 + idx] * 1.44269504f; }
            { const int first = max(res_hi, lo_need);
              if (pre_n > 0 && pre_lo == first && pre_lo + pre_n == hi_need + 1) {
#pragma unroll
                  for (int q = 0; q < 2; ++q) if (q < pre_n) *(LAS u32x4*)(lds + NA_KW_OFF + ((pre_lo + q) % 9) * NA_KW_ROW + key * NA_KW_PITCH + c8 * 16) = pre[q];
              } else
                  for (int R = first; R <= hi_need; ++R)
                      *(LAS u32x4*)(lds + NA_KW_OFF + (R % 9) * NA_KW_ROW + key * NA_KW_PITCH + c8 * 16) = *(const u32x4*)(PB + ((size_t)b * T + (size_t)R * 64 + key) * AB_IN + 1024 + h * 64 + c8 * 8); }
            res_hi = hi_need + 1; pre_n = 0;
            __syncthreads();
            if (it + 1 < it_end && ((it + 1) >> 5) == bh) {
                const int r1 = ((it + 1) & 31) * 2, lo1 = min(max(r1 - 4, 0), 56), hi1 = min(max(r1 + 1 - 4, 0), 56) + 7; const int f1 = max(res_hi, lo1);
                if (hi1 - f1 + 1 >= 1 && hi1 - f1 + 1 <= 2) { pre_lo = f1; pre_n = hi1 - f1 + 1;
#pragma unroll
                    for (int q = 0; q < 2; ++q) if (q < pre_n) pre[q] = *(const u32x4*)(PB + ((size_t)b * T + (size_t)(f1 + q) * 64 + key) * AB_IN + 1024 + h * 64 + c8 * 8); } }
            na_wave_unit<false, true>(P, lds, bh * 256 + (it & 31) * 8 + wave, lane); }
        __syncthreads();
    } else {
        for (int v = gw; v < 24576; v += NGW) na_wave_unit<false, false>(P, lds, v, lane);
    }
    for (int v = gw; v < 1536; v += NGW) na_wave_unit<true, false>(P, lds, v, lane);
}

constexpr int GP_G = 0;
constexpr int GP_SEG = 8192;
constexpr int GP_B = 12288;
constexpr int GP_QD = 45056;
constexpr int GP_KD = 62464;
constexpr int GP_KLT = 79872;
constexpr int GP_ATT = 98304;
constexpr int GP_VT = 107520;
__device__ __forceinline__ void phase_gla_prepass(const Params& P, LAS unsigned char* lds, int j_odd, int tid, int bid, int nb, int dbg = 0) {
    const bf16* PB = (const bf16*)(P.ws + WS_P);
    const int lane = tid & 63, wave = tid >> 6, fr = lane & 15, fq = lane >> 4;
    LAS float* G = (LAS float*)(lds + GP_G); LAS float* SEG = (LAS float*)(lds + GP_SEG); LAS float* BC = (LAS float*)(lds + GP_B);
    LAS bf16* QD = (LAS bf16*)(lds + GP_QD); LAS bf16* KD = (LAS bf16*)(lds + GP_KD); LAS bf16* KLT = (LAS bf16*)(lds + GP_KLT); LAS bf16* ATT = (LAS bf16*)(lds + GP_ATT); LAS bf16* VTs = (LAS bf16*)(lds + GP_VT);
    const float* ROPEC = (const float*)(P.ws + WS_ROPE); const float* ROPES = ROPEC + T * 64;
    const f32x4 zero4 = {0.f, 0.f, 0.f, 0.f};
    const int f = tid & 63, seg = tid >> 6;
    const int ri = tid >> 3, rg = tid & 7;
    for (int unit = bid; unit < 544 * 4; unit += nb) {
        const int c = unit >> 2, h = unit & 3;
        const bool latent = c < 512;
        const size_t m0 = latent ? (size_t)c * 64 : (size_t)ML + (size_t)(c - 512) * 64;
        const int t0 = (c & 63) * 64;
        float gv[4];
#pragma unroll
        for (int q = 0; q < 4; ++q) { const int idx = tid + NTHREADS * q; gv[q] = bf2f(PB[(m0 + (idx >> 5)) * GLA_IN + 3072 + (idx & 31)]); }
        const bf16* rowp = PB + (m0 + ri) * GLA_IN + h * 128 + rg * 8;
        const u32x4 q1r = *(const u32x4*)rowp, q2r = *(const u32x4*)(rowp + 64), k1r = *(const u32x4*)(rowp + 512), k2r = *(const u32x4*)(rowp + 576);
        f32x4 cs4[4];
        if (latent) { const float* cp = ROPEC + (size_t)(t0 + ri) * 64 + rg * 8; const float* sp = ROPES + (size_t)(t0 + ri) * 64 + rg * 8;
            cs4[0] = *(const f32x4*)cp; cs4[1] = *(const f32x4*)(cp + 4); cs4[2] = *(const f32x4*)sp; cs4[3] = *(const f32x4*)(sp + 4); }
        else { cs4[0] = cs4[1] = (f32x4){1.f, 1.f, 1.f, 1.f}; cs4[2] = cs4[3] = zero4; }
        __syncthreads();
#pragma unroll
        for (int q = 0; q < 4; ++q) G[tid + NTHREADS * q] = gv[q];
        float qa[8], qb[8], ka[8], kb[8];
        { const unsigned qw1[4] = {q1r.x, q1r.y, q1r.z, q1r.w}, qw2[4] = {q2r.x, q2r.y, q2r.z, q2r.w}, kw1[4] = {k1r.x, k1r.y, k1r.z, k1r.w}, kw2[4] = {k2r.x, k2r.y, k2r.z, k2r.w};
#pragma unroll
          for (int e = 0; e < 8; ++e) { const int sh = (e & 1) * 16;
              const float x1 = bf2f((qw1[e >> 1] >> sh) & 0xffffu), x2 = bf2f((qw2[e >> 1] >> sh) & 0xffffu), y1 = bf2f((kw1[e >> 1] >> sh) & 0xffffu), y2 = bf2f((kw2[e >> 1] >> sh) & 0xffffu);
              const float cn = cs4[e >> 2][e & 3], sn = cs4[2 + (e >> 2)][e & 3];
              qa[e] = (x1 * cn - x2 * sn) * 0.08838834764831845f; qb[e] = (x1 * sn + x2 * cn) * 0.08838834764831845f; ka[e] = y1 * cn - y2 * sn; kb[e] = y1 * sn + y2 * cn; } }
        __syncthreads();
#pragma unroll 1
        for (int z = 0; z < 2; ++z) {
            const size_t u = ((size_t)c * 4 + h) * 2 + z;
            float bb1[8], bb2[8];
            { float wg1[16], wg2[16];
#pragma unroll
              for (int rr = 0; rr < 16; ++rr) { const float* wp = P.in[14] + ((size_t)(j_odd * 2 + z) * 16 + rr) * 512 + h * 128 + f; wg1[rr] = wp[0]; wg2[rr] = wp[64]; }
              const float bg1 = P.in[15][(size_t)(j_odd * 2 + z) * 512 + h * 128 + f], bg2 = P.in[15][(size_t)(j_odd * 2 + z) * 512 + h * 128 + 64 + f];
              float run1 = 0.f, run2 = 0.f;
#pragma unroll
              for (int ii = 0; ii < 8; ++ii) { const int ip = seg * 8 + ii, i = z ? 63 - ip : ip; float x1 = bg1, x2 = bg2;
                  if (!(dbg & 2))
#pragma unroll
                  for (int r4 = 0; r4 < 4; ++r4) { const f32x4 g4 = *(const LAS f32x4*)(G + i * 32 + z * 16 + r4 * 4);
                      x1 += g4.x * wg1[4 * r4] + g4.y * wg1[4 * r4 + 1] + g4.z * wg1[4 * r4 + 2] + g4.w * wg1[4 * r4 + 3];
                      x2 += g4.x * wg2[4 * r4] + g4.y * wg2[4 * r4 + 1] + g4.z * wg2[4 * r4 + 2] + g4.w * wg2[4 * r4 + 3]; }
                  run1 += (fminf(x1, 0.f) - __logf(1.0f + __expf(-fabsf(x1)))) * (1.0f / 16.0f); run2 += (fminf(x2, 0.f) - __logf(1.0f + __expf(-fabsf(x2)))) * (1.0f / 16.0f);
                  bb1[ii] = run1; bb2[ii] = run2; }
              SEG[seg * 128 + f] = run1; SEG[seg * 128 + 64 + f] = run2; }
            __syncthreads();
            { float off1 = 0.f, off2 = 0.f, tot1 = 0.f, tot2 = 0.f;
#pragma unroll
              for (int sg = 0; sg < 8; ++sg) { const float a1 = SEG[sg * 128 + f], a2 = SEG[sg * 128 + 64 + f]; tot1 += a1; tot2 += a2; if (sg < seg) { off1 += a1; off2 += a2; } }
              if (seg == 0) { float* dec = (float*)(P.ws + WS_GDEC) + u * 128; dec[f] = __expf(tot1); dec[64 + f] = __expf(tot2); }
#pragma unroll
              for (int ii = 0; ii < 8; ++ii) { BC[(seg * 8 + ii) * 128 + f] = bb1[ii] + off1; BC[(seg * 8 + ii) * 128 + 64 + f] = bb2[ii] + off2; } }
            __syncthreads();
            { const int ip = z ? 63 - ri : ri;
              const LAS float* bp = BC + ip * 128 + rg * 8; const LAS float* lp = BC + 63 * 128 + rg * 8;
              float ba[8], bbv[8], la[8], lb[8];
#pragma unroll
              for (int q4 = 0; q4 < 2; ++q4) { const f32x4 x = *(const LAS f32x4*)(bp + 4 * q4), y = *(const LAS f32x4*)(bp + 64 + 4 * q4), lx = *(const LAS f32x4*)(lp + 4 * q4), ly = *(const LAS f32x4*)(lp + 64 + 4 * q4);
#pragma unroll
                  for (int e = 0; e < 4; ++e) { ba[4 * q4 + e] = x[e]; bbv[4 * q4 + e] = y[e]; la[4 * q4 + e] = lx[e]; lb[4 * q4 + e] = ly[e]; } }
              float qda[8], qdb[8], kda[8], kdb[8];
#pragma unroll
              for (int e = 0; e < 8; ++e) { qda[e] = qa[e] * __expf(ba[e]); qdb[e] = qb[e] * __expf(bbv[e]); kda[e] = ka[e] * __expf(-ba[e]); kdb[e] = kb[e] * __expf(-bbv[e]);
                  KLT[(rg * 8 + e) * 72 + ip] = (bf16)f2bf(ka[e] * __expf(la[e] - ba[e])); KLT[(64 + rg * 8 + e) * 72 + ip] = (bf16)f2bf(kb[e] * __expf(lb[e] - bbv[e])); }
              u32x4 w;
              w.x = pk2(qda[0], qda[1]); w.y = pk2(qda[2], qda[3]); w.z = pk2(qda[4], qda[5]); w.w = pk2(qda[6], qda[7]); *(LAS u32x4*)(QD + ip * 136 + rg * 8) = w;
              w.x = pk2(qdb[0], qdb[1]); w.y = pk2(qdb[2], qdb[3]); w.z = pk2(qdb[4], qdb[5]); w.w = pk2(qdb[6], qdb[7]); *(LAS u32x4*)(QD + ip * 136 + 64 + rg * 8) = w;
              w.x = pk2(kda[0], kda[1]); w.y = pk2(kda[2], kda[3]); w.z = pk2(kda[4], kda[5]); w.w = pk2(kda[6], kda[7]); *(LAS u32x4*)(KD + ip * 136 + rg * 8) = w;
              w.x = pk2(kdb[0], kdb[1]); w.y = pk2(kdb[2], kdb[3]); w.z = pk2(kdb[4], kdb[5]); w.w = pk2(kdb[6], kdb[7]); *(LAS u32x4*)(KD + ip * 136 + 64 + rg * 8) = w; }
            __syncthreads();
#pragma unroll
            for (int tt = 0; tt < 2; ++tt) { const int id = wave * 2 + tt, ti = id >> 2, ts = id & 3;
                f32x4 a = zero4;
                if (ts <= ti && !(dbg & 4)) {
#pragma unroll
                    for (int kk = 0; kk < 4; ++kk) { const bf16x8 qf = *(const LAS bf16x8*)(QD + (ti * 16 + fr) * 136 + kk * 32 + fq * 8); const bf16x8 kf = *(const LAS bf16x8*)(KD + (ts * 16 + fr) * 136 + kk * 32 + fq * 8);
                        a = mfma16(kf, qf, a); }
#pragma unroll
                    for (int jx = 0; jx < 4; ++jx) if (ts * 16 + 4 * fq + jx > ti * 16 + fr) a[jx] = 0.f;
                }
                u32x2 w; w.x = pk2(a.x, a.y); w.y = pk2(a.z, a.w); *(LAS u32x2*)(ATT + (ti * 16 + fr) * 72 + ts * 16 + 4 * fq) = w; }
            __syncthreads();
            if (!(dbg & 8)) { bf16* QDG = (bf16*)(P.ws + WS_GQD) + u * 22528; bf16* KLG = QDG + 64 * 136; bf16* ATG = KLG + 128 * 72;
              for (int ch = tid; ch < 64 * 136 / 8; ch += NTHREADS) *(u32x4*)(QDG + ch * 8) = *(const LAS u32x4*)(QD + ch * 8);
              for (int ch = tid; ch < 128 * 72 / 8; ch += NTHREADS) *(u32x4*)(KLG + ch * 8) = *(const LAS u32x4*)(KLT + ch * 8);
              for (int ch = tid; ch < 64 * 72 / 8; ch += NTHREADS) *(u32x4*)(ATG + ch * 8) = *(const LAS u32x4*)(ATT + ch * 8); }
            __syncthreads();
        }
    }
}

constexpr int GS_X = 54272, GS_QD = 0, GS_KLT = 17408, GS_ATT = 35840, GS_VT = 45056, GS_ST = 2 * GS_X, GS_STB = 17408;
__device__ __forceinline__ bf16x8 rev8(bf16x8 v) {
    const u32x4 x = __builtin_bit_cast(u32x4, v); u32x4 y;
    y.x = __builtin_amdgcn_alignbit(x.w, x.w, 16); y.y = __builtin_amdgcn_alignbit(x.z, x.z, 16); y.z = __builtin_amdgcn_alignbit(x.y, x.y, 16); y.w = __builtin_amdgcn_alignbit(x.x, x.x, 16);
    return __builtin_bit_cast(bf16x8, y);
}
__device__ __forceinline__ int gla_chunk(int b, int z, int cs) { return (cs < 4) ? 512 + b * 4 + (z ? 3 - cs : cs) : b * 64 + (z ? 63 - (cs - 4) : (cs - 4)); }
struct GlaStage { u32x4 r[7]; };
__device__ __forceinline__ void gla_stage_load(const Params& P, GlaStage& R, int b, int h, int z, int dvs, int cs, int tid, int wave, int fq) {
    const int c = gla_chunk(b, z, cs); const size_t u = ((size_t)c * 4 + h) * 2 + z;
    const unsigned char* IMG = P.ws + WS_GQD + u * 45056;
    const unsigned char* VTG = P.ws + WS_GVT + ((size_t)c * 1024 + h * 256 + dvs * 64) * 144 - (size_t)2816 * 16;
#pragma unroll
    for (int q = 0; q < 5; ++q) R.r[q] = *(const u32x4*)(IMG + (tid + 512 * q) * 16);
    { const int g = tid + 2560; R.r[5] = *(const u32x4*)((g < 2816 ? IMG : VTG) + g * 16); }
    { const int g = min(tid + 3072, 3391); R.r[6] = *(const u32x4*)(VTG + g * 16); }
}
__device__ __forceinline__ f32x4 gla_dec_load(const Params& P, int b, int h, int z, int cs, int wave, int fq) {
    const int c = gla_chunk(b, z, cs); const size_t u = ((size_t)c * 4 + h) * 2 + z; return *(const f32x4*)((const float*)(P.ws + WS_GDEC) + u * 128 + wave * 16 + 4 * fq);
}
__device__ __forceinline__ void gla_stage_store(LAS unsigned char* xb, const GlaStage& R, int tid) {
#pragma unroll
    for (int q = 0; q < 7; ++q) { const int g = tid + 512 * q; if (q < 6 || g < 3392) *(LAS u32x4*)(xb + g * 16) = R.r[q]; }
}
__device__ __forceinline__ void phase_gla_scan(const Params& P, LAS unsigned char* lds, int tid, int bid, int nb) {
    const int lane = tid & 63, wave = tid >> 6, fr = lane & 15, fq = lane >> 4;
    for (int cb = bid; cb < 256; cb += nb) {
        const int xcd = cb & 7, kq = cb >> 3, g = xcd * 8 + (kq >> 2), dvs = kq & 3;
        const int b = g >> 3, h = (g >> 1) & 3, z = g & 1;
        bf16* O = (bf16*)(P.ws + (z ? WS_OB : WS_OF));
        f32x4 Sacc[4];
#pragma unroll
        for (int te = 0; te < 4; ++te) Sacc[te] = (f32x4){0.f, 0.f, 0.f, 0.f};
        GlaStage R;
        gla_stage_load(P, R, b, h, z, dvs, 0, tid, wave, fq);
        __syncthreads();
        for (int idx = tid; idx < 2 * GS_STB / 4; idx += NTHREADS) ((LAS unsigned*)(lds + GS_ST))[idx] = 0u;
        gla_stage_store(lds, R, tid);
        gla_stage_load(P, R, b, h, z, dvs, 1, tid, wave, fq);
        __syncthreads();
#pragma unroll 1
        for (int cs = 0; cs < 68; ++cs) {
            const LAS unsigned char* xb = lds + (cs & 1) * GS_X;
            const f32x4 dec_cur = gla_dec_load(P, b, h, z, cs, wave, fq);
            if (cs + 1 < 68) gla_stage_store(lds + ((cs + 1) & 1) * GS_X, R, tid);
            if (cs + 2 < 68) gla_stage_load(P, R, b, h, z, dvs, cs + 2, tid, wave, fq);
            const int c = gla_chunk(b, z, cs); const int ti = wave >> 1;
            const LAS bf16* STr = (const LAS bf16*)(lds + GS_ST + (cs & 1) * GS_STB);
            LAS bf16* STw = (LAS bf16*)(lds + GS_ST + ((cs + 1) & 1) * GS_STB);
            const LAS bf16* QDl = (const LAS bf16*)(xb + GS_QD); const LAS bf16* KLl = (const LAS bf16*)(xb + GS_KLT); const LAS bf16* ATl = (const LAS bf16*)(xb + GS_ATT); const LAS bf16* VTl = (const LAS bf16*)(xb + GS_VT);
            bf16x8 vt[4][2];
#pragma unroll
            for (int te = 0; te < 4; ++te)
#pragma unroll
                for (int kk = 0; kk < 2; ++kk) { const bf16x8 v = *(const LAS bf16x8*)(VTl + (te * 16 + fr) * 72 + (z ? (56 - kk * 32 - fq * 8) : (kk * 32 + fq * 8))); vt[te][kk] = z ? rev8(v) : v; }
            const size_t m0 = (c < 512) ? (size_t)c * 64 : (size_t)ML + (size_t)(c - 512) * 64;
            const int ip = ti * 16 + fr; const size_t mrow = m0 + (z ? 63 - ip : ip);
            bf16x8 qd[4], at[2];
#pragma unroll
            for (int kk = 0; kk < 4; ++kk) qd[kk] = *(const LAS bf16x8*)(QDl + ip * 136 + kk * 32 + fq * 8);
#pragma unroll
            for (int kk = 0; kk < 2; ++kk) at[kk] = *(const LAS bf16x8*)(ATl + ip * 72 + kk * 32 + fq * 8);
#pragma unroll
            for (int tt = 0; tt < 2; ++tt) { const int te = (wave & 1) * 2 + tt;
                f32x4 a = {0.f, 0.f, 0.f, 0.f};
#pragma unroll
                for (int kk = 0; kk < 4; ++kk) { const bf16x8 sf = *(const LAS bf16x8*)(STr + (te * 16 + fr) * 136 + kk * 32 + fq * 8); a = mfma16(sf, qd[kk], a); }
                bf16x8 v0 = *(const LAS bf16x8*)(VTl + (te * 16 + fr) * 72 + (z ? (56 - fq * 8) : (fq * 8))), v1 = *(const LAS bf16x8*)(VTl + (te * 16 + fr) * 72 + (z ? (24 - fq * 8) : (32 + fq * 8)));
                if (z) { v0 = rev8(v0); v1 = rev8(v1); }
                a = mfma16(v0, at[0], a); a = mfma16(v1, at[1], a);
                { u32x2 w; w.x = pk2(a.x, a.y); w.y = pk2(a.z, a.w); *(u32x2*)(O + mrow * D + h * 256 + dvs * 64 + te * 16 + 4 * fq) = w; } }
            { const bf16x8 kl0 = *(const LAS bf16x8*)(KLl + (wave * 16 + fr) * 72 + fq * 8), kl1 = *(const LAS bf16x8*)(KLl + (wave * 16 + fr) * 72 + 32 + fq * 8);
#pragma unroll
              for (int te = 0; te < 4; ++te) { f32x4 a = Sacc[te] * dec_cur; a = mfma16(kl0, vt[te][0], a); a = mfma16(kl1, vt[te][1], a); Sacc[te] = a;
                  u32x2 w; w.x = pk2(a.x, a.y); w.y = pk2(a.z, a.w); *(LAS u32x2*)(STw + (te * 16 + fr) * 136 + wave * 16 + 4 * fq) = w; } }
            __syncthreads();
        }
    }
}

__device__ __forceinline__ void phase_gla_out(const Params& P, int j_odd, int tid, int bid, int nb, int Mrows) {
    const int lane = tid & 63, wave = tid >> 6; unsigned char* ws = P.ws;
    const bf16* PB = (const bf16*)(ws + WS_P); bf16* A2 = (bf16*)(ws + WS_A2);
    const bf16* OF = (const bf16*)(ws + WS_OF); const bf16* OB = (const bf16*)(ws + WS_OB);
    const f32x4 ng = *(const f32x4*)(P.in[16] + j_odd * 256 + 4 * lane);
    for (int m0 = (bid * NWAVES + wave) * 2; m0 < Mrows; m0 += nb * NWAVES * 2) {
        u32x2 of[2][4], ob[2][4], rr[2][4];
#pragma unroll
        for (int q = 0; q < 2; ++q) { const int m = min(m0 + q, Mrows - 1);
#pragma unroll
            for (int h = 0; h < 4; ++h) { const int col = h * 256 + 4 * lane;
                of[q][h] = *(const u32x2*)(OF + (size_t)m * D + col); ob[q][h] = *(const u32x2*)(OB + (size_t)m * D + col); rr[q][h] = *(const u32x2*)(PB + (size_t)m * GLA_IN + 2048 + col); } }
#pragma unroll
        for (int q = 0; q < 2; ++q) { const int m = m0 + q;
            if (m < Mrows) {
#pragma unroll
                for (int h = 0; h < 4; ++h) { const int col = h * 256 + 4 * lane;
                    const f32x4 o = {bf2f(of[q][h].x & 0xffffu) + bf2f(ob[q][h].x & 0xffffu), bf2f(of[q][h].x >> 16) + bf2f(ob[q][h].x >> 16), bf2f(of[q][h].y & 0xffffu) + bf2f(ob[q][h].y & 0xffffu), bf2f(of[q][h].y >> 16) + bf2f(ob[q][h].y >> 16)};
                    const float ss = wave_sum(o.x * o.x + o.y * o.y + o.z * o.z + o.w * o.w);
                    const float rs = rsqrtf(ss * (1.0f / 256.0f) + 1e-6f);
                    const float r0 = bf2f(rr[q][h].x & 0xffffu), r1 = bf2f(rr[q][h].x >> 16), r2 = bf2f(rr[q][h].y & 0xffffu), r3 = bf2f(rr[q][h].y >> 16);
                    u32x2 w; w.x = pk2(o.x * rs * ng.x * silu_f(r0), o.y * rs * ng.y * silu_f(r1)); w.y = pk2(o.z * rs * ng.z * silu_f(r2), o.w * rs * ng.w * silu_f(r3));
                    *(u32x2*)(A2 + (size_t)m * D + col) = w; } } }
    }
}

constexpr int L1_HP = 1040;
constexpr int L1_HHI = 0, L1_HLO = 16 * L1_HP * 2;
constexpr int L1_PART = 2 * 16 * L1_HP * 2;
constexpr int L1_SEL = L1_PART + 16384;
constexpr int L1_MAXROWS = 136;
constexpr int L1_VEC = L1_SEL + 8192;
template <bool B> struct BTag { static constexpr bool value = B; };
template <bool L0> struct L1XSel { typedef f32x4 type; };
template <> struct L1XSel<false> { typedef u32x2 type; };
__device__ __forceinline__ f32x4 l1_xval(const f32x4& x) { return x; }
__device__ __forceinline__ f32x4 l1_xval(const u32x2& w) { return (f32x4){bf2f(w.x & 0xffffu), bf2f(w.x >> 16), bf2f(w.y & 0xffffu), bf2f(w.y >> 16)}; }
__device__ __forceinline__ void phase_ln1_router(const Params& P, LAS unsigned char* lds, int layer, int tid, int bid, int nb, int Mrows, bool dry = false) {
    const int lane = tid & 63, wave = tid >> 6, fr = lane & 15, fq = lane >> 4; unsigned char* ws = P.ws;
    LAS bf16* HHI = (LAS bf16*)(lds + L1_HHI); LAS bf16* HLO = (LAS bf16*)(lds + L1_HLO); LAS float* PART = (LAS float*)(lds + L1_PART);
    LAS int* SELE = (LAS int*)(lds + L1_SEL); LAS int* SELP = SELE + L1_MAXROWS * 4; LAS float* SELG = (LAS float*)(SELP + L1_MAXROWS * 4);
    LAS int* hist = (LAS int*)(SELG + L1_MAXROWS * 4); LAS int* base = hist + 32;
    __syncthreads();
    LAS float* RB = (LAS float*)(base + 32);
    if (tid < 32) { hist[tid] = 0; RB[tid] = P.in[19][layer * 32 + tid]; }
    bf16x8 whi[2][4], wlo[2][4];
    { const bf16* rwt = (const bf16*)(ws + WS_RWT) + (size_t)layer * 2 * 32 * 1024;
#pragma unroll
      for (int et = 0; et < 2; ++et)
#pragma unroll
          for (int ks = 0; ks < 4; ++ks) { const bf16* p = rwt + (size_t)(et * 16 + fr) * 1024 + wave * 128 + ks * 32 + fq * 8; whi[et][ks] = *(const bf16x8*)p; wlo[et][ks] = *(const bf16x8*)(p + 32 * 1024); } }
    const int rpb = (Mrows + nb - 1) / nb;
    const int row_lo = bid * rpb, row_hi = min(row_lo + rpb, Mrows);
    const float* mods = (const float*)(ws + WS_MODS) + (size_t)layer * 9 * 6144;
    LAS float* VEC = (LAS float*)(lds + L1_VEC);
    const int mb0 = (row_lo < ML) ? (row_lo >> 12) : 8, mb1 = (row_hi - 1 < ML) ? ((row_hi - 1) >> 12) : 8;
    for (int idx = tid; idx < 8 * 1024; idx += NTHREADS) { const int vsel = idx >> 10, col = idx & 1023; float x;
        if (vsel == 0) x = P.in[6][(size_t)(layer * 2 + 0) * D + col]; else if (vsel == 1) x = P.in[7][(size_t)(layer * 2 + 0) * D + col];
        else { const int set = (vsel - 2) / 3, what = (vsel - 2) % 3; x = mods[(size_t)(set ? mb1 : mb0) * 6144 + (what == 0 ? 3 : what == 1 ? 4 : 2) * 1024 + col]; }
        VEC[idx] = x; }
    const bf16* X2 = (const bf16*)(ws + WS_X); bf16* Xo = (bf16*)(ws + WS_OB); unsigned char* H8o        = (unsigned char*)(ws + (dry ? WS_A2 : WS_H8));
    const bf16* OPR = (const bf16*)(ws + WS_P);
    const f32x4 zero4 = {0.f, 0.f, 0.f, 0.f};
    __syncthreads();
    auto run = [&](auto l0tag) __attribute__((always_inline)) {
        constexpr bool L0 = decltype(l0tag)::value;
        typedef typename L1XSel<L0>::type XT;
        XT xA[2][4], xB[2][4]; u32x2 oA[2][4], oB[2][4];
        auto load_rows = [&](int pp, XT (&xs)[2][4], u32x2 (&os)[2][4]) __attribute__((always_inline)) {
#pragma unroll
            for (int rr = 0; rr < 2; ++rr) { const int m = min(pp + wave * 2 + rr, row_hi - 1);
#pragma unroll
                for (int j = 0; j < 4; ++j) {
                    if constexpr (L0) { const float* xsrc = (m < ML) ? P.in[0] + (size_t)m * D : P.in[2] + (size_t)(m - ML) * D; xs[rr][j] = *(const f32x4*)(xsrc + 4 * lane + 256 * j); }
                    else xs[rr][j] = *(const u32x2*)(X2 + (size_t)m * D + 4 * lane + 256 * j);
                    os[rr][j] = *(const u32x2*)(OPR + (size_t)m * D + 4 * lane + 256 * j); } } };
        auto pass = [&](int p0, XT (&xs)[2][4], u32x2 (&os)[2][4]) __attribute__((always_inline)) {
#pragma unroll
        for (int rr = 0; rr < 2; ++rr) { const int lr16 = wave * 2 + rr, m = p0 + lr16;
            if (m < row_hi) {
                const int mb = (m < ML) ? (m >> 12) : 8; const LAS float* VS = VEC + 2048 + ((mb == mb0) ? 0 : 3072);
                f32x4 v[4]; float s = 0.f;
#pragma unroll
                for (int j = 0; j < 4; ++j) { const int col = 4 * lane + 256 * j; const u32x2 ow = os[rr][j]; const f32x4 g1 = *(const LAS f32x4*)(VS + 2048 + col);
                    const f32x4 o = {bf2f(ow.x & 0xffffu), bf2f(ow.x >> 16), bf2f(ow.y & 0xffffu), bf2f(ow.y >> 16)};
                    const f32x4 xv = l1_xval(xs[rr][j]);
                    v[j] = xv * DN_ALPHA + g1 * o; s += (v[j].x + v[j].y) + (v[j].z + v[j].w); }
                const float mean = wave_sum(s) * (1.f / D); float s2 = 0.f;
#pragma unroll
                for (int j = 0; j < 4; ++j) { v[j] = v[j] - mean; s2 += (v[j].x * v[j].x + v[j].y * v[j].y) + (v[j].z * v[j].z + v[j].w * v[j].w); }
                const float rstd = rsqrtf(wave_sum(s2) * (1.f / D) + LN_EPS);
#pragma unroll
                for (int j = 0; j < 4; ++j) { const int col = 4 * lane + 256 * j; const f32x4 g = *(const LAS f32x4*)(VEC + col), bb = *(const LAS f32x4*)(VEC + 1024 + col);
                    v[j] = v[j] * rstd * g + bb; { u32x2 xw; xw.x = pk2(v[j].x, v[j].y); xw.y = pk2(v[j].z, v[j].w); *(u32x2*)(Xo + (size_t)m * D + col) = xw; }
                    const f32x4 sh = *(const LAS f32x4*)(VS + col), sc = *(const LAS f32x4*)(VS + 1024 + col);
                    const f32x4 hq = v[j] * (1.f + sc) + sh;
                    *(unsigned*)(H8o + (size_t)m * D + col) = pk4_fp8(hq.x * H8_SCALE, hq.y * H8_SCALE, hq.z * H8_SCALE, hq.w * H8_SCALE);
                    const unsigned h01 = pk2(hq.x, hq.y), h23 = pk2(hq.z, hq.w);
                    const unsigned l01 = pk2(hq.x - bf2f(h01 & 0xffffu), hq.y - bf2f(h01 >> 16)), l23 = pk2(hq.z - bf2f(h23 & 0xffffu), hq.w - bf2f(h23 >> 16));
                    u32x2 wh = {h01, h23}, wl = {l01, l23};
                    *(LAS u32x2*)(HHI + lr16 * L1_HP + col) = wh; *(LAS u32x2*)(HLO + lr16 * L1_HP + col) = wl; }
            } }
        __syncthreads();
        { f32x4 acc[2] = {zero4, zero4};
#pragma unroll
          for (int ks = 0; ks < 4; ++ks) { const bf16x8 hh = *(const LAS bf16x8*)(HHI + fr * L1_HP + wave * 128 + ks * 32 + fq * 8), hl = *(const LAS bf16x8*)(HLO + fr * L1_HP + wave * 128 + ks * 32 + fq * 8);
#pragma unroll
              for (int et = 0; et < 2; ++et) { acc[et] = mfma16(whi[et][ks], hh, acc[et]); acc[et] = mfma16(whi[et][ks], hl, acc[et]); acc[et] = mfma16(wlo[et][ks], hh, acc[et]); } }
#pragma unroll
          for (int et = 0; et < 2; ++et) *(LAS f32x4*)(PART + (wave * 16 + fr) * 32 + et * 16 + 4 * fq) = acc[et]; }
        __syncthreads();
        { const int hl = lane & 31, lr16 = wave * 2 + (lane >> 5), m = p0 + lr16;
          float lgv = RB[hl];
#pragma unroll
          for (int w8 = 0; w8 < 8; ++w8) lgv += PART[(w8 * 16 + lr16) * 32 + hl];
          int se[4]; float sv[4];
#pragma unroll
          for (int k = 0; k < 4; ++k) {
              float mx = lgv;
              mx = fmaxf(mx, __builtin_bit_cast(float, __builtin_amdgcn_update_dpp(0, __builtin_bit_cast(int, mx), 0x128, 0xf, 0xf, false)));
              mx = fmaxf(mx, __builtin_bit_cast(float, __builtin_amdgcn_update_dpp(0, __builtin_bit_cast(int, mx), 0x124, 0xf, 0xf, false)));
              mx = fmaxf(mx, __builtin_bit_cast(float, __builtin_amdgcn_update_dpp(0, __builtin_bit_cast(int, mx), 0x122, 0xf, 0xf, false)));
              mx = fmaxf(mx, __builtin_bit_cast(float, __builtin_amdgcn_update_dpp(0, __builtin_bit_cast(int, mx), 0x121, 0xf, 0xf, false)));
              { float a_, b_; swap16(mx, a_, b_); mx = fmaxf(a_, b_); }
              const unsigned long long bal = __ballot(lgv == mx);
              const unsigned hm = (unsigned)(bal >> (lane & 32));
              const int bi = __builtin_ctz(hm);
              se[k] = bi; sv[k] = mx;
              lgv = (hl == bi) ? -3.0e38f : lgv; }
          const float e1 = __expf(sv[1] - sv[0]), e2 = __expf(sv[2] - sv[0]), e3 = __expf(sv[3] - sv[0]); const float inv = 1.f / (1.f + e1 + e2 + e3);
          if ((lane & 31) == 0 && m < row_hi) { const int lr = m - row_lo;
              const float gt[4] = {inv, e1 * inv, e2 * inv, e3 * inv};
#pragma unroll
              for (int k = 0; k < 4; ++k) { const int pos = atomicAdd((int*)(hist + se[k]), 1); SELE[lr * 4 + k] = se[k]; SELP[lr * 4 + k] = pos; SELG[lr * 4 + k] = gt[k]; } } }
        };
        load_rows(row_lo, xA, oA);
        for (int p0 = row_lo; p0 < row_hi; p0 += 32) {
            const bool more = p0 + 16 < row_hi;
            if (more) load_rows(p0 + 16, xB, oB);
            pass(p0, xA, oA);
            if (more) { if (p0 + 32 < row_hi) load_rows(p0 + 32, xA, oA); pass(p0 + 16, xB, oB); }
        }
    };
    if (layer == 0) run(BTag<true>{}); else run(BTag<false>{});
    __syncthreads();
    if (dry) return;
    if (tid < 32) { unsigned* cnt = (unsigned*)(ws + WS_CTL) + CW_CNT + layer * 32; const int hc = hist[tid]; base[tid] = hc ? (int)__hip_atomic_fetch_add(cnt + tid, (unsigned)hc, __ATOMIC_RELAXED, __HIP_MEMORY_SCOPE_AGENT) : 0; }
    __syncthreads();
    const int nrows = row_hi - row_lo;
    int* TOKE = (int*)(ws + WS_TOKE); int* TOKP = (int*)(ws + WS_TOKP); float* TOKG = (float*)(ws + WS_TOKG); int* LIST = (int*)(ws + WS_LIST);
    for (int idx = tid; idx < nrows * 4; idx += NTHREADS) { const int lr = idx >> 2; const int m = row_lo + lr; const int e = SELE[idx], pos = base[e] + SELP[idx];
        TOKE[(size_t)m * 4 + (idx & 3)] = e; TOKP[(size_t)m * 4 + (idx & 3)] = pos; TOKG[(size_t)m * 4 + (idx & 3)] = SELG[idx]; LIST[(size_t)e * M + pos] = m; }
}

__device__ __forceinline__ void phase_ln2_combine(const Params& P, LAS unsigned char* lds, int layer, int tid, int bid, int nb, int Mrows, bool dry = false) {
    const int lane = tid & 63, wave = tid >> 6; unsigned char* ws = P.ws;
    moe_tables<0>(P, lds, tid, layer);
    const LAS int* tab = (const LAS int*)(lds + g8::MOE_TAB);
    const float* mods = (const float*)(ws + WS_MODS) + (size_t)layer * 9 * 6144;
    const float* modn = (const float*)(ws + WS_MODS) + (size_t)(layer + 1) * 9 * 6144;
    const bf16* X = (const bf16*)(ws + WS_OB); bf16* X2 = (bf16*)(ws + WS_X); const bf16* YS = (const bf16*)(ws + WS_YS);
    const int* TOKE = (const int*)(ws + WS_TOKE); const int* TOKP = (const int*)(ws + WS_TOKP); const float* TOKG = (const float*)(ws + WS_TOKG);
    const int rpb = (Mrows + nb - 1) / nb;
    const int row_lo = bid * rpb, row_hi = min(row_lo + rpb, Mrows);
    LAS float* VEC = (LAS float*)lds;
    const int mb0 = (row_lo < ML) ? (row_lo >> 12) : 8, mb1 = (row_hi - 1 < ML) ? ((row_hi - 1) >> 12) : 8;
    const bool has_next = layer < DEPTH - 1;
    for (int idx = tid; idx < 8 * 1024; idx += NTHREADS) { const int vsel = idx >> 10, col = idx & 1023; float x;
        if (vsel == 0) x = P.in[6][(size_t)(layer * 2 + 1) * D + col]; else if (vsel == 1) x = P.in[7][(size_t)(layer * 2 + 1) * D + col];
        else { const int set = (vsel - 2) / 3, what = (vsel - 2) % 3; const int mbs = set ? mb1 : mb0;
            x = (what == 0) ? mods[(size_t)mbs * 6144 + 5 * 1024 + col] : (has_next ? modn[(size_t)mbs * 6144 + (what == 1 ? 0 : 1024) + col] : 0.f); }
        VEC[idx] = x; }
    __syncthreads();
    for (int m0 = row_lo + wave * 2; m0 < row_hi; m0 += 2 * NWAVES) {
        int te[2][4], tp[2][4]; float tg[2][4];
#pragma unroll
        for (int rr = 0; rr < 2; ++rr) { const int m = min(m0 + rr, row_hi - 1);
#pragma unroll
            for (int k = 0; k < 4; ++k) { te[rr][k] = TOKE[(size_t)m * 4 + k]; tp[rr][k] = TOKP[(size_t)m * 4 + k]; tg[rr][k] = TOKG[(size_t)m * 4 + k]; } }
        u32x2 xr[2][4]; u32x2 yr[2][4][4];
#pragma unroll
        for (int rr = 0; rr < 2; ++rr) { const int m = min(m0 + rr, row_hi - 1);
#pragma unroll
            for (int j = 0; j < 4; ++j) xr[rr][j] = *(const u32x2*)(X + (size_t)m * D + 4 * lane + 256 * j);
#pragma unroll
            for (int k = 0; k < 4; ++k) { const bf16* yp = YS + ((size_t)tab[96 + te[rr][k]] + tp[rr][k]) * 1024 + 4 * lane;
#pragma unroll
                for (int j = 0; j < 4; ++j) yr[rr][k][j] = *(const u32x2*)(yp + 256 * j); } }
#pragma unroll
        for (int rr = 0; rr < 2; ++rr) { const int m = m0 + rr;
            if (m < row_hi) {
                const int mb = (m < ML) ? (m >> 12) : 8; const LAS float* VS = VEC + 2048 + ((mb == mb0) ? 0 : 3072);
                f32x4 v[4]; float s = 0.f;
#pragma unroll
                for (int j = 0; j < 4; ++j) { const int col = 4 * lane + 256 * j; f32x4 y = {0.f, 0.f, 0.f, 0.f};
#pragma unroll
                    for (int k = 0; k < 4; ++k) { const u32x2 rw = yr[rr][k][j]; const float gt = tg[rr][k];
                        y.x += gt * bf2f(rw.x & 0xffffu); y.y += gt * bf2f(rw.x >> 16); y.z += gt * bf2f(rw.y & 0xffffu); y.w += gt * bf2f(rw.y >> 16); }
                    const f32x4 g2 = *(const LAS f32x4*)(VS + col);
                    const u32x2 xw = xr[rr][j]; const f32x4 xv = {bf2f(xw.x & 0xffffu), bf2f(xw.x >> 16), bf2f(xw.y & 0xffffu), bf2f(xw.y >> 16)};
                    v[j] = xv * DN_ALPHA + g2 * y; s += (v[j].x + v[j].y) + (v[j].z + v[j].w); }
                const float mean = wave_sum(s) * (1.f / D); float s2 = 0.f;
#pragma unroll
                for (int j = 0; j < 4; ++j) { v[j] = v[j] - mean; s2 += (v[j].x * v[j].x + v[j].y * v[j].y) + (v[j].z * v[j].z + v[j].w * v[j].w); }
                const float rstd = rsqrtf(wave_sum(s2) * (1.f / D) + LN_EPS);
#pragma unroll
                for (int j = 0; j < 4; ++j) { const int col = 4 * lane + 256 * j; const f32x4 g = *(const LAS f32x4*)(VEC + col), bb = *(const LAS f32x4*)(VEC + 1024 + col);
                    v[j] = v[j] * rstd * g + bb;
                    if (dry) *(f32x4*)((float*)(ws + WS_OB) + (size_t)m * D + col) = v[j]; else if (has_next) { u32x2 xo; xo.x = pk2(v[j].x, v[j].y); xo.y = pk2(v[j].z, v[j].w); *(u32x2*)(X2 + (size_t)m * D + col) = xo; } else *(f32x4*)(P.out + (size_t)m * D + col) = v[j];
                    if (has_next) { const f32x4 sh = *(const LAS f32x4*)(VS + 1024 + col), sc = *(const LAS f32x4*)(VS + 2048 + col);
                        *(unsigned*)((unsigned char*)(ws + (dry ? WS_A2 : WS_H)) + (size_t)m * D + col) = pk4_fp8((v[j].x * (1.f + sc.x) + sh.x) * H8_SCALE, (v[j].y * (1.f + sc.y) + sh.y) * H8_SCALE, (v[j].z * (1.f + sc.z) + sh.z) * H8_SCALE, (v[j].w * (1.f + sc.w) + sh.w) * H8_SCALE); } }
            } }
    }
}

#define XB_TMO      128
#define XB_XCNT(j)  (256  + 64 * (j))
#define XB_XSUB(j)  (1280 + 64 * (j))
#define XB_XGEN(j)  (2304 + 64 * (j))
#define XB_TOP      3328
#define XB_TOPGEN   3392
#define XCD_BAR_WORDS 3456
#define XB_SPIN_CAP (1u << 20)

__device__ __forceinline__ unsigned xb_ld(unsigned* p)              { return __hip_atomic_load(p, __ATOMIC_RELAXED, __HIP_MEMORY_SCOPE_AGENT); }
__device__ __forceinline__ unsigned xb_add(unsigned* p, unsigned v) { return __hip_atomic_fetch_add(p, v, __ATOMIC_RELAXED, __HIP_MEMORY_SCOPE_AGENT); }
__device__ __forceinline__ unsigned xb_xcc_id() { return (unsigned)__builtin_amdgcn_s_getreg((3 << 11) | 20) & 0xFu; }
#define XB_SPIN(cond, bar) do { unsigned _sp = 0; while (cond) { __builtin_amdgcn_s_sleep(1); \
    if ((++_sp & 255u) == 0u) { if (xb_ld(&(bar)[XB_TMO])) break; if (_sp > XB_SPIN_CAP) { atomicAdd(&(bar)[XB_TMO], 1u); break; } } } } while (0)

struct XcdBarrier {
    unsigned* bar; unsigned x;
    volatile LAS unsigned* st;
};

__device__ __forceinline__ XcdBarrier xcd_barrier_post(unsigned* bar, volatile LAS unsigned* st) {
    XcdBarrier b; b.bar = bar; b.x = xb_xcc_id(); b.st = st;
    if (threadIdx.x == 0) (void)xb_add(&bar[XB_XCNT(b.x)], 1u);
    return b;
}
__device__ __forceinline__ void xcd_barrier_complete(unsigned* bar, unsigned x, unsigned& nloc, unsigned& nx) {
    const unsigned G = gridDim.x * gridDim.y * gridDim.z;
    unsigned sum, cnt, mine, sp = 0u;
    for (;;) {
        sum = 0u; cnt = 0u; mine = 0u;
#pragma unroll
        for (unsigned j = 0; j < 16; ++j) { const unsigned c = xb_ld(&bar[XB_XCNT(j)]); sum += c; cnt += (c > 0u) ? 1u : 0u; mine = (j == x) ? c : mine; }
        if (sum == G) break;
        __builtin_amdgcn_s_sleep(1);
        if ((++sp & 255u) == 0u) { if (xb_ld(&bar[XB_TMO])) break; if (sp > XB_SPIN_CAP) { atomicAdd(&bar[XB_TMO], 1u); break; } }
    }
    nloc = mine > 0u ? mine : 1u; nx = cnt > 0u ? cnt : 1u;
}

__device__ __forceinline__ void xcd_barrier(const XcdBarrier& b) {
    asm volatile("s_waitcnt vmcnt(0)" ::: "memory");
    __syncthreads();
    if (threadIdx.x == 0) {
        unsigned* bar = b.bar;
        __builtin_amdgcn_s_waitcnt(0);
        unsigned nloc = b.st[0], nx = b.st[1];
        if (nloc == 0u) { xcd_barrier_complete(bar, b.x, nloc, nx); b.st[0] = nloc; b.st[1] = nx; }
        const unsigned old = xb_add(&bar[XB_XSUB(b.x)], 1u);
        const unsigned gen = old / nloc;
        if (old + 1u == (gen + 1u) * nloc) {
            __builtin_amdgcn_fence(__ATOMIC_RELEASE, "agent");
            asm volatile("s_waitcnt vmcnt(0)" ::: "memory");
            const unsigned og = xb_add(&bar[XB_TOP], 1u);
            const unsigned tg = og / nx;
            if (og + 1u == (tg + 1u) * nx) xb_add(&bar[XB_TOPGEN], 1u);
            else XB_SPIN(xb_ld(&bar[XB_TOPGEN]) == tg, bar);
            __builtin_amdgcn_fence(__ATOMIC_ACQUIRE, "agent");
            xb_add(&bar[XB_XGEN(b.x)], 1u);
            asm volatile("s_waitcnt vmcnt(0)" ::: "memory");
        } else {
            XB_SPIN(xb_ld(&bar[XB_XGEN(b.x)]) == gen, bar);
            __builtin_amdgcn_fence(__ATOMIC_ACQUIRE, "agent");
            asm volatile("s_waitcnt vmcnt(0)" ::: "memory");
        }
    }
    __syncthreads();
}


constexpr int NPHASES = 2 + 8 * DEPTH;
__global__ void __launch_bounds__(NTHREADS, 2) fwd_kernel(Params P) {
    extern __shared__ __attribute__((aligned(16))) unsigned char lds_raw[];
    LAS unsigned char* lds = (LAS unsigned char*)lds_raw;
    const int tid = threadIdx.x, bid = blockIdx.x, nb = gridDim.x;
    const int lo = P.ph_lo, hi = P.ph_hi;
    volatile LAS unsigned* misc = (volatile LAS unsigned*)(lds + LDS_MISC);
    if (tid < 4) misc[tid] = 0u;
    __syncthreads();
    XcdBarrier bar; bar.bar = (unsigned*)(P.ws + WS_CTL) + CW_BAR; bar.x = 0; bar.st = misc;
    if (hi - lo > 1) bar = xcd_barrier_post((unsigned*)(P.ws + WS_CTL) + CW_BAR, misc);
#define IN(k) (lo <= (k) && (k) < hi)
#define GRIDBAR() do { XcdBarrier b2_ = bar; int z2_ = 0; asm volatile("" : "+s"(z2_)); b2_.bar = bar.bar + z2_; xcd_barrier(b2_); } while (0)
#define SEAM(k) do { if (lo <= (k) && (k) + 1 < hi) GRIDBAR(); } while (0)
#define DUP(bit, call) do { if (PROBE_DUP & (bit)) { GRIDBAR(); call; } } while (0)
    if (IN(0)) { phase_prologue_a(P, lds, tid, bid, nb); DUP(1, phase_prologue_a(P, lds, tid, bid, nb)); SEAM(0); }
    if (IN(1)) { phase_prologue_b(P, tid, bid, nb); SEAM(1); }
#pragma unroll 1
    for (int i = 0; i < DEPTH; ++i) {
        const int pb = 2 + 8 * i, j = i >> 1;
        Params Pl = P; { int z_ = 0; asm volatile("" : "+s"(z_)); Pl.ws = P.ws + z_; }
        int tid_l = threadIdx.x, bid_l = blockIdx.x; asm volatile("" : "+v"(tid_l)); asm volatile("" : "+s"(bid_l));
        const bool last = (i == DEPTH - 1);
        const int Mres = last ? ML : M;
        if ((i & 1) == 0) {
            if (IN(pb + 0)) { phase_gemm_dense<0>(Pl, lds, tid_l, bid_l, nb, (const void*)(Pl.ws + WS_H), (const void*)(Pl.ws + WS_WABIN + (size_t)j * AB_IN * 1024), M, AB_IN, i); DUP(2, phase_gemm_dense<0>(Pl, lds, tid_l, bid_l, nb, (const void*)(Pl.ws + WS_H), (const void*)(Pl.ws + WS_WABIN + (size_t)j * AB_IN * 1024), M, AB_IN, i)); SEAM(pb + 0); }
            if (IN(pb + 1)) { phase_even_mixer(Pl, lds, j, tid_l, bid_l, nb); DUP(4, phase_even_mixer(Pl, lds, j, tid_l, bid_l, nb)); SEAM(pb + 1); }
            if (IN(pb + 3)) { phase_gemm_dense<1>(Pl, lds, tid_l, bid_l, nb, (const bf16*)(Pl.ws + WS_A2), (const bf16*)(Pl.ws + WS_WABOUT) + (size_t)j * 1024 * 1024, Mres, 1024, i); SEAM(pb + 3); }
        } else {
            if (IN(pb + 0)) { phase_gemm_dense<0>(Pl, lds, tid_l, bid_l, nb, (const void*)(Pl.ws + WS_H), (const void*)(Pl.ws + WS_WGIN + (size_t)j * WGIN_STRIDE), M, GLA_IN, i); DUP(2, phase_gemm_dense<0>(Pl, lds, tid_l, bid_l, nb, (const void*)(Pl.ws + WS_H), (const void*)(Pl.ws + WS_WGIN + (size_t)j * WGIN_STRIDE), M, GLA_IN, i)); SEAM(pb + 0); }
            if (IN(pb + 1)) { if (PROBE_DUP & (1 << 16)) { phase_gla_prepass(Pl, lds, j, tid_l, bid_l, nb, (PROBE_DUP >> 17) & 15); GRIDBAR(); } phase_gla_prepass(Pl, lds, j, tid_l, bid_l, nb); DUP(128, phase_gla_prepass(Pl, lds, j, tid_l, bid_l, nb)); GRIDBAR(); phase_gla_scan(Pl, lds, tid_l, bid_l, nb); DUP(8, phase_gla_scan(Pl, lds, tid_l, bid_l, nb)); SEAM(pb + 1); }
            if (IN(pb + 2)) { phase_gla_out(Pl, j, tid_l, bid_l, nb, Mres); DUP(64, phase_gla_out(Pl, j, tid_l, bid_l, nb, Mres)); SEAM(pb + 2); }
            if (IN(pb + 3)) { phase_gemm_dense<1>(Pl, lds, tid_l, bid_l, nb, (const bf16*)(Pl.ws + WS_A2), (const bf16*)(Pl.ws + WS_WGOUT) + (size_t)j * 1024 * 1024, Mres, 1024, i); SEAM(pb + 3); }
        }
        if (IN(pb + 4)) { if (PROBE_DUP & 256) { phase_ln1_router(Pl, lds, i, tid_l, bid_l, nb, Mres, true); GRIDBAR(); } phase_ln1_router(Pl, lds, i, tid_l, bid_l, nb, Mres); SEAM(pb + 4); }
        if (IN(pb + 5)) { if (PROBE_DUP & (1024 | 2048 | 4096 | 8192 | 16384 | 32768)) { phase_moe_gemm<1>(Pl, lds, tid_l, bid_l, nb, i, (PROBE_DUP >> 10) & 63); GRIDBAR(); } phase_moe_gemm<1>(Pl, lds, tid_l, bid_l, nb, i); DUP(16, phase_moe_gemm<1>(Pl, lds, tid_l, bid_l, nb, i)); SEAM(pb + 5); }
        if (IN(pb + 6)) { phase_moe_gemm<2>(Pl, lds, tid_l, bid_l, nb, i); DUP(32, phase_moe_gemm<2>(Pl, lds, tid_l, bid_l, nb, i)); SEAM(pb + 6); }
        if (IN(pb + 7)) { if (PROBE_DUP & 512) { phase_ln2_combine(Pl, lds, i, tid_l, bid_l, nb, Mres, true); GRIDBAR(); } phase_ln2_combine(Pl, lds, i, tid_l, bid_l, nb, Mres); SEAM(pb + 7); }
    }
#undef IN
#undef SEAM
#undef GRIDBAR
}

extern "C" void kernel_launch(void* const* d_in, const int* in_sizes, int n_in, void* d_out, int out_size, void* d_ws, size_t ws_size, hipStream_t stream) {
    static int grid = 0;
    if (grid == 0) {
        if (n_in != 24 || out_size != ML * D || ws_size < WS_END) { fprintf(stderr, "kernel_launch: unexpected problem (n_in %d, out %d, ws %zu < %zu)\n", n_in, out_size, ws_size, (size_t)WS_END); grid = -1; return; }
        int dev = 0, cus = 0, per_cu = 0;
        if (hipGetDevice(&dev) != hipSuccess || hipDeviceGetAttribute(&cus, hipDeviceAttributeMultiprocessorCount, dev) != hipSuccess) { grid = -1; return; }
        if (hipFuncSetAttribute((const void*)fwd_kernel, hipFuncAttributeMaxDynamicSharedMemorySize, LDS_BYTES) != hipSuccess) { fprintf(stderr, "kernel_launch: hipFuncSetAttribute failed\n"); grid = -1; return; }
        if (hipOccupancyMaxActiveBlocksPerMultiprocessor(&per_cu, (const void*)fwd_kernel, NTHREADS, LDS_BYTES) != hipSuccess || per_cu < 1) { fprintf(stderr, "kernel_launch: occupancy query says %d blocks per CU\n", per_cu); }
        (void)hipGetLastError();
        grid = cus;
    }
    if (grid < 0) return;
    (void)hipMemsetAsync((char*)d_ws + WS_CTL, 0, CTL_ZERO_BYTES, stream);
    Params p{};
    for (int i = 0; i < 24; ++i) p.in[i] = (const float*)d_in[i];
    p.out = (float*)d_out; p.ws = (unsigned char*)d_ws;
#if MK_PER_PHASE
    for (int ph = 0; ph < NPHASES; ++ph) {
        if (ph >= 2 && ((ph - 2) & 7) == 2 && ((((ph - 2) >> 3) & 1) == 0)) continue;
        p.ph_lo = ph; p.ph_hi = ph + 1;
        hipLaunchKernelGGL(fwd_kernel, dim3(grid), dim3(NTHREADS), LDS_BYTES, stream, p);
    }
#else
    p.ph_lo = 0; p.ph_hi = NPHASES;
    hipLaunchKernelGGL(fwd_kernel, dim3(grid), dim3(NTHREADS), LDS_BYTES, stream, p);
#endif
    const hipError_t le = hipPeekAtLastError();
    if (le != hipSuccess) fprintf(stderr, "kernel_launch: launch failed: %s\n", hipGetErrorName(le));
}
```

```cpp
#include <hip/hip_runtime.h>
#include <cstdio>
#include <cstdint>

#ifndef MK_PER_PHASE
#define MK_PER_PHASE 0
#endif

#ifndef PROBE_DUP
#define PROBE_DUP 0
#endif
#define LAS __attribute__((address_space(3)))
typedef unsigned short bf16;
typedef short bf16x8 __attribute__((ext_vector_type(8)));
typedef float f32x4 __attribute__((ext_vector_type(4)));
typedef unsigned u32x4 __attribute__((ext_vector_type(4)));
typedef unsigned u32x2 __attribute__((ext_vector_type(2)));

constexpr int D = 1024, NBATCH = 8, T = 4096, NCTX = 256, DEPTH = 4;
constexpr int ML = NBATCH * T, MC = NBATCH * NCTX, M = ML + MC;
constexpr int AB_IN = 2560, GLA_IN = 3104, NE = 32;
constexpr int NSLOT = M * 4;
constexpr float DN_ALPHA = 1.6817928305074292f;
constexpr float LN_EPS = 1e-5f;
constexpr int NTHREADS = 512, NWAVES = 8;

constexpr size_t MiB = 1ull << 20;
constexpr size_t WS_CTL = 0, CTL_ZERO_BYTES = 1 * MiB;
constexpr size_t WS_MODS = 1 * MiB;
constexpr size_t WS_WABIN = 2 * MiB;
constexpr size_t WS_WABOUT = 12 * MiB;
constexpr size_t WS_WGIN = 16 * MiB, WGIN_STRIDE = (size_t)3328 * 1024;
constexpr size_t WS_WGOUT = 29 * MiB;
constexpr size_t WS_W1T = 33 * MiB;
constexpr size_t WS_W2T = 545 * MiB;
constexpr size_t WS_X = 801 * MiB;
constexpr size_t WS_H = 937 * MiB;
constexpr size_t WS_P = 1005 * MiB;
constexpr size_t WS_A2 = 1213 * MiB;
constexpr size_t WS_OF = 1281 * MiB;
constexpr size_t WS_OB = 1417 * MiB;
constexpr size_t WS_ACT = 1553 * MiB;
constexpr size_t WS_YS = 1827 * MiB;
constexpr size_t WS_LIST = 2101 * MiB;
constexpr size_t WS_TOKE = 2106 * MiB;
constexpr size_t WS_TOKP = 2107 * MiB;
constexpr size_t WS_TOKG = 2108 * MiB;
constexpr size_t WS_VT = 2109 * MiB;
constexpr size_t WS_VTC = WS_VT + 48 * MiB;
constexpr size_t WS_GQD = 2165 * MiB;
constexpr size_t WS_GKLT = 2241 * MiB;
constexpr size_t WS_GATT = 2319 * MiB;
constexpr size_t WS_GDEC = 2359 * MiB;
constexpr size_t WS_GVT = 2362 * MiB;
constexpr size_t WS_ROPE = 2440 * MiB;
constexpr size_t WS_H8 = 2442 * MiB;
constexpr size_t WS_RWT = 2477 * MiB;
constexpr size_t WS_END = 2478 * MiB;
constexpr int CW_BAR = 4096;
constexpr int CW_CNT = 8192;

constexpr int LDS_BYTES = 155648;
constexpr int LDS_MISC = 155648 - 256;

struct Params {
    const float* in[24];
    float* out;
    unsigned char* ws;
    int ph_lo, ph_hi;
};

#define LDS_WAIT() asm volatile("s_waitcnt lgkmcnt(0)" ::: "memory")
#define LDS_BARRIER() asm volatile("s_waitcnt lgkmcnt(0)\n\ts_barrier" ::: "memory")
__device__ __forceinline__ unsigned f2bf(float f) { unsigned u = __builtin_bit_cast(unsigned, f); return (u + 0x7fffu + ((u >> 16) & 1u)) >> 16; }
__device__ __forceinline__ float bf2f(unsigned h) { return __builtin_bit_cast(float, h << 16); }
typedef float f32x2 __attribute__((ext_vector_type(2)));
typedef __bf16 bf16x2_t __attribute__((ext_vector_type(2)));
__device__ __forceinline__ unsigned pk2(float lo, float hi) { const f32x2 v = {lo, hi}; const bf16x2_t b = __builtin_convertvector(v, bf16x2_t); return __builtin_bit_cast(unsigned, b); }
template <int CTRL> __device__ __forceinline__ float dppf(float x) { return __builtin_bit_cast(float, __builtin_amdgcn_update_dpp(0, __builtin_bit_cast(int, x), CTRL, 0xf, 0xf, false)); }
__device__ __forceinline__ void swap16(float x, float& a, float& b) { const unsigned u = __builtin_bit_cast(unsigned, x); const auto r = __builtin_amdgcn_permlane16_swap(u, u, false, false); const unsigned r0 = r[0], r1 = r[1]; a = __builtin_bit_cast(float, r0); b = __builtin_bit_cast(float, r1); }
__device__ __forceinline__ void swap32(float x, float& a, float& b) { const unsigned u = __builtin_bit_cast(unsigned, x); const auto r = __builtin_amdgcn_permlane32_swap(u, u, false, false); const unsigned r0 = r[0], r1 = r[1]; a = __builtin_bit_cast(float, r0); b = __builtin_bit_cast(float, r1); }
__device__ __forceinline__ float xsum_16_32(float v) { float a, b; swap16(v, a, b); v = a + b; swap32(v, a, b); return a + b; }
__device__ __forceinline__ float xmax_16_32(float v) { float a, b; swap16(v, a, b); v = fmaxf(a, b); swap32(v, a, b); return fmaxf(a, b); }
__device__ __forceinline__ float wave_sum(float v) {
    v += dppf<0xB1>(v);
    v += dppf<0x4E>(v);
    v += dppf<0x141>(v);
    v += dppf<0x140>(v);
    return xsum_16_32(v);
}
__device__ __forceinline__ f32x4 mfma16(bf16x8 a, bf16x8 b, f32x4 c) { return __builtin_amdgcn_mfma_f32_16x16x32_bf16(a, b, c, 0, 0, 0); }
__device__ __forceinline__ bf16x8 mk_frag(unsigned a, unsigned b, unsigned c, unsigned d) { u32x4 v = {a, b, c, d}; return __builtin_bit_cast(bf16x8, v); }
__device__ __forceinline__ unsigned pk4_fp8(float a, float b, float c, float d) {
    a = fminf(fmaxf(a, -448.f), 448.f); b = fminf(fmaxf(b, -448.f), 448.f); c = fminf(fmaxf(c, -448.f), 448.f); d = fminf(fmaxf(d, -448.f), 448.f);
    int w = 0; w = __builtin_amdgcn_cvt_pk_fp8_f32(a, b, w, false); w = __builtin_amdgcn_cvt_pk_fp8_f32(c, d, w, true); return (unsigned)w; }
__device__ __forceinline__ unsigned pk4_fp8_nc(float a, float b, float c, float d) { int w = 0; w = __builtin_amdgcn_cvt_pk_fp8_f32(a, b, w, false); w = __builtin_amdgcn_cvt_pk_fp8_f32(c, d, w, true); return (unsigned)w; }
constexpr float H8_SCALE = 16.f, ACT8_SCALE = 4.f, W1_SCALE = 256.f, W2_SCALE = 512.f;
constexpr int H8_E8 = 0x7B7B7B7B, ACT8_E8 = 0x7D7D7D7D, W1_E8 = 0x77777777, W2_E8 = 0x76767676;
__device__ __forceinline__ float silu_f(float x) { return x / (1.f + __expf(-x)); }


__device__ __forceinline__ void conv_item(const float* W, int N, int k0, int nsrc, bf16* WT, int ndst, LAS float* scr, int lane) {
#pragma unroll 8
    for (int i = 0; i < 32; ++i) { const int kk = 2 * i + (lane >> 5); scr[kk * 33 + (lane & 31)] = W[(size_t)(k0 + kk) * N + nsrc + (lane & 31)]; }
    LDS_WAIT(); asm volatile("" ::: "memory");
    const int c = lane & 7;
#pragma unroll
    for (int j = 0; j < 4; ++j) { const int n = (lane >> 3) + 8 * j; const LAS float* s = scr + (8 * c) * 33 + n;
        u32x4 o; o.x = pk2(s[0 * 33], s[1 * 33]); o.y = pk2(s[2 * 33], s[3 * 33]); o.z = pk2(s[4 * 33], s[5 * 33]); o.w = pk2(s[6 * 33], s[7 * 33]);
        *(u32x4*)(WT + (size_t)(ndst + n) * 1024 + k0 + 8 * c) = o; }
    LDS_WAIT(); asm volatile("" ::: "memory");
}

__device__ __forceinline__ void conv_item8(const float* W, int N, int k0, int nsrc, unsigned char* WT8, int ndst, float scale, LAS float* scr, int lane) {
#pragma unroll 8
    for (int i = 0; i < 32; ++i) { const int kk = 2 * i + (lane >> 5); scr[kk * 33 + (lane & 31)] = W[(size_t)(k0 + kk) * N + nsrc + (lane & 31)]; }
    LDS_WAIT(); asm volatile("" ::: "memory");
    const int c = lane & 7;
#pragma unroll
    for (int j = 0; j < 4; ++j) { const int n = (lane >> 3) + 8 * j; const LAS float* s = scr + (8 * c) * 33 + n;
        u32x2 o; o.x = pk4_fp8(s[0 * 33] * scale, s[1 * 33] * scale, s[2 * 33] * scale, s[3 * 33] * scale); o.y = pk4_fp8(s[4 * 33] * scale, s[5 * 33] * scale, s[6 * 33] * scale, s[7 * 33] * scale);
        *(u32x2*)(WT8 + (size_t)(ndst + n) * 1024 + k0 + 8 * c) = o; }
    LDS_WAIT(); asm volatile("" ::: "memory");
}

__device__ __forceinline__ void phase_prologue_a(const Params& P, LAS unsigned char* lds, int tid, int bid, int nb) {
    const int lane = tid & 63, wave = tid >> 6;
    unsigned char* ws = P.ws;
    for (int idx = bid * NTHREADS + tid; idx < T * 64; idx += nb * NTHREADS) { const int t = idx >> 6, f = idx & 63;
        const float pos = (f < 32) ? (float)(t >> 6) : (float)(t & 63); const float freq = expf(-(float)(f & 31) * (9.210340371976184f / 32.0f));
        float sn, cn; sincosf(pos * freq, &sn, &cn); ((float*)(ws + WS_ROPE))[idx] = cn; ((float*)(ws + WS_ROPE))[T * 64 + idx] = sn; }
    for (int idx = bid * NTHREADS + tid; idx < DEPTH * 32 * 1024; idx += nb * NTHREADS) { const int l = idx >> 15, e = (idx >> 10) & 31, k = idx & 1023;
        const float w = P.in[18][((size_t)l * 1024 + k) * 32 + e]; const unsigned hi = f2bf(w); const unsigned lo = f2bf(w - bf2f(hi));
        bf16* rwt = (bf16*)(ws + WS_RWT) + (size_t)l * 2 * 32 * 1024; rwt[e * 1024 + k] = (bf16)hi; rwt[32 * 1024 + e * 1024 + k] = (bf16)lo; }
    for (int u = bid; u < 4 * 48; u += nb) {
        const int l = u / 48, j0 = (u % 48) * 128;
        LAS float* sc = (LAS float*)lds;
        LAS float* red = (LAS float*)(lds + 9 * 1024 * 4);
        for (int idx = tid; idx < 9 * 1024; idx += NTHREADS) { const int r = idx >> 10, k = idx & 1023; const float c = (r < 8) ? P.in[1][r * 1024 + k] : P.in[3][k]; sc[idx] = silu_f(c); }
        __syncthreads();
        const int c = tid & 127, kq = tid >> 7;
        float acc[9];
#pragma unroll
        for (int r = 0; r < 9; ++r) acc[r] = 0.f;
        const float* w = P.in[4] + (size_t)l * 1024 * 6144 + j0 + c;
        for (int k = kq * 256; k < kq * 256 + 256; ++k) { const float wv = w[(size_t)k * 6144];
#pragma unroll
            for (int r = 0; r < 9; ++r) acc[r] += sc[r * 1024 + k] * wv; }
#pragma unroll
        for (int r = 0; r < 9; ++r) red[(kq * 9 + r) * 128 + c] = acc[r];
        __syncthreads();
        float* mods = (float*)(ws + WS_MODS);
        for (int idx = tid; idx < 9 * 128; idx += NTHREADS) { const int r = idx >> 7, cc = idx & 127;
            const float s = (red[(0 * 9 + r) * 128 + cc] + red[(1 * 9 + r) * 128 + cc]) + (red[(2 * 9 + r) * 128 + cc] + red[(3 * 9 + r) * 128 + cc]);
            mods[(size_t)(l * 9 + r) * 6144 + j0 + cc] = s + P.in[5][l * 6144 + j0 + cc]; }
        __syncthreads();
    }
    LAS float* scr = (LAS float*)(lds + wave * 16384);
    const int gw = bid * NWAVES + wave, NGW = nb * NWAVES;
    constexpr int I0 = 2 * 16 * 80, I1 = 2 * 16 * 32, I2 = 2 * 16 * 97, I3 = 2 * 16 * 32, I4 = 128 * 16 * 64, I5 = 128 * 16 * 32;
    constexpr int NITEMS = I0 + I1 + I2 + I3 + I4 + I5;
    for (int it = gw; it < NITEMS; it += NGW) {
        int r = it;
        if (r < I0) { const int mt = r / (16 * 80), q = r % (16 * 80), kb = q / 80, nbk = q % 80;
            conv_item8(P.in[8] + (size_t)mt * 1024 * AB_IN, AB_IN, kb * 64, nbk * 32, (unsigned char*)(ws + WS_WABIN) + (size_t)mt * AB_IN * 1024, nbk * 32, W1_SCALE, scr, lane); continue; } r -= I0;
        if (r < I1) { const int mt = r / (16 * 32), q = r % (16 * 32), kb = q / 32, nbk = q % 32;
            conv_item(P.in[12] + (size_t)mt * 1024 * 1024, 1024, kb * 64, nbk * 32, (bf16*)(ws + WS_WABOUT) + (size_t)mt * 1024 * 1024, nbk * 32, scr, lane); continue; } r -= I1;
        if (r < I2) { const int mt = r / (16 * 97), q = r % (16 * 97), kb = q / 97, nbk = q % 97;
            conv_item8(P.in[13] + (size_t)mt * 1024 * GLA_IN, GLA_IN, kb * 64, nbk * 32, (unsigned char*)(ws + WS_WGIN) + (size_t)mt * WGIN_STRIDE, nbk * 32, W1_SCALE, scr, lane); continue; } r -= I2;
        if (r < I3) { const int mt = r / (16 * 32), q = r % (16 * 32), kb = q / 32, nbk = q % 32;
            conv_item(P.in[17] + (size_t)mt * 1024 * 1024, 1024, kb * 64, nbk * 32, (bf16*)(ws + WS_WGOUT) + (size_t)mt * 1024 * 1024, nbk * 32, scr, lane); continue; } r -= I3;
        if (r < I4) { const int mt = r / (16 * 64), q = r % (16 * 64), kb = q / 64, rb = q % 64;
            const int tile = rb >> 3, half = (rb >> 2) & 1, qq = rb & 3; const int nsrc = half * 1024 + tile * 128 + qq * 32;
            conv_item8(P.in[20] + (size_t)mt * 1024 * 2048, 2048, kb * 64, nsrc, (unsigned char*)(ws + WS_W1T) + (size_t)mt * 2048 * 1024, rb * 32, W1_SCALE, scr, lane); continue; } r -= I4;
        { const int mt = r / (16 * 32), q = r % (16 * 32), kb = q / 32, nbk = q % 32;
            conv_item8(P.in[22] + (size_t)mt * 1024 * 1024, 1024, kb * 64, nbk * 32, (unsigned char*)(ws + WS_W2T) + (size_t)mt * 1024 * 1024, nbk * 32, W2_SCALE, scr, lane); }
    }
}

__device__ __forceinline__ void store_h_row(unsigned char* hrow, const f32x4 (&v)[4], const float* shift, const float* scale, int lane) {
#pragma unroll
    for (int j = 0; j < 4; ++j) { const int col = 4 * lane + 256 * j;
        const f32x4 sh = *(const f32x4*)(shift + col), sc = *(const f32x4*)(scale + col);
        *(unsigned*)(hrow + col) = pk4_fp8((v[j].x * (1.f + sc.x) + sh.x) * H8_SCALE, (v[j].y * (1.f + sc.y) + sh.y) * H8_SCALE, (v[j].z * (1.f + sc.z) + sh.z) * H8_SCALE, (v[j].w * (1.f + sc.w) + sh.w) * H8_SCALE); }
}

__device__ __forceinline__ void phase_prologue_b(const Params& P, int tid, int bid, int nb) {
    const int lane = tid & 63, wave = tid >> 6; unsigned char* ws = P.ws;
    const float* mods = (const float*)(ws + WS_MODS);
    for (int m = bid * NWAVES + wave; m < M; m += nb * NWAVES) {
        const float* src = (m < ML) ? P.in[0] + (size_t)m * D : P.in[2] + (size_t)(m - ML) * D;
        const int mb = (m < ML) ? (m >> 12) : 8;
        f32x4 v[4];
#pragma unroll
        for (int j = 0; j < 4; ++j) v[j] = *(const f32x4*)(src + 4 * lane + 256 * j);
        const float* md = mods + (size_t)(0 * 9 + mb) * 6144;
        store_h_row((unsigned char*)(ws + WS_H) + (size_t)m * D, v, md + 0, md + 1024, lane);
    }
}


namespace g8 {
constexpr int BM = 256, BK = 64, HALF = 128, HTB = HALF * BK * 2, STAGE_BYTES = 8 * HTB, NXCD = 8, WGM = 8, KDIM = 1024, NT = KDIM / BK;
__device__ __forceinline__ int lds_byte(int r, int c) { const int st = (r >> 4) * 2 + (c >> 5), rr = r & 15, cc = c & 31, ob = rr * 64 + cc * 2; return st * 1024 + (ob ^ (((ob >> 9) & 1) << 5)); }
__device__ __forceinline__ void stage_rc(int b, int& R, int& C) { const int st = b / 1024, sb = b % 1024, swz = sb ^ (((sb >> 9) & 1) << 5); R = (st >> 1) * 16 + swz / 64; C = (st & 1) * 32 + (swz % 64) / 2; }
template <bool FP8> __device__ __forceinline__ void stage_rcb(int b, int& R, int& CB) { const int st = b / 1024, sb = b % 1024, swz = sb ^ (((sb >> 9) & 1) << 5); R = (st >> 1) * 16 + swz / 64;
    CB = FP8 ? (2 * ((swz % 64) >> 4) + (st & 1)) * 16 : (st & 1) * 64 + (swz % 64); }
__device__ __forceinline__ int perm32(int rho) { const int n = rho >> 4, i = rho & 15; return 8 * (i >> 2) + 4 * n + (i & 3); }

struct Unit { int pm, pn, ui, e, nvalid; unsigned slot0; };
typedef int i32x8 __attribute__((ext_vector_type(8)));
typedef int i32x4 __attribute__((ext_vector_type(4)));
__device__ __forceinline__ i32x8 cat8(bf16x8 lo, bf16x8 hi) { const u32x4 a = __builtin_bit_cast(u32x4, lo), c = __builtin_bit_cast(u32x4, hi); return (i32x8){(int)a.x, (int)a.y, (int)a.z, (int)a.w, (int)c.x, (int)c.y, (int)c.z, (int)c.w}; }

template <class Prob, class Epi>
__device__ __forceinline__ void gemm_phase(LAS unsigned char* lds, const Prob& S, const Epi& E, int tid) {
    const int wid = __builtin_amdgcn_readfirstlane(tid >> 6), wr = wid >> 2, wc = wid & 3;
    constexpr int ROWB = Prob::FP8 ? KDIM : KDIM * 2;
    constexpr int NTK = Prob::FP8 ? NT / 2 : NT;
    unsigned voffB; { int R0, CB; stage_rcb<Prob::FP8>(tid * 16, R0, CB); const int Rb = Epi::PERM ? ((R0 & ~31) + perm32(R0 & 31)) : R0; voffB = (unsigned)(Rb * ROWB + CB); }
    constexpr size_t kstep = (size_t)(BK * 2);
    constexpr size_t hstep = (size_t)HALF * ROWB;
    constexpr size_t pstep = (size_t)64 * ROWB;
    const unsigned ldsw = (unsigned)wid * 1024u;
    int aoff, boff; { const int fr = tid & 15, fq = (tid >> 4) & 3; aoff = lds_byte(wr * 64 + fr, fq * 8); boff = lds_byte(wc * 32 + fr, fq * 8); }
#define PG8_SA(b, h) (((b) * 2 + (h)) * HTB)
#define PG8_SB(b, h) ((4 + (b) * 2 + (h)) * HTB)
#define PG8_GLDS2(sbase, voff, ldsoff) do { const char* _sb = (const char*)(sbase); asm volatile("" : "+s"(_sb)); unsigned _vo = (voff); asm volatile("" : "+v"(_vo)); __builtin_amdgcn_global_load_lds((const unsigned*)(_sb + _vo), (LAS unsigned*)(lds + (ldsoff)), 16, 0, 0); } while (0)
#define PG8_STAGE_B(bufoff, gbase) do { PG8_GLDS2((const char*)(gbase), voffB, (bufoff) + ldsw); PG8_GLDS2((const char*)(gbase) + pstep, voffB, (bufoff) + ldsw + 8192); } while (0)
#define PG8_STAGE_A(bufoff, gbase, h) do { if (Prob::GATHER) { PG8_GLDS2((const char*)(gbase), vA[h][0], (bufoff) + ldsw); PG8_GLDS2((const char*)(gbase), vA[h][1], (bufoff) + ldsw + 8192); } \
        else { PG8_GLDS2((const char*)(gbase) + (h) * hstep, vA[0][0], (bufoff) + ldsw); PG8_GLDS2((const char*)(gbase) + (h) * hstep + pstep, vA[0][0], (bufoff) + ldsw + 8192); } } while (0)
#define PG8_LDA(dst, b, h) do { _Pragma("unroll") for (int m = 0; m < 4; ++m) _Pragma("unroll") for (int k = 0; k < 2; ++k) dst[m][k] = *(const LAS bf16x8*)(lds + PG8_SA(b, h) + aoff + m * 2048 + k * 1024); } while (0)
#define PG8_LDB(dst, b, h) do { _Pragma("unroll") for (int n = 0; n < 2; ++n) _Pragma("unroll") for (int k = 0; k < 2; ++k) dst[n][k] = *(const LAS bf16x8*)(lds + PG8_SB(b, h) + boff + n * 2048 + k * 1024); } while (0)
#define PG8_MMA(ai, bj, At, Bt) do { __builtin_amdgcn_s_setprio(1); _Pragma("unroll") for (int m = 0; m < 4; ++m) _Pragma("unroll") for (int n = 0; n < 2; ++n) { \
        if constexpr (Prob::FP8) acc[ai][bj][m][n] = __builtin_amdgcn_mfma_scale_f32_16x16x128_f8f6f4(cat8(Bt[n][0], Bt[n][1]), cat8(At[m][0], At[m][1]), acc[ai][bj][m][n], 0, 0, 0, Prob::SCALE_B, 0, Prob::SCALE_A); \
        else { _Pragma("unroll") for (int k = 0; k < 2; ++k) acc[ai][bj][m][n] = __builtin_amdgcn_mfma_f32_16x16x32_bf16(Bt[n][k], At[m][k], acc[ai][bj][m][n], 0, 0, 0); } } __builtin_amdgcn_s_setprio(0); } while (0)
#define PG8_WAIT_V(n) asm volatile("s_waitcnt vmcnt(" #n ")" ::: "memory")
#define PG8_WAIT_L(n) asm volatile("s_waitcnt lgkmcnt(" #n ")" ::: "memory")
#define PG8_BAR __builtin_amdgcn_s_barrier()
#define PG8_SCHED __builtin_amdgcn_sched_barrier(0)
    Unit cur, nxt; int ui = 0;
    if (!S.next(0, cur)) return;
    f32x4 acc[2][2][4][2];
#pragma unroll
    for (int a = 0; a < 2; ++a)
#pragma unroll
        for (int b = 0; b < 2; ++b)
#pragma unroll
            for (int m = 0; m < 4; ++m)
#pragma unroll
                for (int n = 0; n < 2; ++n) acc[a][b][m][n] = (f32x4){0.f, 0.f, 0.f, 0.f};
    bf16x8 At[4][2], B0[2][2], B1[2][2];
    const char* cA = S.a_base(cur); const char* cB = S.b_base(cur);
    unsigned vA[2][2];
    S.a_voff(cur, tid, vA);
    PG8_STAGE_B(PG8_SB(0, 0), cB); PG8_STAGE_B(PG8_SB(0, 1), cB + hstep); PG8_STAGE_A(PG8_SA(0, 0), cA, 0); PG8_STAGE_A(PG8_SA(0, 1), cA, 1);
    if (wr == 1) PG8_BAR;
    PG8_WAIT_V(2); PG8_BAR;
    PG8_STAGE_B(PG8_SB(1, 0), cB + kstep); PG8_STAGE_A(PG8_SA(1, 0), cA + kstep, 0); PG8_STAGE_B(PG8_SB(1, 1), cB + hstep + kstep);
    PG8_WAIT_V(6); PG8_BAR;
    for (;;) {
        const bool has_next = S.next(ui + 1, nxt);
        const char* nA = cA; const char* nB = cB;
        unsigned vN[2];
        if (has_next) { nA = S.a_base(nxt); nB = S.b_base(nxt); if (Prob::GATHER) S.a_tok(nxt, tid, vN); }
#pragma unroll 1
        for (int t = 0; t < NTK; t += 2) {
            const bool last = (t == NTK - 2);
            const char* a1 = cA + (size_t)(t + 1) * kstep;
            const char* a2 = last ? nA : cA + (size_t)(t + 2) * kstep; const char* b2 = last ? nB : cB + (size_t)(t + 2) * kstep;
            const char* a3 = a2 + kstep; const char* b3 = b2 + kstep;
            PG8_LDB(B0, 0, 0); PG8_LDB(B1, 0, 1); PG8_SCHED; PG8_LDA(At, 0, 0); PG8_STAGE_A(PG8_SA(1, 1), a1, 1);
            PG8_WAIT_V(8); PG8_WAIT_L(0); PG8_BAR; PG8_MMA(0, 0, At, B0); PG8_MMA(0, 1, At, B1); PG8_BAR; PG8_SCHED;
            if (Prob::GATHER) { if (last && has_next) { int R0, CB; stage_rcb<Prob::FP8>(tid * 16, R0, CB); const unsigned c2 = (unsigned)CB; constexpr int SH = Prob::FP8 ? 10 : 11; vA[0][0] = ((vN[0] & 0xffffu) << SH) | c2; vA[0][1] = ((vN[0] >> 16) << SH) | c2; vA[1][0] = ((vN[1] & 0xffffu) << SH) | c2; vA[1][1] = ((vN[1] >> 16) << SH) | c2; } }
            PG8_LDA(At, 0, 1); PG8_STAGE_B(PG8_SB(0, 0), b2); PG8_STAGE_B(PG8_SB(0, 1), b2 + hstep); PG8_STAGE_A(PG8_SA(0, 0), a2, 0);
            PG8_WAIT_V(8); PG8_WAIT_L(0); PG8_BAR; PG8_MMA(1, 0, At, B0); PG8_MMA(1, 1, At, B1); PG8_BAR; PG8_SCHED;
            PG8_LDB(B0, 1, 0); PG8_LDB(B1, 1, 1); PG8_SCHED; PG8_LDA(At, 1, 0); PG8_STAGE_A(PG8_SA(0, 1), a2, 1);
            PG8_WAIT_V(8); PG8_WAIT_L(0); PG8_BAR; PG8_MMA(0, 0, At, B0); PG8_MMA(0, 1, At, B1); PG8_BAR; PG8_SCHED;
            PG8_LDA(At, 1, 1); PG8_STAGE_B(PG8_SB(1, 0), b3); PG8_STAGE_B(PG8_SB(1, 1), b3 + hstep); PG8_STAGE_A(PG8_SA(1, 0), a3, 0);
            PG8_WAIT_V(8); PG8_WAIT_L(0); PG8_BAR; PG8_MMA(1, 0, At, B0); PG8_MMA(1, 1, At, B1); PG8_BAR; PG8_SCHED;
        }
        if (wr == 0) PG8_BAR;
        { int t_e = tid; asm volatile("" : "+v"(t_e)); int fr_e = t_e & 15, fq_e = (t_e >> 4) & 3;
          E(acc, cur, wr, wc, fr_e, fq_e); }
        if (!has_next) break;
#pragma unroll
        for (int a = 0; a < 2; ++a)
#pragma unroll
            for (int b = 0; b < 2; ++b)
#pragma unroll
                for (int m = 0; m < 4; ++m)
#pragma unroll
                    for (int n = 0; n < 2; ++n) acc[a][b][m][n] = (f32x4){0.f, 0.f, 0.f, 0.f};
        cur = nxt; cA = nA; cB = nB; ++ui;
        if (wr == 1) PG8_BAR;
    }
    PG8_WAIT_V(0);
    PG8_BAR;
#undef PG8_SA
#undef PG8_SB
#undef PG8_GLDS2
#undef PG8_STAGE_A
#undef PG8_STAGE_B
#undef PG8_LDA
#undef PG8_LDB
#undef PG8_MMA
#undef PG8_WAIT_V
#undef PG8_WAIT_L
#undef PG8_BAR
#undef PG8_SCHED
}

template <bool F8>
struct DenseProb {
    const void* A; const void* Bt; int nM, nN, nwg, G, c;
    __device__ __forceinline__ void init(const void* A_, const void* Bt_, int Mrows, int Npad, int G_, int c_) { A = A_; Bt = Bt_; nM = Mrows / BM; nN = Npad / BM; nwg = nM * nN; G = G_; c = c_; }
    __device__ __forceinline__ bool next(int i, Unit& u) const {
        const long L = (long)i * G + c; if (L >= nwg) return false;
        int wgid = (int)L; { const int q = nwg / NXCD, r = nwg % NXCD, xcd = wgid % NXCD, off = wgid / NXCD; wgid = (xcd < r ? xcd * (q + 1) : r * (q + 1) + (xcd - r) * q) + off; }
        const int nig = WGM * nN, gid = wgid / nig, fm = gid * WGM, gsz = (nM - fm) < WGM ? (nM - fm) : WGM;
        u.pm = fm + ((wgid % nig) % gsz); u.pn = (wgid % nig) / gsz; u.ui = i; u.e = 0; u.nvalid = 256; u.slot0 = 0; return true;
    }
    static constexpr int RB_ = F8 ? KDIM : KDIM * 2;
    __device__ __forceinline__ const char* a_base(const Unit& u) const { return (const char*)A + (size_t)u.pm * BM * RB_; }
    __device__ __forceinline__ const char* b_base(const Unit& u) const { return (const char*)Bt + (size_t)u.pn * BM * RB_; }
    static constexpr bool GATHER = false, FP8 = F8; static constexpr int SCALE_A = H8_E8, SCALE_B = W1_E8;
    __device__ __forceinline__ void a_voff(const Unit&, int tid, unsigned (&v)[2][2]) const { int R0, CB; stage_rcb<F8>(tid * 16, R0, CB); v[0][0] = (unsigned)(R0 * RB_ + CB); }
    __device__ __forceinline__ void a_tok(const Unit&, int, unsigned (&)[2]) const {}
};

constexpr int MOE_IDX = STAGE_BYTES;
constexpr int MOE_MAXU = 40;
constexpr int MOE_TAB = MOE_IDX + MOE_MAXU * 512;
constexpr int TB_XN = 130, TB_XE = 138, TB_XUP = 394;
constexpr int MOE_UT = MOE_TAB + 2688;
template <int WHICH>
struct MoeProb {
    const unsigned char* A; const unsigned char* Wt; LAS unsigned char* lds; int nunits, G, c, xy; int same;
    static constexpr int nN = (WHICH == 1) ? 8 : 4;
    static constexpr bool FP8 = true; static constexpr int SCALE_A = (WHICH == 1) ? H8_E8 : ACT8_E8, SCALE_B = (WHICH == 1) ? W1_E8 : W2_E8;
    __device__ __forceinline__ void fill_units(int tid) const {
        if (tid < MOE_MAXU) { const LAS int* tab = (const LAS int*)(lds + MOE_TAB); int L = tid * G + c;
            if (xy >= 0) { const int x = xy & 7, y = xy >> 3, q = nunits >> 3, rr = nunits & 7, len = q + (x < rr ? 1 : 0), li = tid * (G >> 3) + y; L = (li < len) ? x * q + min(x, rr) + li : nunits; }
            i32x4 r = {-1, 0, 0, 0};
            if (L < nunits) { const int tt = L / nN, pn = L % nN; int e = 0;
                for (int q = 1; q < 32; ++q) e = (tab[32 + q] <= tt) ? q : e;
                const int tl = tt - tab[32 + e], cnt = tab[e];
                r = (i32x4){e | (pn << 8), tl, min(cnt - tl * 256, 256), tab[96 + e] + tl * 256}; }
            ((LAS i32x4*)(lds + MOE_UT))[tid] = r; }
    }
    __device__ __forceinline__ bool next(int i, Unit& u) const {
        if (i >= MOE_MAXU) return false;
        const i32x4 r = ((const LAS i32x4*)(lds + MOE_UT))[i];
        const int w0 = __builtin_amdgcn_readfirstlane(r.x); if (w0 < 0) return false;
        u.e = w0 & 255; u.pn = w0 >> 8; u.ui = i; u.pm = __builtin_amdgcn_readfirstlane(r.y); u.nvalid = __builtin_amdgcn_readfirstlane(r.z); u.slot0 = (unsigned)__builtin_amdgcn_readfirstlane(r.w); return true;
    }
    __device__ __forceinline__ const char* a_base(const Unit& u) const { return (WHICH == 1) ? (const char*)A : (const char*)A + (size_t)u.slot0 * KDIM; }
    __device__ __forceinline__ const char* b_base(const Unit& u) const { return same ? (const char*)Wt : (const char*)Wt + ((size_t)u.e * (nN * 256) + (size_t)u.pn * 256) * KDIM; }
    static constexpr bool GATHER = (WHICH == 1);
    __device__ __forceinline__ void a_voff(const Unit& u, int tid, unsigned (&v)[2][2]) const {
        int R0, CB; stage_rcb<true>(tid * 16, R0, CB);
        if (WHICH == 1) { const LAS unsigned short* idx = (const LAS unsigned short*)(lds + MOE_IDX) + u.ui * 256;
#pragma unroll
            for (int h = 0; h < 2; ++h)
#pragma unroll
                for (int i = 0; i < 2; ++i) v[h][i] = (unsigned)(idx[h * HALF + i * 64 + R0] * KDIM + CB);
        } else v[0][0] = (unsigned)(R0 * KDIM + CB);
    }
    __device__ __forceinline__ void a_tok(const Unit& u, int tid, unsigned (&v)[2]) const {
        if (WHICH == 1) { int R0, CB; stage_rcb<true>(tid * 16, R0, CB); const LAS unsigned short* idx = (const LAS unsigned short*)(lds + MOE_IDX) + u.ui * 256;
            v[0] = (unsigned)idx[R0] | ((unsigned)idx[64 + R0] << 16); v[1] = (unsigned)idx[HALF + R0] | ((unsigned)idx[HALF + 64 + R0] << 16); }
    }
};

struct EpiP {
    static constexpr bool PERM = true;
    bf16* out; int ncols; bf16* vt;
    __device__ __forceinline__ void operator()(const f32x4 (&acc)[2][2][4][2], const Unit& u, int wr, int wc, int fr, int fq) const {
        if (vt != nullptr && ncols == GLA_IN && u.pn >= 4 && u.pn < 8) {
            const int row0 = u.pm * BM;
#pragma unroll
            for (int bj = 0; bj < 2; ++bj) { const int e0 = u.pn * BM + bj * HALF + wc * 32 + 8 * fq - 1024;
#pragma unroll
                for (int ai = 0; ai < 2; ++ai)
#pragma unroll
                    for (int m = 0; m < 4; ++m) { const int rl = ai * HALF + wr * 64 + m * 16 + fr; const int c = (row0 + rl) >> 6, i = rl & 63;
                        bf16* p = vt + ((size_t)c * 1024 + e0) * 72 + i;
#pragma unroll
                        for (int n = 0; n < 2; ++n) { const unsigned w0 = pk2(acc[ai][bj][m][n][0], acc[ai][bj][m][n][1]), w1 = pk2(acc[ai][bj][m][n][2], acc[ai][bj][m][n][3]);
                            p[(4 * n + 0) * 72] = (bf16)(w0 & 0xffffu); p[(4 * n + 1) * 72] = (bf16)(w0 >> 16); p[(4 * n + 2) * 72] = (bf16)(w1 & 0xffffu); p[(4 * n + 3) * 72] = (bf16)(w1 >> 16); } } }
            return;
        }
        if (vt != nullptr && ncols == AB_IN && u.pn >= 7) {
            const int row0 = u.pm * BM;
            bf16* base; int tl, tok0;
            if (row0 < ML) { base = vt + (size_t)(row0 >> 12) * 12 * 64 * T; tl = T; tok0 = row0 & (T - 1); }
            else { base = vt + (size_t)(WS_VTC - WS_VT) / 2 + (size_t)((row0 - ML) >> 8) * 12 * 64 * NCTX; tl = NCTX; tok0 = 0; }
#pragma unroll
            for (int bj = 0; bj < 2; ++bj) { const int c = u.pn * BM + bj * HALF + wc * 32 + 8 * fq - 1792;
                bf16* cb = base + (size_t)c * tl + tok0 + wr * 64 + fr;
#pragma unroll
                for (int ai = 0; ai < 2; ++ai)
#pragma unroll
                    for (int m = 0; m < 4; ++m) { bf16* p = cb + ai * HALF + m * 16;
#pragma unroll
                        for (int n = 0; n < 2; ++n) { const unsigned w0 = pk2(acc[ai][bj][m][n][0], acc[ai][bj][m][n][1]), w1 = pk2(acc[ai][bj][m][n][2], acc[ai][bj][m][n][3]);
                            p[(size_t)(4 * n + 0) * tl] = (bf16)(w0 & 0xffffu); p[(size_t)(4 * n + 1) * tl] = (bf16)(w0 >> 16); p[(size_t)(4 * n + 2) * tl] = (bf16)(w1 & 0xffffu); p[(size_t)(4 * n + 3) * tl] = (bf16)(w1 >> 16); } } }
            return;
        }
#pragma unroll
        for (int ai = 0; ai < 2; ++ai)
#pragma unroll
            for (int m = 0; m < 4; ++m) { const size_t row = (size_t)u.pm * BM + ai * HALF + wr * 64 + m * 16 + fr;
#pragma unroll
                for (int bj = 0; bj < 2; ++bj) { const int col = u.pn * BM + bj * HALF + wc * 32 + 8 * fq;
                    if (col < ncols) { const f32x4 v0 = acc[ai][bj][m][0], v1 = acc[ai][bj][m][1];
                        u32x4 w; w.x = pk2(v0[0], v0[1]); w.y = pk2(v0[2], v0[3]); w.z = pk2(v1[0], v1[1]); w.w = pk2(v1[2], v1[3]);
                        *(u32x4*)(out + row * ncols + col) = w; } } }
    }
};
struct EpiResid {
    static constexpr bool PERM = false;
    float* X; const float* gate_base;
    __device__ __forceinline__ void operator()(const f32x4 (&acc)[2][2][4][2], const Unit& u, int wr, int wc, int fr, int fq) const {
#pragma unroll
        for (int ai = 0; ai < 2; ++ai)
#pragma unroll
            for (int m = 0; m < 4; ++m) { const size_t row = (size_t)u.pm * BM + ai * HALF + wr * 64 + m * 16 + fr; const int mb = (row < (size_t)ML) ? (int)(row >> 12) : 8;
#pragma unroll
                for (int bj = 0; bj < 2; ++bj)
#pragma unroll
                    for (int n = 0; n < 2; ++n) { const int col = u.pn * BM + bj * HALF + wc * 32 + n * 16 + 4 * fq;
                        const f32x4 g = *(const f32x4*)(gate_base + (size_t)mb * 6144 + col); float* xp = X + row * D + col; const f32x4 x = *(const f32x4*)xp;
                        *(f32x4*)xp = x * DN_ALPHA + g * acc[ai][bj][m][n]; } }
    }
};
struct EpiSwiglu {
    static constexpr bool PERM = true;
    unsigned char* act; const float* b1_base; int dbg;
    __device__ __forceinline__ void operator()(const f32x4 (&acc)[2][2][4][2], const Unit& u, int wr, int wc, int fr, int fq) const {
        if (dbg & 2) return;
        const float* b1 = b1_base + (size_t)u.e * 2048; const int gcol = u.pn * HALF + wc * 32 + 8 * fq;
        f32x4 bg[2], bl[2];
#pragma unroll
        for (int n = 0; n < 2; ++n) { if (dbg & 8) { bg[n] = (f32x4){0.f, 0.f, 0.f, 0.f}; bl[n] = bg[n]; } else { bg[n] = *(const f32x4*)(b1 + gcol + 4 * n); bl[n] = *(const f32x4*)(b1 + 1024 + gcol + 4 * n); } }
        __builtin_amdgcn_s_waitcnt(0x0F70);
#pragma unroll
        for (int ai = 0; ai < 2; ++ai)
#pragma unroll
            for (int m = 0; m < 4; ++m) { const int rl = ai * HALF + wr * 64 + m * 16 + fr;
                if (rl < u.nvalid) { float o[8];
#pragma unroll
                    for (int n = 0; n < 2; ++n)
#pragma unroll
                        for (int jp = 0; jp < 2; ++jp) {
                            f32x2 g = (f32x2){acc[ai][0][m][n][2 * jp], acc[ai][0][m][n][2 * jp + 1]} + (f32x2){bg[n][2 * jp], bg[n][2 * jp + 1]};
                            f32x2 l = (f32x2){acc[ai][1][m][n][2 * jp], acc[ai][1][m][n][2 * jp + 1]} + (f32x2){bl[n][2 * jp], bl[n][2 * jp + 1]};
                            if (dbg & 1) { o[4 * n + 2 * jp] = g.x + l.x; o[4 * n + 2 * jp + 1] = g.y + l.y; } else {
                                g.x = fminf(g.x, 7.0f); g.y = fminf(g.y, 7.0f); l.x = fminf(fmaxf(l.x, -7.0f), 7.0f); l.y = fminf(fmaxf(l.y, -7.0f), 7.0f);
                                const f32x2 t = g * (f32x2){-1.702f * 1.44269504f, -1.702f * 1.44269504f};
                                const f32x2 a = (f32x2){__builtin_amdgcn_exp2f(t.x), __builtin_amdgcn_exp2f(t.y)} + (f32x2){1.f, 1.f};
                                const f32x2 sg = g * (f32x2){__builtin_amdgcn_rcpf(a.x), __builtin_amdgcn_rcpf(a.y)};
                                const f32x2 ov = sg * (l * (f32x2){ACT8_SCALE, ACT8_SCALE} + (f32x2){ACT8_SCALE, ACT8_SCALE});
                                o[4 * n + 2 * jp] = ov.x; o[4 * n + 2 * jp + 1] = ov.y; } }
                    u32x2 w; w.x = pk4_fp8_nc(o[0], o[1], o[2], o[3]); w.y = pk4_fp8_nc(o[4], o[5], o[6], o[7]);
                    if (!(dbg & 4) || w.x == 0x12345u) *(u32x2*)(act + ((size_t)u.slot0 + rl) * 1024 + gcol) = w; }
                __builtin_amdgcn_sched_barrier(0); }
    }
};
struct EpiYs {
    static constexpr bool PERM = true;
    bf16* ys; const float* b2_base;
    __device__ __forceinline__ void operator()(const f32x4 (&acc)[2][2][4][2], const Unit& u, int wr, int wc, int fr, int fq) const {
        const float* b2 = b2_base + (size_t)u.e * 1024;
        f32x4 bb[2][2];
#pragma unroll
        for (int bj = 0; bj < 2; ++bj)
#pragma unroll
            for (int n = 0; n < 2; ++n) bb[bj][n] = *(const f32x4*)(b2 + u.pn * BM + bj * HALF + wc * 32 + 8 * fq + 4 * n);
        __builtin_amdgcn_s_waitcnt(0x0F70);
#pragma unroll
        for (int ai = 0; ai < 2; ++ai)
#pragma unroll
            for (int m = 0; m < 4; ++m) { const int rl = ai * HALF + wr * 64 + m * 16 + fr;
                if (rl < u.nvalid) {
#pragma unroll
                    for (int bj = 0; bj < 2; ++bj) { const int col = u.pn * BM + bj * HALF + wc * 32 + 8 * fq;
                        const f32x4 v0 = acc[ai][bj][m][0] + bb[bj][0], v1 = acc[ai][bj][m][1] + bb[bj][1];
                        u32x4 w; w.x = pk2(v0[0], v0[1]); w.y = pk2(v0[2], v0[3]); w.z = pk2(v1[0], v1[1]); w.w = pk2(v1[2], v1[3]);
                        *(u32x4*)(ys + ((size_t)u.slot0 + rl) * 1024 + col) = w; } } }
    }
};
}

template <int KIND>
__device__ __forceinline__ void phase_gemm_dense(const Params& P, LAS unsigned char* lds, int tid, int bid, int nb, const void* A, const void* Wt, int Mrows, int N, int layer) {
    unsigned char* ws = P.ws;
    if (KIND == 0) { g8::DenseProb<true> S; S.init(A, Wt, Mrows, (N + 255) & ~255, nb, bid);
        g8::EpiP e{(bf16*)(ws + WS_P), N, (N == AB_IN) ? (bf16*)(ws + WS_VT) : (bf16*)(ws + WS_GVT)}; g8::gemm_phase(lds, S, e, tid); }
    else { g8::DenseProb<false> S; S.init(A, Wt, Mrows, (N + 255) & ~255, nb, bid);
        g8::EpiP e{(bf16*)(ws + WS_P), 1024, (bf16*)nullptr}; g8::gemm_phase(lds, S, e, tid); }
}

template <int NN>
__device__ __forceinline__ void moe_tables(const Params& P, LAS unsigned char* lds, int tid, int layer) {
    LAS int* tab = (LAS int*)(lds + g8::MOE_TAB);
    __syncthreads();
    if (tid < 32) tab[tid] = (int)__hip_atomic_load((const unsigned*)(P.ws + WS_CTL) + CW_CNT + layer * 32 + tid, __ATOMIC_RELAXED, __HIP_MEMORY_SCOPE_AGENT);
    __syncthreads();
    if (tid == 0) { int tp = 0, rb = 0;
        for (int e = 0; e < 32; ++e) { const int c = tab[e]; tab[32 + e] = tp; tab[96 + e] = rb; tp += (c + 255) >> 8; rb += c; }
        tab[32 + 32] = tp; tab[96 + 32] = rb;
        if (NN > 0) {
            int load[8]; unsigned taken = 0u;
            for (int x = 0; x < 8; ++x) { load[x] = 0; tab[g8::TB_XN + x] = 0; tab[g8::TB_XUP + x * 33] = 0; }
            for (int it = 0; it < 32; ++it) { int be = -1, bt = -1;
                for (int e = 0; e < 32; ++e) { const int t = (tab[e] + 255) >> 8; if (!((taken >> e) & 1u) && t > bt) { bt = t; be = e; } }
                taken |= 1u << be;
                int bx = 0; for (int x = 1; x < 8; ++x) if (load[x] < load[bx]) bx = x;
                const int n = tab[g8::TB_XN + bx]; tab[g8::TB_XE + bx * 32 + n] = be; tab[g8::TB_XUP + bx * 33 + n + 1] = tab[g8::TB_XUP + bx * 33 + n] + bt * NN; tab[g8::TB_XN + bx] = n + 1; load[bx] += bt; } } }
    __syncthreads();
}
template <int WHICH>
__device__ __forceinline__ void phase_moe_gemm(const Params& P, LAS unsigned char* lds, int tid, int bid, int nb, int layer, int dbg = 0) {
    unsigned char* ws = P.ws;
    moe_tables<0>(P, lds, tid, layer);
    const LAS int* tab = (const LAS int*)(lds + g8::MOE_TAB);
    g8::MoeProb<WHICH> S; S.lds = lds; S.G = nb; S.c = bid; S.xy = ((nb & 7) == 0) ? bid : -1;        S.same = (dbg & 16) ? 1 : 0; S.nunits = __builtin_amdgcn_readfirstlane(tab[64]) * g8::MoeProb<WHICH>::nN;
    S.fill_units(tid); __syncthreads();
    if (WHICH == 1) {
        S.A = (const unsigned char*)(ws + WS_H8); S.Wt = (const unsigned char*)(ws + WS_W1T) + (size_t)layer * 32 * 2048 * 1024;
        const int* list = (const int*)(ws + WS_LIST); LAS unsigned short* idx = (LAS unsigned short*)(lds + g8::MOE_IDX);
        { const LAS g8::i32x4* ut = (const LAS g8::i32x4*)(lds + g8::MOE_UT);
#pragma unroll 4
          for (int ent = tid; ent < g8::MOE_MAXU * 256; ent += NTHREADS) { const int i = ent >> 8, r = ent & 255; const g8::i32x4 q = ut[i];
              if (q.x >= 0) idx[ent] = (unsigned short)((r < q.z) ? list[(size_t)(q.x & 255) * M + q.y * 256 + r] : 0); } }
        __syncthreads();
        g8::EpiSwiglu e{(unsigned char*)(ws + WS_ACT), P.in[21] + (size_t)layer * 32 * 2048, dbg};
        g8::gemm_phase(lds, S, e, tid);
    } else {
        S.A = (const unsigned char*)(ws + WS_ACT); S.Wt = (const unsigned char*)(ws + WS_W2T) + (size_t)layer * 32 * 1024 * 1024;
        g8::EpiYs e{(bf16*)(ws + WS_YS), P.in[23] + (size_t)layer * 32 * 1024};
        g8::gemm_phase(lds, S, e, tid);
    }
}

constexpr int NA_RPB_OFF = 102400;
constexpr int NA_KC_OFF = 0, NA_VC_OFF = 32768, NA_VC_PITCH = 544, NA_KW_OFF = 67584, NA_KW_PITCH = 144, NA_KW_ROW = 64 * 144, NA_RPB2 = NA_KW_OFF + 9 * NA_KW_ROW;
template <bool ISCTX, bool CTXLDS>
__device__ __forceinline__ void na_wave_unit(const Params& P, LAS unsigned char* lds, int v, int lane) {
    const bf16* PB = (const bf16*)(P.ws + WS_P);
    bf16* A2 = (bf16*)(P.ws + WS_A2);
    const int fr = lane & 15, fq = lane >> 4;
    int b, h, r = 0, jb = 0; size_t mq0;
    if (!ISCTX) { jb = v & 3; r = (v >> 2) & 63; h = (v >> 8) % 12; b = v / (256 * 12); mq0 = (size_t)b * T + r * 64 + jb * 16; }
    else { const int qb = v & 15; h = (v >> 4) % 12; b = v / (16 * 12); mq0 = (size_t)ML + b * NCTX + qb * 16; }
    const int row_start = min(max(r - 4, 0), 56);
    const int band_start = min(max(jb * 16 - 8, 0), 32);
    const int kap = 8 * (fr >> 2) + (fr & 3);
    const bf16* kwin = PB + ((size_t)b * T + (size_t)row_start * 64 + band_start + kap) * AB_IN + 1024 + h * 64 + fq * 8;
    const bf16* kctx = PB + ((size_t)ML + (size_t)b * NCTX + kap) * AB_IN + 1024 + h * 64 + fq * 8;
    const bf16* vtl = (const bf16*)(P.ws + WS_VT) + ((size_t)(b * 12 + h) * 64 + fr) * T + (size_t)row_start * 64 + band_start + 8 * fq;
    const bf16* vtc = (const bf16*)(P.ws + WS_VTC) + ((size_t)(b * 12 + h) * 64 + fr) * NCTX + 8 * fq;
    const bf16* qp = PB + (mq0 + fr) * AB_IN + 256 + h * 64 + fq * 8;
    const bf16x8 qf0 = *(const bf16x8*)qp, qf1 = *(const bf16x8*)(qp + 32);
    const f32x4 zero4 = {0.f, 0.f, 0.f, 0.f};
    const LAS float* rpb = CTXLDS ? (const LAS float*)(lds + NA_RPB2) : (const LAS float*)(lds + NA_RPB_OFF) + h * 15 * 31;
    const int qcol = jb * 16 + fr, wstart = min(max(qcol - 8, 0), 48);
    constexpr int C0 = ISCTX ? 4 : 0;
    bf16x8 kf[4][2], vf[2][4];
#define NA_LOAD_KV(c) do { _Pragma("unroll") for (int s_ = 0; s_ < 2; ++s_) { _Pragma("unroll") for (int hh = 0; hh < 2; ++hh) { \
        if (CTXLDS && (c) >= 4) { const int key_ = (2 * ((c) - 4) + s_) * 32 + 4 * hh + kap; const LAS unsigned char* kl_ = lds + NA_KC_OFF + key_ * 128; \
            kf[2 * s_ + hh][0] = *(const LAS bf16x8*)(kl_ + ((fq ^ (key_ & 7)) << 4)); kf[2 * s_ + hh][1] = *(const LAS bf16x8*)(kl_ + (((4 + fq) ^ (key_ & 7)) << 4)); } \
        else if (CTXLDS) { const LAS unsigned char* kl_ = lds + NA_KW_OFF + ((row_start + 2 * (c) + s_) % 9) * NA_KW_ROW + (band_start + 4 * hh + kap) * NA_KW_PITCH + fq * 16; \
            kf[2 * s_ + hh][0] = *(const LAS bf16x8*)kl_; kf[2 * s_ + hh][1] = *(const LAS bf16x8*)(kl_ + 64); } \
        else { const bf16* kp_ = ((c) < 4) ? kwin + (size_t)((2 * (c) + s_) * 64 + 4 * hh) * AB_IN : kctx + (size_t)((2 * ((c) - 4) + s_) * 32 + 4 * hh) * AB_IN; \
            kf[2 * s_ + hh][0] = *(const bf16x8*)kp_; kf[2 * s_ + hh][1] = *(const bf16x8*)(kp_ + 32); } } \
        _Pragma("unroll") for (int dt = 0; dt < 4; ++dt) { \
            if (CTXLDS && (c) >= 4) vf[s_][dt] = *(const LAS bf16x8*)(lds + NA_VC_OFF + (dt * 16 + fr) * NA_VC_PITCH + ((2 * ((c) - 4) + s_) * 32 + 8 * fq) * 2); \
            else vf[s_][dt] = ((c) < 4) ? *(const bf16x8*)(vtl + (size_t)(dt * 16) * T + (2 * (c) + s_) * 64) : *(const bf16x8*)(vtc + (size_t)(dt * 16) * NCTX + (2 * ((c) - 4) + s_) * 32); } } } while (0)
    float mrun = -3.0e38f, lrun = 0.f;
    f32x4 o[4];
#pragma unroll
    for (int dt = 0; dt < 4; ++dt) o[dt] = zero4;
#pragma unroll
    for (int c = C0; c < 8; ++c) {
        NA_LOAD_KV(c);
        f32x4 s[4];
#pragma unroll
        for (int t = 0; t < 4; ++t) { f32x4 a = mfma16(kf[t][0], qf0, zero4); s[t] = mfma16(kf[t][1], qf1, a); }
        float mx = mrun;
        if (c < 4) {
#pragma unroll
            for (int t = 0; t < 4; ++t) { const int kr = 2 * c + (t >> 1), hh = t & 1; const int drow = row_start + kr - r + 7;
#pragma unroll
                for (int i = 0; i < 4; ++i) { const int kcol = band_start + 8 * fq + 4 * hh + i; const bool ok = (kcol >= wstart) && (kcol < wstart + 16);
                    const int dcol = min(max(kcol - qcol + 15, 0), 30);
                    const float lg = ok ? (s[t][i] * (0.125f * 1.44269504f) + rpb[drow * 31 + dcol]) : -1.0e30f; s[t][i] = lg; mx = fmaxf(mx, lg); } }
        } else {
#pragma unroll
            for (int t = 0; t < 4; ++t)
#pragma unroll
                for (int i = 0; i < 4; ++i) { const float lg = s[t][i] * (0.125f * 1.44269504f); s[t][i] = lg; mx = fmaxf(mx, lg); }
        }
        mx = xmax_16_32(mx);
        const float corr = __builtin_amdgcn_exp2f(mrun - mx); mrun = mx;
        float sum = 0.f;
#pragma unroll
        for (int t = 0; t < 4; ++t)
#pragma unroll
            for (int i = 0; i < 4; ++i) { const float p = __builtin_amdgcn_exp2f(s[t][i] - mx); s[t][i] = p; sum += p; }
        sum = xsum_16_32(sum);
        lrun = lrun * corr + sum;
#pragma unroll
        for (int dt = 0; dt < 4; ++dt) o[dt] = o[dt] * corr;
#pragma unroll
        for (int s_ = 0; s_ < 2; ++s_) { const int ta = 2 * s_, tb = 2 * s_ + 1;
            const bf16x8 pf = mk_frag(pk2(s[ta][0], s[ta][1]), pk2(s[ta][2], s[ta][3]), pk2(s[tb][0], s[tb][1]), pk2(s[tb][2], s[tb][3]));
#pragma unroll
            for (int dt = 0; dt < 4; ++dt) o[dt] = mfma16(vf[s_][dt], pf, o[dt]); }
    }
#undef NA_LOAD_KV
    const float inv = 1.0f / lrun;
#pragma unroll
    for (int dt = 0; dt < 4; ++dt) { u32x2 w; w.x = pk2(o[dt].x * inv, o[dt].y * inv); w.y = pk2(o[dt].z * inv, o[dt].w * inv);
        *(u32x2*)(A2 + (mq0 + fr) * D + 256 + h * 64 + dt * 16 + 4 * fq) = w; }
}

template <int W>
__device__ __forceinline__ void pool_thread(const LAS bf16* U, LAS bf16* pooled, int t0, int TL, int h, int ch) {
    constexpr int HW = W / 2, NR = 16 + W - 1;
    const int tb = t0 + 16 * h - HW, rr0 = 16 * h + 8 - HW;
    float pf[NR + 1]; pf[0] = 0.f;
#pragma unroll
    for (int i = 0; i < NR; ++i) { const int t = tb + i; const float v = bf2f(U[(rr0 + i) * 256 + ch]); pf[i + 1] = pf[i] + ((t >= 0 && t < TL) ? v : 0.f); }
#pragma unroll
    for (int k = 0; k < 16; ++k) { const int t = t0 + 16 * h + k; const int cnt = min(t - HW + W, TL) - max(t - HW, 0);
        const float ctr = bf2f(U[(16 * h + 8 + k) * 256 + ch]);
        pooled[(16 * h + k) * 272 + ch] = (bf16)f2bf((pf[k + W] - pf[k]) / (float)cnt - ctr); }
}
__device__ __forceinline__ void pool_units(const Params& P, LAS unsigned char* lds, int j_even, int tid, int bid, int nb) {
    const bf16* PB = (const bf16*)(P.ws + WS_P);
    bf16* A2 = (bf16*)(P.ws + WS_A2);
    const int lane = tid & 63, wave = tid >> 6, fr = lane & 15, fq = lane >> 4;
    LAS bf16* pwT = (LAS bf16*)lds;
    LAS bf16* pooled = (LAS bf16*)(lds + 36864);
    LAS bf16* U = (LAS bf16*)(lds + 128000);
    for (int idx = tid; idx < 4 * 64 * 64; idx += NTHREADS) { const int g = idx >> 12, d = (idx >> 6) & 63, e = idx & 63;
        pwT[(g * 64 + e) * 72 + d] = (bf16)f2bf(P.in[9][(size_t)j_even * 4 * 64 * 64 + idx]); }
    f32x4 psc[4];
#pragma unroll
    for (int et = 0; et < 4; ++et) psc[et] = *(const f32x4*)(P.in[10] + j_even * 256 + (wave >> 1) * 64 + et * 16 + 4 * fq);
    for (int u = bid; u < 1088; u += nb) {
        size_t seq0; int t0, TL;
        if (u < 1024) { const int b = u >> 7; t0 = (u & 127) * 32; seq0 = (size_t)b * T; TL = T; }
        else { const int q = u - 1024; const int b = q >> 3; t0 = (q & 7) * 32; seq0 = (size_t)ML + (size_t)b * NCTX; TL = NCTX; }
        __syncthreads();
        for (int c = tid; c < 48 * 32; c += NTHREADS) { const int rr = c >> 5, ck = c & 31; const int t = t0 - 8 + rr;
            if (t >= 0 && t < TL) *(LAS u32x4*)(U + rr * 256 + ck * 8) = *(const u32x4*)(PB + (seq0 + t) * AB_IN + ck * 8); }
        __syncthreads();
        { const int h2 = tid >> 8, ch = tid & 255, g = __builtin_amdgcn_readfirstlane(ch >> 6);
          if (g == 0) pool_thread<2>(U, pooled, t0, TL, h2, ch); else if (g == 1) pool_thread<4>(U, pooled, t0, TL, h2, ch); else if (g == 2) pool_thread<8>(U, pooled, t0, TL, h2, ch); else pool_thread<16>(U, pooled, t0, TL, h2, ch); }
        __syncthreads();
        { const int g = wave >> 1, tt = wave & 1;
          const size_t mrow = seq0 + t0 + tt * 16 + fr;
#pragma unroll
          for (int et = 0; et < 4; ++et) { f32x4 a = {0.f, 0.f, 0.f, 0.f};
#pragma unroll
              for (int ks = 0; ks < 2; ++ks) { const bf16x8 wf = *(const LAS bf16x8*)(pwT + (g * 64 + et * 16 + fr) * 72 + ks * 32 + fq * 8); const bf16x8 pf = *(const LAS bf16x8*)(pooled + (tt * 16 + fr) * 272 + g * 64 + ks * 32 + fq * 8);
                  a = mfma16(wf, pf, a); }
              const int col = g * 64 + et * 16 + 4 * fq; const f32x4 sc = psc[et];
              u32x2 w; w.x = pk2(a.x * sc.x, a.y * sc.y); w.y = pk2(a.z * sc.z, a.w * sc.w); *(u32x2*)(A2 + mrow * D + col) = w; } }
    }
    __syncthreads();
}

__device__ __forceinline__ void phase_even_mixer(const Params& P, LAS unsigned char* lds, int j_even, int tid, int bid, int nb) {
    const int lane = tid & 63, wave = tid >> 6;
    if (nb != 256) for (int idx = tid; idx < 12 * 15 * 31; idx += NTHREADS) ((LAS float*)(lds + NA_RPB_OFF))[idx] = P.in[11][(size_t)j_even * 12 * 15 * 31 + idx] * 1.44269504f;
    pool_units(P, lds, j_even, tid, bid, nb);
    const int gw = bid * NWAVES + wave, NGW = nb * NWAVES;
    if (nb == 256) {
        const bf16* PB = (const bf16*)(P.ws + WS_P);
        int bh_cur = -1, res_hi = 0;
        u32x4 pre[2]; int pre_lo = 0, pre_n = 0;
        const int it_end = bid * 12 + 12;
        for (int it = bid * 12; it < it_end; ++it) { const int bh = it >> 5, b = bh / 12, h = bh % 12;
            const int r0 = (it & 31) * 2, lo_need = min(max(r0 - 4, 0), 56), hi_need = min(max(r0 + 1 - 4, 0), 56) + 7;
            const int key = tid >> 3, c8 = tid & 7;
            __syncthreads();
            if (bh != bh_cur) { bh_cur = bh; res_hi = lo_need; pre_n = 0;
                for (int ch = tid; ch < 256 * 8; ch += NTHREADS) { const int kk = ch >> 3, cc = ch & 7;
                    *(LAS u32x4*)(lds + NA_KC_OFF + kk * 128 + ((cc ^ (kk & 7)) << 4)) = *(const u32x4*)(PB + ((size_t)ML + (size_t)b * NCTX + kk) * AB_IN + 1024 + h * 64 + cc * 8); }
                const bf16* vtc = (const bf16*)(P.ws + WS_VTC) + (size_t)(b * 12 + h) * 64 * NCTX;
                for (int ch = tid; ch < 64 * 32; ch += NTHREADS) { const int dh = ch >> 5, cc = ch & 31;
                    *(LAS u32x4*)(lds + NA_VC_OFF + dh * NA_VC_PITCH + cc * 16) = *(const u32x4*)(vtc + (size_t)dh * NCTX + cc * 8); }
                for (int idx = tid; idx < 15 * 31; idx += NTHREADS) ((LAS float*)(lds + NA_RPB2))[idx] = P.in[11][((size_t)j_even * 12 + h) * 15 * 31 + idx] * 1.44269504f; }
            { const int first = max(res_hi, lo_need);
              if (pre_n > 0 && pre_lo == first && pre_lo + pre_n == hi_need + 1) {
#pragma unroll
                  for (int q = 0; q < 2; ++q) if (q < pre_n) *(LAS u32x4*)(lds + NA_KW_OFF + ((pre_lo + q) % 9) * NA_KW_ROW + key * NA_KW_PITCH + c8 * 16) = pre[q];
              } else
                  for (int R = first; R <= hi_need; ++R)
                      *(LAS u32x4*)(lds + NA_KW_OFF + (R % 9) * NA_KW_ROW + key * NA_KW_PITCH + c8 * 16) = *(const u32x4*)(PB + ((size_t)b * T + (size_t)R * 64 + key) * AB_IN + 1024 + h * 64 + c8 * 8); }
            res_hi = hi_need + 1; pre_n = 0;
            __syncthreads();
            if (it + 1 < it_end && ((it + 1) >> 5) == bh) {
                const int r1 = ((it + 1) & 31) * 2, lo1 = min(max(r1 - 4, 0), 56), hi1 = min(max(r1 + 1 - 4, 0), 56) + 7; const int f1 = max(res_hi, lo1);
                if (hi1 - f1 + 1 >= 1 && hi1 - f1 + 1 <= 2) { pre_lo = f1; pre_n = hi1 - f1 + 1;
#pragma unroll
                    for (int q = 0; q < 2; ++q) if (q < pre_n) pre[q] = *(const u32x4*)(PB + ((size_t)b * T + (size_t)(f1 + q) * 64 + key) * AB_IN + 1024 + h * 64 + c8 * 8); } }
            na_wave_unit<false, true>(P, lds, bh * 256 + (it & 31) * 8 + wave, lane); }
        __syncthreads();
    } else {
        for (int v = gw; v < 24576; v += NGW) na_wave_unit<false, false>(P, lds, v, lane);
    }
    for (int v = gw; v < 1536; v += NGW) na_wave_unit<true, false>(P, lds, v, lane);
}

constexpr int GP_G = 0;
constexpr int GP_SEG = 8192;
constexpr int GP_B = 12288;
constexpr int GP_QD = 45056;
constexpr int GP_KD = 62464;
constexpr int GP_KLT = 79872;
constexpr int GP_ATT = 98304;
constexpr int GP_VT = 107520;
__device__ __forceinline__ void phase_gla_prepass(const Params& P, LAS unsigned char* lds, int j_odd, int tid, int bid, int nb, int dbg = 0) {
    const bf16* PB = (const bf16*)(P.ws + WS_P);
    const int lane = tid & 63, wave = tid >> 6, fr = lane & 15, fq = lane >> 4;
    LAS float* G = (LAS float*)(lds + GP_G); LAS float* SEG = (LAS float*)(lds + GP_SEG); LAS float* BC = (LAS float*)(lds + GP_B);
    LAS bf16* QD = (LAS bf16*)(lds + GP_QD); LAS bf16* KD = (LAS bf16*)(lds + GP_KD); LAS bf16* KLT = (LAS bf16*)(lds + GP_KLT); LAS bf16* ATT = (LAS bf16*)(lds + GP_ATT); LAS bf16* VTs = (LAS bf16*)(lds + GP_VT);
    const float* ROPEC = (const float*)(P.ws + WS_ROPE); const float* ROPES = ROPEC + T * 64;
    const f32x4 zero4 = {0.f, 0.f, 0.f, 0.f};
    const int f = tid & 63, seg = tid >> 6;
    const int ri = tid >> 3, rg = tid & 7;
    for (int unit = bid; unit < 544 * 4; unit += nb) {
        const int c = unit >> 2, h = unit & 3;
        const bool latent = c < 512;
        const size_t m0 = latent ? (size_t)c * 64 : (size_t)ML + (size_t)(c - 512) * 64;
        const int t0 = (c & 63) * 64;
        float gv[4];
#pragma unroll
        for (int q = 0; q < 4; ++q) { const int idx = tid + NTHREADS * q; gv[q] = bf2f(PB[(m0 + (idx >> 5)) * GLA_IN + 3072 + (idx & 31)]); }
        const bf16* rowp = PB + (m0 + ri) * GLA_IN + h * 128 + rg * 8;
        const u32x4 q1r = *(const u32x4*)rowp, q2r = *(const u32x4*)(rowp + 64), k1r = *(const u32x4*)(rowp + 512), k2r = *(const u32x4*)(rowp + 576);
        f32x4 cs4[4];
        if (latent) { const float* cp = ROPEC + (size_t)(t0 + ri) * 64 + rg * 8; const float* sp = ROPES + (size_t)(t0 + ri) * 64 + rg * 8;
            cs4[0] = *(const f32x4*)cp; cs4[1] = *(const f32x4*)(cp + 4); cs4[2] = *(const f32x4*)sp; cs4[3] = *(const f32x4*)(sp + 4); }
        else { cs4[0] = cs4[1] = (f32x4){1.f, 1.f, 1.f, 1.f}; cs4[2] = cs4[3] = zero4; }
        __syncthreads();
#pragma unroll
        for (int q = 0; q < 4; ++q) G[tid + NTHREADS * q] = gv[q];
        float qa[8], qb[8], ka[8], kb[8];
        { const unsigned qw1[4] = {q1r.x, q1r.y, q1r.z, q1r.w}, qw2[4] = {q2r.x, q2r.y, q2r.z, q2r.w}, kw1[4] = {k1r.x, k1r.y, k1r.z, k1r.w}, kw2[4] = {k2r.x, k2r.y, k2r.z, k2r.w};
#pragma unroll
          for (int e = 0; e < 8; ++e) { const int sh = (e & 1) * 16;
              const float x1 = bf2f((qw1[e >> 1] >> sh) & 0xffffu), x2 = bf2f((qw2[e >> 1] >> sh) & 0xffffu), y1 = bf2f((kw1[e >> 1] >> sh) & 0xffffu), y2 = bf2f((kw2[e >> 1] >> sh) & 0xffffu);
              const float cn = cs4[e >> 2][e & 3], sn = cs4[2 + (e >> 2)][e & 3];
              qa[e] = (x1 * cn - x2 * sn) * 0.08838834764831845f; qb[e] = (x1 * sn + x2 * cn) * 0.08838834764831845f; ka[e] = y1 * cn - y2 * sn; kb[e] = y1 * sn + y2 * cn; } }
        __syncthreads();
#pragma unroll 1
        for (int z = 0; z < 2; ++z) {
            const size_t u = ((size_t)c * 4 + h) * 2 + z;
            float bb1[8], bb2[8];
            { float wg1[16], wg2[16];
#pragma unroll
              for (int rr = 0; rr < 16; ++rr) { const float* wp = P.in[14] + ((size_t)(j_odd * 2 + z) * 16 + rr) * 512 + h * 128 + f; wg1[rr] = wp[0]; wg2[rr] = wp[64]; }
              const float bg1 = P.in[15][(size_t)(j_odd * 2 + z) * 512 + h * 128 + f], bg2 = P.in[15][(size_t)(j_odd * 2 + z) * 512 + h * 128 + 64 + f];
              float run1 = 0.f, run2 = 0.f;
#pragma unroll
              for (int ii = 0; ii < 8; ++ii) { const int ip = seg * 8 + ii, i = z ? 63 - ip : ip; float x1 = bg1, x2 = bg2;
                  if (!(dbg & 2))
#pragma unroll
                  for (int r4 = 0; r4 < 4; ++r4) { const f32x4 g4 = *(const LAS f32x4*)(G + i * 32 + z * 16 + r4 * 4);
                      x1 += g4.x * wg1[4 * r4] + g4.y * wg1[4 * r4 + 1] + g4.z * wg1[4 * r4 + 2] + g4.w * wg1[4 * r4 + 3];
                      x2 += g4.x * wg2[4 * r4] + g4.y * wg2[4 * r4 + 1] + g4.z * wg2[4 * r4 + 2] + g4.w * wg2[4 * r4 + 3]; }
                  run1 += (fminf(x1, 0.f) - __logf(1.0f + __expf(-fabsf(x1)))) * (1.0f / 16.0f); run2 += (fminf(x2, 0.f) - __logf(1.0f + __expf(-fabsf(x2)))) * (1.0f / 16.0f);
                  bb1[ii] = run1; bb2[ii] = run2; }
              SEG[seg * 128 + f] = run1; SEG[seg * 128 + 64 + f] = run2; }
            __syncthreads();
            { float off1 = 0.f, off2 = 0.f, tot1 = 0.f, tot2 = 0.f;
#pragma unroll
              for (int sg = 0; sg < 8; ++sg) { const float a1 = SEG[sg * 128 + f], a2 = SEG[sg * 128 + 64 + f]; tot1 += a1; tot2 += a2; if (sg < seg) { off1 += a1; off2 += a2; } }
              if (seg == 0) { float* dec = (float*)(P.ws + WS_GDEC) + u * 128; dec[f] = __expf(tot1); dec[64 + f] = __expf(tot2); }
#pragma unroll
              for (int ii = 0; ii < 8; ++ii) { BC[(seg * 8 + ii) * 128 + f] = bb1[ii] + off1; BC[(seg * 8 + ii) * 128 + 64 + f] = bb2[ii] + off2; } }
            __syncthreads();
            { const int ip = z ? 63 - ri : ri;
              const LAS float* bp = BC + ip * 128 + rg * 8; const LAS float* lp = BC + 63 * 128 + rg * 8;
              float ba[8], bbv[8], la[8], lb[8];
#pragma unroll
              for (int q4 = 0; q4 < 2; ++q4) { const f32x4 x = *(const LAS f32x4*)(bp + 4 * q4), y = *(const LAS f32x4*)(bp + 64 + 4 * q4), lx = *(const LAS f32x4*)(lp + 4 * q4), ly = *(const LAS f32x4*)(lp + 64 + 4 * q4);
#pragma unroll
                  for (int e = 0; e < 4; ++e) { ba[4 * q4 + e] = x[e]; bbv[4 * q4 + e] = y[e]; la[4 * q4 + e] = lx[e]; lb[4 * q4 + e] = ly[e]; } }
              float qda[8], qdb[8], kda[8], kdb[8];
#pragma unroll
              for (int e = 0; e < 8; ++e) { qda[e] = qa[e] * __expf(ba[e]); qdb[e] = qb[e] * __expf(bbv[e]); kda[e] = ka[e] * __expf(-ba[e]); kdb[e] = kb[e] * __expf(-bbv[e]);
                  KLT[(rg * 8 + e) * 72 + ip] = (bf16)f2bf(ka[e] * __expf(la[e] - ba[e])); KLT[(64 + rg * 8 + e) * 72 + ip] = (bf16)f2bf(kb[e] * __expf(lb[e] - bbv[e])); }
              u32x4 w;
              w.x = pk2(qda[0], qda[1]); w.y = pk2(qda[2], qda[3]); w.z = pk2(qda[4], qda[5]); w.w = pk2(qda[6], qda[7]); *(LAS u32x4*)(QD + ip * 136 + rg * 8) = w;
              w.x = pk2(qdb[0], qdb[1]); w.y = pk2(qdb[2], qdb[3]); w.z = pk2(qdb[4], qdb[5]); w.w = pk2(qdb[6], qdb[7]); *(LAS u32x4*)(QD + ip * 136 + 64 + rg * 8) = w;
              w.x = pk2(kda[0], kda[1]); w.y = pk2(kda[2], kda[3]); w.z = pk2(kda[4], kda[5]); w.w = pk2(kda[6], kda[7]); *(LAS u32x4*)(KD + ip * 136 + rg * 8) = w;
              w.x = pk2(kdb[0], kdb[1]); w.y = pk2(kdb[2], kdb[3]); w.z = pk2(kdb[4], kdb[5]); w.w = pk2(kdb[6], kdb[7]); *(LAS u32x4*)(KD + ip * 136 + 64 + rg * 8) = w; }
            __syncthreads();
#pragma unroll
            for (int tt = 0; tt < 2; ++tt) { const int id = wave * 2 + tt, ti = id >> 2, ts = id & 3;
                f32x4 a = zero4;
                if (ts <= ti && !(dbg & 4)) {
#pragma unroll
                    for (int kk = 0; kk < 4; ++kk) { const bf16x8 qf = *(const LAS bf16x8*)(QD + (ti * 16 + fr) * 136 + kk * 32 + fq * 8); const bf16x8 kf = *(const LAS bf16x8*)(KD + (ts * 16 + fr) * 136 + kk * 32 + fq * 8);
                        a = mfma16(kf, qf, a); }
#pragma unroll
                    for (int jx = 0; jx < 4; ++jx) if (ts * 16 + 4 * fq + jx > ti * 16 + fr) a[jx] = 0.f;
                }
                u32x2 w; w.x = pk2(a.x, a.y); w.y = pk2(a.z, a.w); *(LAS u32x2*)(ATT + (ti * 16 + fr) * 72 + ts * 16 + 4 * fq) = w; }
            __syncthreads();
            if (!(dbg & 8)) { bf16* QDG = (bf16*)(P.ws + WS_GQD) + u * 22528; bf16* KLG = QDG + 64 * 136; bf16* ATG = KLG + 128 * 72;
              for (int ch = tid; ch < 64 * 136 / 8; ch += NTHREADS) *(u32x4*)(QDG + ch * 8) = *(const LAS u32x4*)(QD + ch * 8);
              for (int ch = tid; ch < 128 * 72 / 8; ch += NTHREADS) *(u32x4*)(KLG + ch * 8) = *(const LAS u32x4*)(KLT + ch * 8);
              for (int ch = tid; ch < 64 * 72 / 8; ch += NTHREADS) *(u32x4*)(ATG + ch * 8) = *(const LAS u32x4*)(ATT + ch * 8); }
            __syncthreads();
        }
    }
}

constexpr int GS_X = 54272, GS_QD = 0, GS_KLT = 17408, GS_ATT = 35840, GS_VT = 45056, GS_ST = 2 * GS_X, GS_STB = 17408;
__device__ __forceinline__ bf16x8 rev8(bf16x8 v) {
    const u32x4 x = __builtin_bit_cast(u32x4, v); u32x4 y;
    y.x = __builtin_amdgcn_alignbit(x.w, x.w, 16); y.y = __builtin_amdgcn_alignbit(x.z, x.z, 16); y.z = __builtin_amdgcn_alignbit(x.y, x.y, 16); y.w = __builtin_amdgcn_alignbit(x.x, x.x, 16);
    return __builtin_bit_cast(bf16x8, y);
}
__device__ __forceinline__ int gla_chunk(int b, int z, int cs) { return (cs < 4) ? 512 + b * 4 + (z ? 3 - cs : cs) : b * 64 + (z ? 63 - (cs - 4) : (cs - 4)); }
struct GlaStage { u32x4 r[7]; };
__device__ __forceinline__ void gla_stage_load(const Params& P, GlaStage& R, int b, int h, int z, int dvs, int cs, int tid, int wave, int fq) {
    const int c = gla_chunk(b, z, cs); const size_t u = ((size_t)c * 4 + h) * 2 + z;
    const unsigned char* IMG = P.ws + WS_GQD + u * 45056;
    const unsigned char* VTG = P.ws + WS_GVT + ((size_t)c * 1024 + h * 256 + dvs * 64) * 144 - (size_t)2816 * 16;
#pragma unroll
    for (int q = 0; q < 5; ++q) R.r[q] = *(const u32x4*)(IMG + (tid + 512 * q) * 16);
    { const int g = tid + 2560; R.r[5] = *(const u32x4*)((g < 2816 ? IMG : VTG) + g * 16); }
    { const int g = min(tid + 3072, 3391); R.r[6] = *(const u32x4*)(VTG + g * 16); }
}
__device__ __forceinline__ f32x4 gla_dec_load(const Params& P, int b, int h, int z, int cs, int wave, int fq) {
    const int c = gla_chunk(b, z, cs); const size_t u = ((size_t)c * 4 + h) * 2 + z; return *(const f32x4*)((const float*)(P.ws + WS_GDEC) + u * 128 + wave * 16 + 4 * fq);
}
__device__ __forceinline__ void gla_stage_store(LAS unsigned char* xb, const GlaStage& R, int tid) {
#pragma unroll
    for (int q = 0; q < 7; ++q) { const int g = tid + 512 * q; if (q < 6 || g < 3392) *(LAS u32x4*)(xb + g * 16) = R.r[q]; }
}
__device__ __forceinline__ void phase_gla_scan(const Params& P, LAS unsigned char* lds, int tid, int bid, int nb) {
    const int lane = tid & 63, wave = tid >> 6, fr = lane & 15, fq = lane >> 4;
    for (int cb = bid; cb < 256; cb += nb) {
        const int xcd = cb & 7, kq = cb >> 3, g = xcd * 8 + (kq >> 2), dvs = kq & 3;
        const int b = g >> 3, h = (g >> 1) & 3, z = g & 1;
        bf16* O = (bf16*)(P.ws + (z ? WS_OB : WS_OF));
        f32x4 Sacc[4];
#pragma unroll
        for (int te = 0; te < 4; ++te) Sacc[te] = (f32x4){0.f, 0.f, 0.f, 0.f};
        GlaStage R;
        gla_stage_load(P, R, b, h, z, dvs, 0, tid, wave, fq);
        __syncthreads();
        for (int idx = tid; idx < 2 * GS_STB / 4; idx += NTHREADS) ((LAS unsigned*)(lds + GS_ST))[idx] = 0u;
        gla_stage_store(lds, R, tid);
        gla_stage_load(P, R, b, h, z, dvs, 1, tid, wave, fq);
        __syncthreads();
#pragma unroll 1
        for (int cs = 0; cs < 68; ++cs) {
            const LAS unsigned char* xb = lds + (cs & 1) * GS_X;
            const f32x4 dec_cur = gla_dec_load(P, b, h, z, cs, wave, fq);
            if (cs + 1 < 68) gla_stage_store(lds + ((cs + 1) & 1) * GS_X, R, tid);
            if (cs + 2 < 68) gla_stage_load(P, R, b, h, z, dvs, cs + 2, tid, wave, fq);
            const int c = gla_chunk(b, z, cs); const int ti = wave >> 1;
            const LAS bf16* STr = (const LAS bf16*)(lds + GS_ST + (cs & 1) * GS_STB);
            LAS bf16* STw = (LAS bf16*)(lds + GS_ST + ((cs + 1) & 1) * GS_STB);
            const LAS bf16* QDl = (const LAS bf16*)(xb + GS_QD); const LAS bf16* KLl = (const LAS bf16*)(xb + GS_KLT); const LAS bf16* ATl = (const LAS bf16*)(xb + GS_ATT); const LAS bf16* VTl = (const LAS bf16*)(xb + GS_VT);
            bf16x8 vt[4][2];
#pragma unroll
            for (int te = 0; te < 4; ++te)
#pragma unroll
                for (int kk = 0; kk < 2; ++kk) { const bf16x8 v = *(const LAS bf16x8*)(VTl + (te * 16 + fr) * 72 + (z ? (56 - kk * 32 - fq * 8) : (kk * 32 + fq * 8))); vt[te][kk] = z ? rev8(v) : v; }
            const size_t m0 = (c < 512) ? (size_t)c * 64 : (size_t)ML + (size_t)(c - 512) * 64;
            const int ip = ti * 16 + fr; const size_t mrow = m0 + (z ? 63 - ip : ip);
            bf16x8 qd[4], at[2];
#pragma unroll
            for (int kk = 0; kk < 4; ++kk) qd[kk] = *(const LAS bf16x8*)(QDl + ip * 136 + kk * 32 + fq * 8);
#pragma unroll
            for (int kk = 0; kk < 2; ++kk) at[kk] = *(const LAS bf16x8*)(ATl + ip * 72 + kk * 32 + fq * 8);
#pragma unroll
            for (int tt = 0; tt < 2; ++tt) { const int te = (wave & 1) * 2 + tt;
                f32x4 a = {0.f, 0.f, 0.f, 0.f};
#pragma unroll
                for (int kk = 0; kk < 4; ++kk) { const bf16x8 sf = *(const LAS bf16x8*)(STr + (te * 16 + fr) * 136 + kk * 32 + fq * 8); a = mfma16(sf, qd[kk], a); }
                bf16x8 v0 = *(const LAS bf16x8*)(VTl + (te * 16 + fr) * 72 + (z ? (56 - fq * 8) : (fq * 8))), v1 = *(const LAS bf16x8*)(VTl + (te * 16 + fr) * 72 + (z ? (24 - fq * 8) : (32 + fq * 8)));
                if (z) { v0 = rev8(v0); v1 = rev8(v1); }
                a = mfma16(v0, at[0], a); a = mfma16(v1, at[1], a);
                { u32x2 w; w.x = pk2(a.x, a.y); w.y = pk2(a.z, a.w); *(u32x2*)(O + mrow * D + h * 256 + dvs * 64 + te * 16 + 4 * fq) = w; } }
            { const bf16x8 kl0 = *(const LAS bf16x8*)(KLl + (wave * 16 + fr) * 72 + fq * 8), kl1 = *(const LAS bf16x8*)(KLl + (wave * 16 + fr) * 72 + 32 + fq * 8);
#pragma unroll
              for (int te = 0; te < 4; ++te) { f32x4 a = Sacc[te] * dec_cur; a = mfma16(kl0, vt[te][0], a); a = mfma16(kl1, vt[te][1], a); Sacc[te] = a;
                  u32x2 w; w.x = pk2(a.x, a.y); w.y = pk2(a.z, a.w); *(LAS u32x2*)(STw + (te * 16 + fr) * 136 + wave * 16 + 4 * fq) = w; } }
            __syncthreads();
        }
    }
}

__device__ __forceinline__ void phase_gla_out(const Params& P, int j_odd, int tid, int bid, int nb, int Mrows) {
    const int lane = tid & 63, wave = tid >> 6; unsigned char* ws = P.ws;
    const bf16* PB = (const bf16*)(ws + WS_P); bf16* A2 = (bf16*)(ws + WS_A2);
    const bf16* OF = (const bf16*)(ws + WS_OF); const bf16* OB = (const bf16*)(ws + WS_OB);
    const f32x4 ng = *(const f32x4*)(P.in[16] + j_odd * 256 + 4 * lane);
    for (int m0 = (bid * NWAVES + wave) * 2; m0 < Mrows; m0 += nb * NWAVES * 2) {
        u32x2 of[2][4], ob[2][4], rr[2][4];
#pragma unroll
        for (int q = 0; q < 2; ++q) { const int m = min(m0 + q, Mrows - 1);
#pragma unroll
            for (int h = 0; h < 4; ++h) { const int col = h * 256 + 4 * lane;
                of[q][h] = *(const u32x2*)(OF + (size_t)m * D + col); ob[q][h] = *(const u32x2*)(OB + (size_t)m * D + col); rr[q][h] = *(const u32x2*)(PB + (size_t)m * GLA_IN + 2048 + col); } }
#pragma unroll
        for (int q = 0; q < 2; ++q) { const int m = m0 + q;
            if (m < Mrows) {
#pragma unroll
                for (int h = 0; h < 4; ++h) { const int col = h * 256 + 4 * lane;
                    const f32x4 o = {bf2f(of[q][h].x & 0xffffu) + bf2f(ob[q][h].x & 0xffffu), bf2f(of[q][h].x >> 16) + bf2f(ob[q][h].x >> 16), bf2f(of[q][h].y & 0xffffu) + bf2f(ob[q][h].y & 0xffffu), bf2f(of[q][h].y >> 16) + bf2f(ob[q][h].y >> 16)};
                    const float ss = wave_sum(o.x * o.x + o.y * o.y + o.z * o.z + o.w * o.w);
                    const float rs = rsqrtf(ss * (1.0f / 256.0f) + 1e-6f);
                    const float r0 = bf2f(rr[q][h].x & 0xffffu), r1 = bf2f(rr[q][h].x >> 16), r2 = bf2f(rr[q][h].y & 0xffffu), r3 = bf2f(rr[q][h].y >> 16);
                    u32x2 w; w.x = pk2(o.x * rs * ng.x * silu_f(r0), o.y * rs * ng.y * silu_f(r1)); w.y = pk2(o.z * rs * ng.z * silu_f(r2), o.w * rs * ng.w * silu_f(r3));
                    *(u32x2*)(A2 + (size_t)m * D + col) = w; } } }
    }
}

constexpr int L1_HP = 1040;
constexpr int L1_HHI = 0, L1_HLO = 16 * L1_HP * 2;
constexpr int L1_PART = 2 * 16 * L1_HP * 2;
constexpr int L1_SEL = L1_PART + 16384;
constexpr int L1_MAXROWS = 136;
constexpr int L1_VEC = L1_SEL + 8192;
template <bool B> struct BTag { static constexpr bool value = B; };
template <bool L0> struct L1XSel { typedef f32x4 type; };
template <> struct L1XSel<false> { typedef u32x2 type; };
__device__ __forceinline__ f32x4 l1_xval(const f32x4& x) { return x; }
__device__ __forceinline__ f32x4 l1_xval(const u32x2& w) { return (f32x4){bf2f(w.x & 0xffffu), bf2f(w.x >> 16), bf2f(w.y & 0xffffu), bf2f(w.y >> 16)}; }
__device__ __forceinline__ void phase_ln1_router(const Params& P, LAS unsigned char* lds, int layer, int tid, int bid, int nb, int Mrows, bool dry = false) {
    const int lane = tid & 63, wave = tid >> 6, fr = lane & 15, fq = lane >> 4; unsigned char* ws = P.ws;
    LAS bf16* HHI = (LAS bf16*)(lds + L1_HHI); LAS bf16* HLO = (LAS bf16*)(lds + L1_HLO); LAS float* PART = (LAS float*)(lds + L1_PART);
    LAS int* SELE = (LAS int*)(lds + L1_SEL); LAS int* SELP = SELE + L1_MAXROWS * 4; LAS float* SELG = (LAS float*)(SELP + L1_MAXROWS * 4);
    LAS int* hist = (LAS int*)(SELG + L1_MAXROWS * 4); LAS int* base = hist + 32;
    __syncthreads();
    LAS float* RB = (LAS float*)(base + 32);
    if (tid < 32) { hist[tid] = 0; RB[tid] = P.in[19][layer * 32 + tid]; }
    bf16x8 whi[2][4], wlo[2][4];
    { const bf16* rwt = (const bf16*)(ws + WS_RWT) + (size_t)layer * 2 * 32 * 1024;
#pragma unroll
      for (int et = 0; et < 2; ++et)
#pragma unroll
          for (int ks = 0; ks < 4; ++ks) { const bf16* p = rwt + (size_t)(et * 16 + fr) * 1024 + wave * 128 + ks * 32 + fq * 8; whi[et][ks] = *(const bf16x8*)p; wlo[et][ks] = *(const bf16x8*)(p + 32 * 1024); } }
    const int rpb = (Mrows + nb - 1) / nb;
    const int row_lo = bid * rpb, row_hi = min(row_lo + rpb, Mrows);
    const float* mods = (const float*)(ws + WS_MODS) + (size_t)layer * 9 * 6144;
    LAS float* VEC = (LAS float*)(lds + L1_VEC);
    const int mb0 = (row_lo < ML) ? (row_lo >> 12) : 8, mb1 = (row_hi - 1 < ML) ? ((row_hi - 1) >> 12) : 8;
    for (int idx = tid; idx < 8 * 1024; idx += NTHREADS) { const int vsel = idx >> 10, col = idx & 1023; float x;
        if (vsel == 0) x = P.in[6][(size_t)(layer * 2 + 0) * D + col]; else if (vsel == 1) x = P.in[7][(size_t)(layer * 2 + 0) * D + col];
        else { const int set = (vsel - 2) / 3, what = (vsel - 2) % 3; x = mods[(size_t)(set ? mb1 : mb0) * 6144 + (what == 0 ? 3 : what == 1 ? 4 : 2) * 1024 + col]; }
        VEC[idx] = x; }
    const bf16* X2 = (const bf16*)(ws + WS_X); bf16* Xo = (bf16*)(ws + WS_OB); unsigned char* H8o        = (unsigned char*)(ws + (dry ? WS_A2 : WS_H8));
    const bf16* OPR = (const bf16*)(ws + WS_P);
    const f32x4 zero4 = {0.f, 0.f, 0.f, 0.f};
    __syncthreads();
    auto run = [&](auto l0tag) __attribute__((always_inline)) {
        constexpr bool L0 = decltype(l0tag)::value;
        typedef typename L1XSel<L0>::type XT;
        XT xA[2][4], xB[2][4]; u32x2 oA[2][4], oB[2][4];
        auto load_rows = [&](int pp, XT (&xs)[2][4], u32x2 (&os)[2][4]) __attribute__((always_inline)) {
#pragma unroll
            for (int rr = 0; rr < 2; ++rr) { const int m = min(pp + wave * 2 + rr, row_hi - 1);
#pragma unroll
                for (int j = 0; j < 4; ++j) {
                    if constexpr (L0) { const float* xsrc = (m < ML) ? P.in[0] + (size_t)m * D : P.in[2] + (size_t)(m - ML) * D; xs[rr][j] = *(const f32x4*)(xsrc + 4 * lane + 256 * j); }
                    else xs[rr][j] = *(const u32x2*)(X2 + (size_t)m * D + 4 * lane + 256 * j);
                    os[rr][j] = *(const u32x2*)(OPR + (size_t)m * D + 4 * lane + 256 * j); } } };
        auto pass = [&](int p0, XT (&xs)[2][4], u32x2 (&os)[2][4]) __attribute__((always_inline)) {
#pragma unroll
        for (int rr = 0; rr < 2; ++rr) { const int lr16 = wave * 2 + rr, m = p0 + lr16;
            if (m < row_hi) {
                const int mb = (m < ML) ? (m >> 12) : 8; const LAS float* VS = VEC + 2048 + ((mb == mb0) ? 0 : 3072);
                f32x4 v[4]; float s = 0.f;
#pragma unroll
                for (int j = 0; j < 4; ++j) { const int col = 4 * lane + 256 * j; const u32x2 ow = os[rr][j]; const f32x4 g1 = *(const LAS f32x4*)(VS + 2048 + col);
                    const f32x4 o = {bf2f(ow.x & 0xffffu), bf2f(ow.x >> 16), bf2f(ow.y & 0xffffu), bf2f(ow.y >> 16)};
                    const f32x4 xv = l1_xval(xs[rr][j]);
                    v[j] = xv * DN_ALPHA + g1 * o; s += (v[j].x + v[j].y) + (v[j].z + v[j].w); }
                const float mean = wave_sum(s) * (1.f / D); float s2 = 0.f;
#pragma unroll
                for (int j = 0; j < 4; ++j) { v[j] = v[j] - mean; s2 += (v[j].x * v[j].x + v[j].y * v[j].y) + (v[j].z * v[j].z + v[j].w * v[j].w); }
                const float rstd = rsqrtf(wave_sum(s2) * (1.f / D) + LN_EPS);
#pragma unroll
                for (int j = 0; j < 4; ++j) { const int col = 4 * lane + 256 * j; const f32x4 g = *(const LAS f32x4*)(VEC + col), bb = *(const LAS f32x4*)(VEC + 1024 + col);
                    v[j] = v[j] * rstd * g + bb; { u32x2 xw; xw.x = pk2(v[j].x, v[j].y); xw.y = pk2(v[j].z, v[j].w); *(u32x2*)(Xo + (size_t)m * D + col) = xw; }
                    const f32x4 sh = *(const LAS f32x4*)(VS + col), sc = *(const LAS f32x4*)(VS + 1024 + col);
                    const f32x4 hq = v[j] * (1.f + sc) + sh;
                    *(unsigned*)(H8o + (size_t)m * D + col) = pk4_fp8(hq.x * H8_SCALE, hq.y * H8_SCALE, hq.z * H8_SCALE, hq.w * H8_SCALE);
                    const unsigned h01 = pk2(hq.x, hq.y), h23 = pk2(hq.z, hq.w);
                    const unsigned l01 = pk2(hq.x - bf2f(h01 & 0xffffu), hq.y - bf2f(h01 >> 16)), l23 = pk2(hq.z - bf2f(h23 & 0xffffu), hq.w - bf2f(h23 >> 16));
                    u32x2 wh = {h01, h23}, wl = {l01, l23};
                    *(LAS u32x2*)(HHI + lr16 * L1_HP + col) = wh; *(LAS u32x2*)(HLO + lr16 * L1_HP + col) = wl; }
            } }
        __syncthreads();
        { f32x4 acc[2] = {zero4, zero4};
#pragma unroll
          for (int ks = 0; ks < 4; ++ks) { const bf16x8 hh = *(const LAS bf16x8*)(HHI + fr * L1_HP + wave * 128 + ks * 32 + fq * 8), hl = *(const LAS bf16x8*)(HLO + fr * L1_HP + wave * 128 + ks * 32 + fq * 8);
#pragma unroll
              for (int et = 0; et < 2; ++et) { acc[et] = mfma16(whi[et][ks], hh, acc[et]); acc[et] = mfma16(whi[et][ks], hl, acc[et]); acc[et] = mfma16(wlo[et][ks], hh, acc[et]); } }
#pragma unroll
          for (int et = 0; et < 2; ++et) *(LAS f32x4*)(PART + (wave * 16 + fr) * 32 + et * 16 + 4 * fq) = acc[et]; }
        __syncthreads();
        { const int hl = lane & 31, lr16 = wave * 2 + (lane >> 5), m = p0 + lr16;
          float lgv = RB[hl];
#pragma unroll
          for (int w8 = 0; w8 < 8; ++w8) lgv += PART[(w8 * 16 + lr16) * 32 + hl];
          int se[4]; float sv[4];
#pragma unroll
          for (int k = 0; k < 4; ++k) {
              float mx = lgv;
              mx = fmaxf(mx, __builtin_bit_cast(float, __builtin_amdgcn_update_dpp(0, __builtin_bit_cast(int, mx), 0x128, 0xf, 0xf, false)));
              mx = fmaxf(mx, __builtin_bit_cast(float, __builtin_amdgcn_update_dpp(0, __builtin_bit_cast(int, mx), 0x124, 0xf, 0xf, false)));
              mx = fmaxf(mx, __builtin_bit_cast(float, __builtin_amdgcn_update_dpp(0, __builtin_bit_cast(int, mx), 0x122, 0xf, 0xf, false)));
              mx = fmaxf(mx, __builtin_bit_cast(float, __builtin_amdgcn_update_dpp(0, __builtin_bit_cast(int, mx), 0x121, 0xf, 0xf, false)));
              { float a_, b_; swap16(mx, a_, b_); mx = fmaxf(a_, b_); }
              const unsigned long long bal = __ballot(lgv == mx);
              const unsigned hm = (unsigned)(bal >> (lane & 32));
              const int bi = __builtin_ctz(hm);
              se[k] = bi; sv[k] = mx;
              lgv = (hl == bi) ? -3.0e38f : lgv; }
          const float e1 = __expf(sv[1] - sv[0]), e2 = __expf(sv[2] - sv[0]), e3 = __expf(sv[3] - sv[0]); const float inv = 1.f / (1.f + e1 + e2 + e3);
          if ((lane & 31) == 0 && m < row_hi) { const int lr = m - row_lo;
              const float gt[4] = {inv, e1 * inv, e2 * inv, e3 * inv};
#pragma unroll
              for (int k = 0; k < 4; ++k) { const int pos = atomicAdd((int*)(hist + se[k]), 1); SELE[lr * 4 + k] = se[k]; SELP[lr * 4 + k] = pos; SELG[lr * 4 + k] = gt[k]; } } }
        };
        load_rows(row_lo, xA, oA);
        for (int p0 = row_lo; p0 < row_hi; p0 += 32) {
            const bool more = p0 + 16 < row_hi;
            if (more) load_rows(p0 + 16, xB, oB);
            pass(p0, xA, oA);
            if (more) { if (p0 + 32 < row_hi) load_rows(p0 + 32, xA, oA); pass(p0 + 16, xB, oB); }
        }
    };
    if (layer == 0) run(BTag<true>{}); else run(BTag<false>{});
    __syncthreads();
    if (dry) return;
    if (tid < 32) { unsigned* cnt = (unsigned*)(ws + WS_CTL) + CW_CNT + layer * 32; const int hc = hist[tid]; base[tid] = hc ? (int)__hip_atomic_fetch_add(cnt + tid, (unsigned)hc, __ATOMIC_RELAXED, __HIP_MEMORY_SCOPE_AGENT) : 0; }
    __syncthreads();
    const int nrows = row_hi - row_lo;
    int* TOKE = (int*)(ws + WS_TOKE); int* TOKP = (int*)(ws + WS_TOKP); float* TOKG = (float*)(ws + WS_TOKG); int* LIST = (int*)(ws + WS_LIST);
    for (int idx = tid; idx < nrows * 4; idx += NTHREADS) { const int lr = idx >> 2; const int m = row_lo + lr; const int e = SELE[idx], pos = base[e] + SELP[idx];
        TOKE[(size_t)m * 4 + (idx & 3)] = e; TOKP[(size_t)m * 4 + (idx & 3)] = pos; TOKG[(size_t)m * 4 + (idx & 3)] = SELG[idx]; LIST[(size_t)e * M + pos] = m; }
}

__device__ __forceinline__ void phase_ln2_combine(const Params& P, LAS unsigned char* lds, int layer, int tid, int bid, int nb, int Mrows, bool dry = false) {
    const int lane = tid & 63, wave = tid >> 6; unsigned char* ws = P.ws;
    moe_tables<0>(P, lds, tid, layer);
    const LAS int* tab = (const LAS int*)(lds + g8::MOE_TAB);
    const float* mods = (const float*)(ws + WS_MODS) + (size_t)layer * 9 * 6144;
    const float* modn = (const float*)(ws + WS_MODS) + (size_t)(layer + 1) * 9 * 6144;
    const bf16* X = (const bf16*)(ws + WS_OB); bf16* X2 = (bf16*)(ws + WS_X); const bf16* YS = (const bf16*)(ws + WS_YS);
    const int* TOKE = (const int*)(ws + WS_TOKE); const int* TOKP = (const int*)(ws + WS_TOKP); const float* TOKG = (const float*)(ws + WS_TOKG);
    const int rpb = (Mrows + nb - 1) / nb;
    const int row_lo = bid * rpb, row_hi = min(row_lo + rpb, Mrows);
    LAS float* VEC = (LAS float*)lds;
    const int mb0 = (row_lo < ML) ? (row_lo >> 12) : 8, mb1 = (row_hi - 1 < ML) ? ((row_hi - 1) >> 12) : 8;
    const bool has_next = layer < DEPTH - 1;
    for (int idx = tid; idx < 8 * 1024; idx += NTHREADS) { const int vsel = idx >> 10, col = idx & 1023; float x;
        if (vsel == 0) x = P.in[6][(size_t)(layer * 2 + 1) * D + col]; else if (vsel == 1) x = P.in[7][(size_t)(layer * 2 + 1) * D + col];
        else { const int set = (vsel - 2) / 3, what = (vsel - 2) % 3; const int mbs = set ? mb1 : mb0;
            x = (what == 0) ? mods[(size_t)mbs * 6144 + 5 * 1024 + col] : (has_next ? modn[(size_t)mbs * 6144 + (what == 1 ? 0 : 1024) + col] : 0.f); }
        VEC[idx] = x; }
    __syncthreads();
    for (int m0 = row_lo + wave * 2; m0 < row_hi; m0 += 2 * NWAVES) {
        int te[2][4], tp[2][4]; float tg[2][4];
#pragma unroll
        for (int rr = 0; rr < 2; ++rr) { const int m = min(m0 + rr, row_hi - 1);
#pragma unroll
            for (int k = 0; k < 4; ++k) { te[rr][k] = TOKE[(size_t)m * 4 + k]; tp[rr][k] = TOKP[(size_t)m * 4 + k]; tg[rr][k] = TOKG[(size_t)m * 4 + k]; } }
        u32x2 xr[2][4]; u32x2 yr[2][4][4];
#pragma unroll
        for (int rr = 0; rr < 2; ++rr) { const int m = min(m0 + rr, row_hi - 1);
#pragma unroll
            for (int j = 0; j < 4; ++j) xr[rr][j] = *(const u32x2*)(X + (size_t)m * D + 4 * lane + 256 * j);
#pragma unroll
            for (int k = 0; k < 4; ++k) { const bf16* yp = YS + ((size_t)tab[96 + te[rr][k]] + tp[rr][k]) * 1024 + 4 * lane;
#pragma unroll
                for (int j = 0; j < 4; ++j) yr[rr][k][j] = *(const u32x2*)(yp + 256 * j); } }
#pragma unroll
        for (int rr = 0; rr < 2; ++rr) { const int m = m0 + rr;
            if (m < row_hi) {
                const int mb = (m < ML) ? (m >> 12) : 8; const LAS float* VS = VEC + 2048 + ((mb == mb0) ? 0 : 3072);
                f32x4 v[4]; float s = 0.f;
#pragma unroll
                for (int j = 0; j < 4; ++j) { const int col = 4 * lane + 256 * j; f32x4 y = {0.f, 0.f, 0.f, 0.f};
#pragma unroll
                    for (int k = 0; k < 4; ++k) { const u32x2 rw = yr[rr][k][j]; const float gt = tg[rr][k];
                        y.x += gt * bf2f(rw.x & 0xffffu); y.y += gt * bf2f(rw.x >> 16); y.z += gt * bf2f(rw.y & 0xffffu); y.w += gt * bf2f(rw.y >> 16); }
                    const f32x4 g2 = *(const LAS f32x4*)(VS + col);
                    const u32x2 xw = xr[rr][j]; const f32x4 xv = {bf2f(xw.x & 0xffffu), bf2f(xw.x >> 16), bf2f(xw.y & 0xffffu), bf2f(xw.y >> 16)};
                    v[j] = xv * DN_ALPHA + g2 * y; s += (v[j].x + v[j].y) + (v[j].z + v[j].w); }
                const float mean = wave_sum(s) * (1.f / D); float s2 = 0.f;
#pragma unroll
                for (int j = 0; j < 4; ++j) { v[j] = v[j] - mean; s2 += (v[j].x * v[j].x + v[j].y * v[j].y) + (v[j].z * v[j].z + v[j].w * v[j].w); }
                const float rstd = rsqrtf(wave_sum(s2) * (1.f / D) + LN_EPS);
#pragma unroll
                for (int j = 0; j < 4; ++j) { const int col = 4 * lane + 256 * j; const f32x4 g = *(const LAS f32x4*)(VEC + col), bb = *(const LAS f32x4*)(VEC + 1024 + col);
                    v[j] = v[j] * rstd * g + bb;
                    if (dry) *(f32x4*)((float*)(ws + WS_OB) + (size_t)m * D + col) = v[j]; else if (has_next) { u32x2 xo; xo.x = pk2(v[j].x, v[j].y); xo.y = pk2(v[j].z, v[j].w); *(u32x2*)(X2 + (size_t)m * D + col) = xo; } else *(f32x4*)(P.out + (size_t)m * D + col) = v[j];
                    if (has_next) { const f32x4 sh = *(const LAS f32x4*)(VS + 1024 + col), sc = *(const LAS f32x4*)(VS + 2048 + col);
                        *(unsigned*)((unsigned char*)(ws + (dry ? WS_A2 : WS_H)) + (size_t)m * D + col) = pk4_fp8((v[j].x * (1.f + sc.x) + sh.x) * H8_SCALE, (v[j].y * (1.f + sc.y) + sh.y) * H8_SCALE, (v[j].z * (1.f + sc.z) + sh.z) * H8_SCALE, (v[j].w * (1.f + sc.w) + sh.w) * H8_SCALE); } }
            } }
    }
}

#define XB_TMO      128
#define XB_XCNT(j)  (256  + 64 * (j))
#define XB_XSUB(j)  (1280 + 64 * (j))
#define XB_XGEN(j)  (2304 + 64 * (j))
#define XB_TOP      3328
#define XB_TOPGEN   3392
#define XCD_BAR_WORDS 3456
#define XB_SPIN_CAP (1u << 20)

__device__ __forceinline__ unsigned xb_ld(unsigned* p)              { return __hip_atomic_load(p, __ATOMIC_RELAXED, __HIP_MEMORY_SCOPE_AGENT); }
__device__ __forceinline__ unsigned xb_add(unsigned* p, unsigned v) { return __hip_atomic_fetch_add(p, v, __ATOMIC_RELAXED, __HIP_MEMORY_SCOPE_AGENT); }
__device__ __forceinline__ unsigned xb_xcc_id() { return (unsigned)__builtin_amdgcn_s_getreg((3 << 11) | 20) & 0xFu; }
#define XB_SPIN(cond, bar) do { unsigned _sp = 0; while (cond) { __builtin_amdgcn_s_sleep(1); \
    if ((++_sp & 255u) == 0u) { if (xb_ld(&(bar)[XB_TMO])) break; if (_sp > XB_SPIN_CAP) { atomicAdd(&(bar)[XB_TMO], 1u); break; } } } } while (0)

struct XcdBarrier {
    unsigned* bar; unsigned x;
    volatile LAS unsigned* st;
};

__device__ __forceinline__ XcdBarrier xcd_barrier_post(unsigned* bar, volatile LAS unsigned* st) {
    XcdBarrier b; b.bar = bar; b.x = xb_xcc_id(); b.st = st;
    if (threadIdx.x == 0) (void)xb_add(&bar[XB_XCNT(b.x)], 1u);
    return b;
}
__device__ __forceinline__ void xcd_barrier_complete(unsigned* bar, unsigned x, unsigned& nloc, unsigned& nx) {
    const unsigned G = gridDim.x * gridDim.y * gridDim.z;
    unsigned sum, cnt, mine, sp = 0u;
    for (;;) {
        sum = 0u; cnt = 0u; mine = 0u;
#pragma unroll
        for (unsigned j = 0; j < 16; ++j) { const unsigned c = xb_ld(&bar[XB_XCNT(j)]); sum += c; cnt += (c > 0u) ? 1u : 0u; mine = (j == x) ? c : mine; }
        if (sum == G) break;
        __builtin_amdgcn_s_sleep(1);
        if ((++sp & 255u) == 0u) { if (xb_ld(&bar[XB_TMO])) break; if (sp > XB_SPIN_CAP) { atomicAdd(&bar[XB_TMO], 1u); break; } }
    }
    nloc = mine > 0u ? mine : 1u; nx = cnt > 0u ? cnt : 1u;
}

__device__ __forceinline__ void xcd_barrier(const XcdBarrier& b) {
    asm volatile("s_waitcnt vmcnt(0)" ::: "memory");
    __syncthreads();
    if (threadIdx.x == 0) {
        unsigned* bar = b.bar;
        __builtin_amdgcn_s_waitcnt(0);
        unsigned nloc = b.st[0], nx = b.st[1];
        if (nloc == 0u) { xcd_barrier_complete(bar, b.x, nloc, nx); b.st[0] = nloc; b.st[1] = nx; }
        const unsigned old = xb_add(&bar[XB_XSUB(b.x)], 1u);
        const unsigned gen = old / nloc;
        if (old + 1u == (gen + 1u) * nloc) {
            __builtin_amdgcn_fence(__ATOMIC_RELEASE, "agent");
            asm volatile("s_waitcnt vmcnt(0)" ::: "memory");
            const unsigned og = xb_add(&bar[XB_TOP], 1u);
            const unsigned tg = og / nx;
            if (og + 1u == (tg + 1u) * nx) xb_add(&bar[XB_TOPGEN], 1u);
            else XB_SPIN(xb_ld(&bar[XB_TOPGEN]) == tg, bar);
            __builtin_amdgcn_fence(__ATOMIC_ACQUIRE, "agent");
            xb_add(&bar[XB_XGEN(b.x)], 1u);
            asm volatile("s_waitcnt vmcnt(0)" ::: "memory");
        } else {
            XB_SPIN(xb_ld(&bar[XB_XGEN(b.x)]) == gen, bar);
            __builtin_amdgcn_fence(__ATOMIC_ACQUIRE, "agent");
            asm volatile("s_waitcnt vmcnt(0)" ::: "memory");
        }
    }
    __syncthreads();
}


constexpr int NPHASES = 2 + 8 * DEPTH;
__global__ void __launch_bounds__(NTHREADS, 2) fwd_kernel(Params P) {
    extern __shared__ __attribute__((aligned(16))) unsigned char lds_raw[];
    LAS unsigned char* lds = (LAS unsigned char*)lds_raw;
    const int tid = threadIdx.x, bid = blockIdx.x, nb = gridDim.x;
    const int lo = P.ph_lo, hi = P.ph_hi;
    volatile LAS unsigned* misc = (volatile LAS unsigned*)(lds + LDS_MISC);
    if (tid < 4) misc[tid] = 0u;
    __syncthreads();
    XcdBarrier bar; bar.bar = (unsigned*)(P.ws + WS_CTL) + CW_BAR; bar.x = 0; bar.st = misc;
    if (hi - lo > 1) bar = xcd_barrier_post((unsigned*)(P.ws + WS_CTL) + CW_BAR, misc);
#define IN(k) (lo <= (k) && (k) < hi)
#define GRIDBAR() do { XcdBarrier b2_ = bar; int z2_ = 0; asm volatile("" : "+s"(z2_)); b2_.bar = bar.bar + z2_; xcd_barrier(b2_); } while (0)
#define SEAM(k) do { if (lo <= (k) && (k) + 1 < hi) GRIDBAR(); } while (0)
#define DUP(bit, call) do { if (PROBE_DUP & (bit)) { GRIDBAR(); call; } } while (0)
    if (IN(0)) { phase_prologue_a(P, lds, tid, bid, nb); DUP(1, phase_prologue_a(P, lds, tid, bid, nb)); SEAM(0); }
    if (IN(1)) { phase_prologue_b(P, tid, bid, nb); SEAM(1); }
#pragma unroll 1
    for (int i = 0; i < DEPTH; ++i) {
        const int pb = 2 + 8 * i, j = i >> 1;
        Params Pl = P; { int z_ = 0; asm volatile("" : "+s"(z_)); Pl.ws = P.ws + z_; }
        int tid_l = threadIdx.x, bid_l = blockIdx.x; asm volatile("" : "+v"(tid_l)); asm volatile("" : "+s"(bid_l));
        const bool last = (i == DEPTH - 1);
        const int Mres = last ? ML : M;
        if ((i & 1) == 0) {
            if (IN(pb + 0)) { phase_gemm_dense<0>(Pl, lds, tid_l, bid_l, nb, (const void*)(Pl.ws + WS_H), (const void*)(Pl.ws + WS_WABIN + (size_t)j * AB_IN * 1024), M, AB_IN, i); DUP(2, phase_gemm_dense<0>(Pl, lds, tid_l, bid_l, nb, (const void*)(Pl.ws + WS_H), (const void*)(Pl.ws + WS_WABIN + (size_t)j * AB_IN * 1024), M, AB_IN, i)); SEAM(pb + 0); }
            if (IN(pb + 1)) { phase_even_mixer(Pl, lds, j, tid_l, bid_l, nb); DUP(4, phase_even_mixer(Pl, lds, j, tid_l, bid_l, nb)); SEAM(pb + 1); }
            if (IN(pb + 3)) { phase_gemm_dense<1>(Pl, lds, tid_l, bid_l, nb, (const bf16*)(Pl.ws + WS_A2), (const bf16*)(Pl.ws + WS_WABOUT) + (size_t)j * 1024 * 1024, Mres, 1024, i); SEAM(pb + 3); }
        } else {
            if (IN(pb + 0)) { phase_gemm_dense<0>(Pl, lds, tid_l, bid_l, nb, (const void*)(Pl.ws + WS_H), (const void*)(Pl.ws + WS_WGIN + (size_t)j * WGIN_STRIDE), M, GLA_IN, i); DUP(2, phase_gemm_dense<0>(Pl, lds, tid_l, bid_l, nb, (const void*)(Pl.ws + WS_H), (const void*)(Pl.ws + WS_WGIN + (size_t)j * WGIN_STRIDE), M, GLA_IN, i)); SEAM(pb + 0); }
            if (IN(pb + 1)) { if (PROBE_DUP & (1 << 16)) { phase_gla_prepass(Pl, lds, j, tid_l, bid_l, nb, (PROBE_DUP >> 17) & 15); GRIDBAR(); } phase_gla_prepass(Pl, lds, j, tid_l, bid_l, nb); DUP(128, phase_gla_prepass(Pl, lds, j, tid_l, bid_l, nb)); GRIDBAR(); phase_gla_scan(Pl, lds, tid_l, bid_l, nb); DUP(8, phase_gla_scan(Pl, lds, tid_l, bid_l, nb)); SEAM(pb + 1); }
            if (IN(pb + 2)) { phase_gla_out(Pl, j, tid_l, bid_l, nb, Mres); DUP(64, phase_gla_out(Pl, j, tid_l, bid_l, nb, Mres)); SEAM(pb + 2); }
            if (IN(pb + 3)) { phase_gemm_dense<1>(Pl, lds, tid_l, bid_l, nb, (const bf16*)(Pl.ws + WS_A2), (const bf16*)(Pl.ws + WS_WGOUT) + (size_t)j * 1024 * 1024, Mres, 1024, i); SEAM(pb + 3); }
        }
        if (IN(pb + 4)) { if (PROBE_DUP & 256) { phase_ln1_router(Pl, lds, i, tid_l, bid_l, nb, Mres, true); GRIDBAR(); } phase_ln1_router(Pl, lds, i, tid_l, bid_l, nb, Mres); SEAM(pb + 4); }
        if (IN(pb + 5)) { if (PROBE_DUP & (1024 | 2048 | 4096 | 8192 | 16384 | 32768)) { phase_moe_gemm<1>(Pl, lds, tid_l, bid_l, nb, i, (PROBE_DUP >> 10) & 63); GRIDBAR(); } phase_moe_gemm<1>(Pl, lds, tid_l, bid_l, nb, i); DUP(16, phase_moe_gemm<1>(Pl, lds, tid_l, bid_l, nb, i)); SEAM(pb + 5); }
        if (IN(pb + 6)) { phase_moe_gemm<2>(Pl, lds, tid_l, bid_l, nb, i); DUP(32, phase_moe_gemm<2>(Pl, lds, tid_l, bid_l, nb, i)); SEAM(pb + 6); }
        if (IN(pb + 7)) { if (PROBE_DUP & 512) { phase_ln2_combine(Pl, lds, i, tid_l, bid_l, nb, Mres, true); GRIDBAR(); } phase_ln2_combine(Pl, lds, i, tid_l, bid_l, nb, Mres); SEAM(pb + 7); }
    }
#undef IN
#undef SEAM
#undef GRIDBAR
}

extern "C" void kernel_launch(void* const* d_in, const int* in_sizes, int n_in, void* d_out, int out_size, void* d_ws, size_t ws_size, hipStream_t stream) {
    static int grid = 0;
    if (grid == 0) {
        if (n_in != 24 || out_size != ML * D || ws_size < WS_END) { fprintf(stderr, "kernel_launch: unexpected problem (n_in %d, out %d, ws %zu < %zu)\n", n_in, out_size, ws_size, (size_t)WS_END); grid = -1; return; }
        int dev = 0, cus = 0, per_cu = 0;
        if (hipGetDevice(&dev) != hipSuccess || hipDeviceGetAttribute(&cus, hipDeviceAttributeMultiprocessorCount, dev) != hipSuccess) { grid = -1; return; }
        if (hipFuncSetAttribute((const void*)fwd_kernel, hipFuncAttributeMaxDynamicSharedMemorySize, LDS_BYTES) != hipSuccess) { fprintf(stderr, "kernel_launch: hipFuncSetAttribute failed\n"); grid = -1; return; }
        if (hipOccupancyMaxActiveBlocksPerMultiprocessor(&per_cu, (const void*)fwd_kernel, NTHREADS, LDS_BYTES) != hipSuccess || per_cu < 1) { fprintf(stderr, "kernel_launch: occupancy query says %d blocks per CU\n", per_cu); }
        (void)hipGetLastError();
        grid = cus;
    }
    if (grid < 0) return;
    (void)hipMemsetAsync((char*)d_ws + WS_CTL, 0, CTL_ZERO_BYTES, stream);
    Params p{};
    for (int i = 0; i < 24; ++i) p.in[i] = (const float*)d_in[i];
    p.out = (float*)d_out; p.ws = (unsigned char*)d_ws;
#if MK_PER_PHASE
    for (int ph = 0; ph < NPHASES; ++ph) {
        if (ph >= 2 && ((ph - 2) & 7) == 2 && ((((ph - 2) >> 3) & 1) == 0)) continue;
        p.ph_lo = ph; p.ph_hi = ph + 1;
        hipLaunchKernelGGL(fwd_kernel, dim3(grid), dim3(NTHREADS), LDS_BYTES, stream, p);
    }
#else
    p.ph_lo = 0; p.ph_hi = NPHASES;
    hipLaunchKernelGGL(fwd_kernel, dim3(grid), dim3(NTHREADS), LDS_BYTES, stream, p);
#endif
    const hipError_t le = hipPeekAtLastError();
    if (le != hipSuccess) fprintf(stderr, "kernel_launch: launch failed: %s\n", hipGetErrorName(le));
}
```
